# Optimizing an MI355X kernel written in HIP

```python
import math
import jax, jax.numpy as jnp
from jax import lax
import numpy as np

D_MODEL = 2048
BATCH = 4
SEQ = 4096
DEPTH = 4

D_FF = 4 * D_MODEL
NORM_EPS = 1e-6

MLA_HEADS = 8
MLA_Q_RANK = 512
MLA_KV_RANK = 512
MLA_NOPE_DIM = 128
MLA_ROPE_DIM = 64
MLA_V_DIM = 128
ROPE_THETA = 10000.0
Q_BLOCK = 128

MOBA_HEADS = 8
MOBA_HEAD_DIM = 128
MOBA_BLOCK = 256
MOBA_TOPK = 3
MOBA_Q_CHUNK = 16

DIL_WINDOWS = (128, 512, 2048)
DIL_RATES = (1, 4, 16)
N_DIL = 3
DIL_HEADS_PER_GROUP = 4
DIL_HEAD_DIM = 128

SWA_Q_HEADS = 16
SWA_KV_HEADS = 2
SWA_HEAD_DIM = 64
SWA_WINDOW = 128

BAND = 128

EVEN_IN = MLA_Q_RANK + MLA_KV_RANK + MLA_ROPE_DIM + 3 * MOBA_HEADS * MOBA_HEAD_DIM
EVEN_OUT = MLA_HEADS * MLA_V_DIM + MOBA_HEADS * MOBA_HEAD_DIM
ODD_IN = 3 * N_DIL * DIL_HEADS_PER_GROUP * DIL_HEAD_DIM + (SWA_Q_HEADS + 2 * SWA_KV_HEADS) * SWA_HEAD_DIM
ODD_OUT = DIL_HEADS_PER_GROUP * DIL_HEAD_DIM + SWA_Q_HEADS * SWA_HEAD_DIM

kernel_name = "hybrid_mla_moba_dilated_swa_trunk"


def rms_norm(x, g):
    xf = x.astype(jnp.float32)
    y = xf * lax.rsqrt(jnp.mean(xf * xf, axis=-1, keepdims=True) + NORM_EPS)
    return (y * g.astype(jnp.float32)).astype(x.dtype)


def alibi_slopes(n):
    return jnp.exp2(-8.0 * jnp.arange(1, n + 1, dtype=jnp.float32) / n)


def apply_rope(x, pos):
    half = x.shape[-1] // 2
    inv_freq = ROPE_THETA ** (-jnp.arange(half, dtype=jnp.float32) / half)
    ang = pos.astype(jnp.float32)[:, None] * inv_freq[None, :]
    shape = (1, x.shape[1]) + (1,) * (x.ndim - 3) + (half,)
    cos = jnp.cos(ang).reshape(shape)
    sin = jnp.sin(ang).reshape(shape)
    xf = x.astype(jnp.float32)
    x1, x2 = xf[..., :half], xf[..., half:]
    return jnp.concatenate([x1 * cos - x2 * sin, x2 * cos + x1 * sin], axis=-1).astype(x.dtype)


def mla_attention(q_lat, kv_lat, k_pe, q_norm, w_uq, kv_norm, w_ukv):
    B, S, _ = q_lat.shape
    H, dn, dr, dv = MLA_HEADS, MLA_NOPE_DIM, MLA_ROPE_DIM, MLA_V_DIM
    pos = jnp.arange(S, dtype=jnp.int32)
    q = (rms_norm(q_lat, q_norm) @ w_uq).reshape(B, S, H, dn + dr)
    kv = (rms_norm(kv_lat, kv_norm) @ w_ukv).reshape(B, S, H, dn + dv)
    q = jnp.concatenate([q[..., :dn], apply_rope(q[..., dn:], pos)], axis=-1)
    k_rot = jnp.broadcast_to(apply_rope(k_pe, pos)[:, :, None, :], (B, S, H, dr))
    k = jnp.concatenate([kv[..., :dn], k_rot], axis=-1)
    v = kv[..., dn:]
    scale = (dn + dr) ** -0.5

    def query_block(c):
        q0 = c * Q_BLOCK
        qc = lax.dynamic_slice_in_dim(q, q0, Q_BLOCK, axis=1)
        s = jnp.einsum("bqhd,bkhd->bhqk", qc, k, preferred_element_type=jnp.float32) * scale
        qpos = q0 + jnp.arange(Q_BLOCK, dtype=jnp.int32)
        s = jnp.where(pos[None, :] <= qpos[:, None], s, -jnp.inf)
        p = jax.nn.softmax(s, axis=-1)
        return jnp.einsum("bhqk,bkhd->bqhd", p.astype(v.dtype), v, preferred_element_type=jnp.float32)

    o = lax.map(query_block, jnp.arange(S // Q_BLOCK))
    return o.transpose(1, 0, 2, 3, 4).reshape(B, S, H * dv).astype(q_lat.dtype)


def moba_attention(q, k, v):
    B, S, H, dh = q.shape
    nb = -(-S // MOBA_BLOCK)
    pad = nb * MOBA_BLOCK - S
    kp = jnp.pad(k, ((0, 0), (0, pad), (0, 0), (0, 0)))
    vp = jnp.pad(v, ((0, 0), (0, pad), (0, 0), (0, 0)))
    kb = kp.reshape(B, nb, MOBA_BLOCK, H, dh).transpose(0, 3, 1, 2, 4)
    vb = vp.reshape(B, nb, MOBA_BLOCK, H, dh).transpose(0, 3, 1, 2, 4)
    kmean = jnp.mean(kb.astype(jnp.float32), axis=3).astype(q.dtype)
    k_sel = min(MOBA_TOPK, nb)
    slopes = alibi_slopes(H)
    scale = dh ** -0.5
    blk_ids = jnp.arange(nb, dtype=jnp.int32)
    offs = jnp.arange(MOBA_BLOCK, dtype=jnp.int32)
    b_ix = jnp.arange(B)[:, None, None, None]
    h_ix = jnp.arange(H)[None, :, None, None]

    def query_chunk(c):
        t0 = c * MOBA_Q_CHUNK
        qc = lax.dynamic_slice_in_dim(q, t0, MOBA_Q_CHUNK, axis=1).transpose(0, 2, 1, 3)
        tpos = t0 + jnp.arange(MOBA_Q_CHUNK, dtype=jnp.int32)
        own = t0 // MOBA_BLOCK
        gate = jnp.einsum("bhqd,bhnd->bhqn", qc, kmean, preferred_element_type=jnp.float32)
        gate = jnp.where(blk_ids < own, gate, -jnp.inf)
        gval, gidx = lax.top_k(gate, k_sel)
        own_idx = jnp.broadcast_to(own, gidx.shape[:-1] + (1,)).astype(gidx.dtype)
        idx = jnp.concatenate([gidx, own_idx], axis=-1)
        ok = jnp.concatenate([gval > -jnp.inf, jnp.ones(own_idx.shape, bool)], axis=-1)
        kg = kb[b_ix, h_ix, idx]
        vg = vb[b_ix, h_ix, idx]
        s = jnp.einsum("bhqd,bhqnjd->bhqnj", qc, kg, preferred_element_type=jnp.float32) * scale
        kpos = idx[..., None] * MOBA_BLOCK + offs
        dist = tpos[None, None, :, None, None] - kpos
        mask = ok[..., None] & (dist >= 0)
        s = jnp.where(mask, s - slopes[None, :, None, None, None] * dist.astype(jnp.float32), -jnp.inf)
        p = jax.nn.softmax(s.reshape(B, H, MOBA_Q_CHUNK, -1), axis=-1).reshape(s.shape)
        return jnp.einsum("bhqnj,bhqnjd->bqhd", p.astype(vg.dtype), vg, preferred_element_type=jnp.float32)

    o = lax.map(query_chunk, jnp.arange(S // MOBA_Q_CHUNK))
    return o.transpose(1, 0, 2, 3, 4).reshape(B, S, H * dh).astype(q.dtype)


def banded_window_attention(q, k, v, slopes, max_dist, pos_scale):
    N, L, Hk, G, dh = q.shape
    nb = -(-L // BAND)
    Lp = nb * BAND
    qp = jnp.pad(q, ((0, 0), (0, Lp - L), (0, 0), (0, 0), (0, 0))).reshape(N, nb, BAND, Hk, G, dh)
    kp = jnp.pad(k, ((0, 0), (BAND, Lp - L), (0, 0), (0, 0))).reshape(N, nb + 1, BAND, Hk, dh)
    vp = jnp.pad(v, ((0, 0), (BAND, Lp - L), (0, 0), (0, 0))).reshape(N, nb + 1, BAND, Hk, dh)
    kw = jnp.concatenate([kp[:, :-1], kp[:, 1:]], axis=2)
    vw = jnp.concatenate([vp[:, :-1], vp[:, 1:]], axis=2)
    s = jnp.einsum("nbqhgd,nbkhd->nbhgqk", qp, kw, preferred_element_type=jnp.float32) * (dh ** -0.5)
    blk = jnp.arange(nb, dtype=jnp.int32)[:, None, None]
    qpos = blk * BAND + jnp.arange(BAND, dtype=jnp.int32)[None, :, None]
    kpos = blk * BAND - BAND + jnp.arange(2 * BAND, dtype=jnp.int32)[None, None, :]
    dist = qpos - kpos
    mask = (dist >= 0) & (dist <= max_dist) & (kpos >= 0)
    bias = -(slopes[None, :, :, None, None] * (pos_scale * dist).astype(jnp.float32)[:, None, None])
    s = jnp.where(mask[:, None, None], s + bias, -jnp.inf)
    m = jnp.max(s, axis=-1)
    p = jnp.exp(s - m[..., None])
    l = jnp.sum(p, axis=-1)
    acc = jnp.einsum("nbhgqk,nbkhd->nbqhgd", p.astype(vw.dtype), vw, preferred_element_type=jnp.float32)
    acc = acc.reshape(N, Lp, Hk, G, dh)[:, :L]
    m = m.transpose(0, 1, 4, 2, 3).reshape(N, Lp, Hk, G)[:, :L]
    l = l.transpose(0, 1, 4, 2, 3).reshape(N, Lp, Hk, G)[:, :L]
    return acc, m, l


def dilated_attention(q, k, v):
    B, S, _, dh = q.shape
    HG = DIL_HEADS_PER_GROUP
    slopes = alibi_slopes(N_DIL * HG).reshape(N_DIL, HG)
    accs, ms, ls = [], [], []
    for g in range(N_DIL):
        w, d = DIL_WINDOWS[g], DIL_RATES[g]

        def strided(x):
            return x.reshape(B, S // d, d, HG, dh).transpose(0, 2, 1, 3, 4).reshape(B * d, S // d, HG, dh)

        sl = slice(g * HG, (g + 1) * HG)
        acc, m, l = banded_window_attention(strided(q[:, :, sl])[:, :, :, None], strided(k[:, :, sl]),
                                            strided(v[:, :, sl]), slopes[g][:, None], w // d, d)
        accs.append(acc.reshape(B, d, S // d, HG, dh).transpose(0, 2, 1, 3, 4).reshape(B, S, HG, dh))
        ms.append(m.reshape(B, d, S // d, HG).transpose(0, 2, 1, 3).reshape(B, S, HG))
        ls.append(l.reshape(B, d, S // d, HG).transpose(0, 2, 1, 3).reshape(B, S, HG))
    acc = jnp.stack(accs)
    m = jnp.stack(ms)
    l = jnp.stack(ls)
    wts = jnp.exp(m - jnp.max(m, axis=0, keepdims=True))
    out = jnp.sum(acc * wts[..., None], axis=0) / jnp.sum(l * wts, axis=0)[..., None]
    return out.reshape(B, S, HG * dh).astype(q.dtype)


def swa_sink_attention(q, k, v, sinks):
    B, S, Hq, dh = q.shape
    Hkv = k.shape[2]
    G = Hq // Hkv
    slopes = alibi_slopes(Hq).reshape(Hkv, G)
    acc, m, l = banded_window_attention(q.reshape(B, S, Hkv, G, dh), k, v, slopes, SWA_WINDOW - 1, 1)
    sk = sinks.astype(jnp.float32).reshape(Hkv, G)
    mx = jnp.maximum(m, sk)
    a = jnp.exp(m - mx)
    out = acc * a[..., None] / (l * a + jnp.exp(sk - mx))[..., None]
    return out.reshape(B, S, Hq * dh).astype(q.dtype)


def even_mixer(h, w_in, q_norm, w_uq, kv_norm, w_ukv, w_out):
    B, S, _ = h.shape
    hd = MOBA_HEADS * MOBA_HEAD_DIM
    sizes = [MLA_Q_RANK, MLA_KV_RANK, MLA_ROPE_DIM, hd, hd, hd]
    z = h @ w_in
    q_lat, kv_lat, k_pe, qb, kb, vb = jnp.split(z, np.cumsum(sizes)[:-1].tolist(), axis=-1)
    a = mla_attention(q_lat, kv_lat, k_pe, q_norm, w_uq, kv_norm, w_ukv)
    shp = (B, S, MOBA_HEADS, MOBA_HEAD_DIM)
    b = moba_attention(qb.reshape(shp), kb.reshape(shp), vb.reshape(shp))
    return jnp.concatenate([a, b], axis=-1).astype(h.dtype) @ w_out


def odd_mixer(h, w_in, sinks, w_out):
    B, S, _ = h.shape
    cd = N_DIL * DIL_HEADS_PER_GROUP * DIL_HEAD_DIM
    sizes = [cd, cd, cd, SWA_Q_HEADS * SWA_HEAD_DIM, SWA_KV_HEADS * SWA_HEAD_DIM, SWA_KV_HEADS * SWA_HEAD_DIM]
    z = h @ w_in
    qc, kc, vc, qd, kd, vd = jnp.split(z, np.cumsum(sizes)[:-1].tolist(), axis=-1)
    cshp = (B, S, N_DIL * DIL_HEADS_PER_GROUP, DIL_HEAD_DIM)
    c = dilated_attention(qc.reshape(cshp), kc.reshape(cshp), vc.reshape(cshp))
    kvshp = (B, S, SWA_KV_HEADS, SWA_HEAD_DIM)
    d = swa_sink_attention(qd.reshape(B, S, SWA_Q_HEADS, SWA_HEAD_DIM), kd.reshape(kvshp),
                           vd.reshape(kvshp), sinks)
    return jnp.concatenate([c, d], axis=-1).astype(h.dtype) @ w_out


def squared_relu_mlp(h, w_up, w_down):
    return jnp.square(jax.nn.relu(h @ w_up)) @ w_down


def setup_inputs(seed: int = 0) -> dict:
    key = jax.random.key(seed)
    ks = jax.random.split(key, 15)
    n_even = (DEPTH + 1) // 2
    n_odd = DEPTH // 2
    f32 = jnp.float32

    def w(k, shape, fan_in):
        return jax.random.normal(k, shape, f32) * fan_in ** -0.5

    def gain(k, shape):
        return 1.0 + 0.05 * jax.random.normal(k, shape, f32)

    return {
        "x": jax.random.normal(ks[0], (BATCH, SEQ, D_MODEL), f32),
        "attn_norm": gain(ks[1], (DEPTH, D_MODEL)),
        "mlp_norm": gain(ks[2], (DEPTH, D_MODEL)),
        "w_up": w(ks[3], (DEPTH, D_MODEL, D_FF), D_MODEL),
        "w_down": w(ks[4], (DEPTH, D_FF, D_MODEL), D_FF),
        "ev_w_in": w(ks[5], (n_even, D_MODEL, EVEN_IN), D_MODEL),
        "ev_q_norm": gain(ks[6], (n_even, MLA_Q_RANK)),
        "ev_w_uq": w(ks[7], (n_even, MLA_Q_RANK, MLA_HEADS * (MLA_NOPE_DIM + MLA_ROPE_DIM)), MLA_Q_RANK),
        "ev_kv_norm": gain(ks[8], (n_even, MLA_KV_RANK)),
        "ev_w_ukv": w(ks[9], (n_even, MLA_KV_RANK, MLA_HEADS * (MLA_NOPE_DIM + MLA_V_DIM)), MLA_KV_RANK),
        "ev_w_out": w(ks[10], (n_even, EVEN_OUT, D_MODEL), EVEN_OUT),
        "od_w_in": w(ks[11], (n_odd, D_MODEL, ODD_IN), D_MODEL),
        "od_sinks": 0.5 * jax.random.normal(ks[12], (n_odd, SWA_Q_HEADS), f32),
        "od_w_out": w(ks[13], (n_odd, ODD_OUT, D_MODEL), ODD_OUT),
        "final_norm": gain(ks[14], (D_MODEL,)),
    }


def reference(x, attn_norm, mlp_norm, w_up, w_down, ev_w_in, ev_q_norm, ev_w_uq, ev_kv_norm,
              ev_w_ukv, ev_w_out, od_w_in, od_sinks, od_w_out, final_norm):
    for layer in range(DEPTH):
        i = layer // 2
        h = rms_norm(x, attn_norm[layer])
        if layer % 2 == 0:
            mix = even_mixer(h, ev_w_in[i], ev_q_norm[i], ev_w_uq[i], ev_kv_norm[i], ev_w_ukv[i], ev_w_out[i])
        else:
            mix = odd_mixer(h, od_w_in[i], od_sinks[i], od_w_out[i])
        x = x + mix.astype(x.dtype)
        h = rms_norm(x, mlp_norm[layer])
        x = x + squared_relu_mlp(h, w_up[layer], w_down[layer]).astype(x.dtype)
    return rms_norm(x, final_norm)
```

```cpp
#include <hip/hip_runtime.h>
#include <cstdio>
#include <cstdint>
namespace pg8 {
#define PG8_LAS __attribute__((address_space(3)))
typedef unsigned short bf16_t;
typedef short bf16x8 __attribute__((ext_vector_type(8)));
typedef float f32x4 __attribute__((ext_vector_type(4)));
typedef unsigned u32x4 __attribute__((ext_vector_type(4)));
constexpr int BM = 256, BK = 64, HALF = 128, HTB = HALF * BK * 2  , STAGE_BYTES = 8 * HTB, NXCD = 8, WGM = 8;

__host__ __device__ __forceinline__ int lds_byte(int r, int c) { const int st = (r >> 4) * 2 + (c >> 5), rr = r & 15, cc = c & 31, ob = rr * 64 + cc * 2; return st * 1024 + (ob ^ (((ob >> 9) & 1) << 5)); }
__host__ __device__ __forceinline__ void stage_rc(int b, int& R, int& C) { const int st = b / 1024, sb = b % 1024, swz = sb ^ (((sb >> 9) & 1) << 5); R = (st >> 1) * 16 + swz / 64; C = (st & 1) * 32 + (swz % 64) / 2; }
__host__ __device__ __forceinline__ int perm32(int rho) { const int n = rho >> 4, i = rho & 15; return 8 * (i >> 2) + 4 * n + (i & 3); }

struct Unit { int pm, pn; };
struct Gemm { const bf16_t* A; const bf16_t* Bt; int M, N, K, lda, ldb; };

struct StaticOrder {
    int nM, nN, nwg, G, c, wgm;
    __host__ __device__ __forceinline__ void init(int M, int N, int G_, int c_) { nM = M / BM; nN = N / BM; nwg = nM * nN; G = G_; c = c_; wgm = WGM; }
    __host__ __device__ __forceinline__ bool next(int i, Unit& u) const {
        const long L = (long)i * G + c; if (L >= nwg) return false;
        int wgid = (int)L; { const int q = nwg / NXCD, r = nwg % NXCD, xcd = wgid % NXCD, off = wgid / NXCD; wgid = (xcd < r ? xcd * (q + 1) : r * (q + 1) + (xcd - r) * q) + off; }
        const int nig = wgm * nN, gid = wgid / nig, fm = gid * wgm, gsz = (nM - fm) < wgm ? (nM - fm) : wgm;
        u.pm = fm + ((wgid % nig) % gsz); u.pn = (wgid % nig) / gsz; return true;
    }
    __device__ __forceinline__ void a_ready(const Unit&) const {}
    __device__ __forceinline__ void done(const Unit&) const {}
};
typedef int i32x4 __attribute__((ext_vector_type(4)));
template <bool I8> struct AccT { typedef f32x4 type; };
template <> struct AccT<true> { typedef i32x4 type; };
__device__ __forceinline__ f32x4 mma16(bf16x8 a, bf16x8 b, f32x4 c) { return __builtin_amdgcn_mfma_f32_16x16x32_bf16(a, b, c, 0, 0, 0); }
__device__ __forceinline__ i32x4 mma16(bf16x8 a, bf16x8 b, i32x4 c) { return __builtin_amdgcn_mfma_i32_16x16x64_i8(__builtin_bit_cast(i32x4, a), __builtin_bit_cast(i32x4, b), c, 0, 0, 0); }
template <class Epi, class Sched, bool ALIGN_EPI = false, bool SP2 = false>
__device__ __forceinline__ void gemm_phase(PG8_LAS unsigned char* lds, const Gemm g, const Sched& S, const Epi& E) {
    int tid_o = threadIdx.x; asm volatile("" : "+v"(tid_o));
    const int tid = tid_o, wid = __builtin_amdgcn_readfirstlane(tid >> 6), lane = tid & 63, wr = wid >> 2, wc = wid & 3, fr = lane & 15, fq = lane >> 4;
    constexpr int ESZ = Epi::I8 ? 1 : 2;
    const int K = g.K, nt = K * ESZ / (BK * 2);
    unsigned voffA[2], voffB[2];
#pragma unroll
    for (int i = 0; i < 2; ++i) { int R, C; stage_rc(tid * 16 + i * 8192, R, C); const int Rb = Epi::PERM ? (64 * (R >> 5) + perm32(R & 31)) : R;
        voffA[i] = (unsigned)(R * g.lda * ESZ + C * 2); voffB[i] = (unsigned)(Rb * g.ldb * ESZ + C * 2); }
    const size_t kstep = (size_t)(BK * 2);
    const size_t hstepA = (size_t)HALF * g.lda * ESZ, hstepB = (size_t)(Epi::PERM ? 32 : HALF) * g.ldb * ESZ;
    const size_t tstepA = 2 * hstepA, tstepB = (size_t)BM * g.ldb * ESZ;
    const unsigned ldsw = (unsigned)wid * 1024u;
    const int aoff = lds_byte(wr * 64 + fr, fq * 8), boff = lds_byte(wc * 32 + fr, fq * 8);
#define PG8_SA(b, h) (((b) * 2 + (h)) * HTB)
#define PG8_SB(b, h) ((4 + (b) * 2 + (h)) * HTB)
#define PG8_STAGE(bufoff, gbase, voff) do { _Pragma("unroll") for (int _i = 0; _i < 2; ++_i) \
        __builtin_amdgcn_global_load_lds((const unsigned*)((const char*)(gbase) + (voff)[_i]), (PG8_LAS unsigned*)(lds + (bufoff) + ldsw + _i * 8192), 16, 0, 0); } while (0)
#define PG8_LDA(dst, b, h) do { _Pragma("unroll") for (int m = 0; m < 4; ++m) _Pragma("unroll") for (int k = 0; k < 2; ++k) dst[m][k] = *(const PG8_LAS bf16x8*)(lds + PG8_SA(b, h) + aoff + m * 2048 + k * 1024); } while (0)
#define PG8_LDB(dst, b, h) do { _Pragma("unroll") for (int n = 0; n < 2; ++n) _Pragma("unroll") for (int k = 0; k < 2; ++k) dst[n][k] = *(const PG8_LAS bf16x8*)(lds + PG8_SB(b, h) + boff + n * 2048 + k * 1024); } while (0)
#define PG8_MMA(ai, bj, At, Bt) do { __builtin_amdgcn_s_setprio(1); _Pragma("unroll") for (int m = 0; m < 4; ++m) _Pragma("unroll") for (int n = 0; n < 2; ++n) _Pragma("unroll") for (int k = 0; k < 2; ++k) \
        acc[ai][bj][m][n] = mma16(Bt[n][k], At[m][k], acc[ai][bj][m][n]); __builtin_amdgcn_s_setprio(0); } while (0)
#define PG8_WAIT_V(n) asm volatile("s_waitcnt vmcnt(" #n ")" ::: "memory")
#define PG8_WAIT_L(n) asm volatile("s_waitcnt lgkmcnt(" #n ")" ::: "memory")
#define PG8_BAR __builtin_amdgcn_s_barrier()
#define PG8_SCHED __builtin_amdgcn_sched_barrier(0)
    Unit cur, nxt; int ui = 0;
    if (!S.next(0, cur)) return;
    typedef typename AccT<Epi::I8>::type acc_t;
    acc_t acc[2][2][4][2];
#pragma unroll
    for (int a = 0; a < 2; ++a)
#pragma unroll
        for (int b = 0; b < 2; ++b)
#pragma unroll
            for (int m = 0; m < 4; ++m)
#pragma unroll
                for (int n = 0; n < 2; ++n) acc[a][b][m][n] = (acc_t){0, 0, 0, 0};
    bf16x8 At[4][2], B0[2][2], B1[2][2];
    const char* cA = (const char*)g.A + (size_t)cur.pm * tstepA; const char* cB = (const char*)g.Bt + (size_t)cur.pn * tstepB;
    S.a_ready(cur);
    if constexpr (SP2) {
        PG8_STAGE(PG8_SB(0, 0), cB, voffB); PG8_STAGE(PG8_SB(0, 1), cB + hstepB, voffB); PG8_STAGE(PG8_SA(0, 0), cA, voffA); PG8_STAGE(PG8_SA(0, 1), cA + hstepA, voffA);
        if (wr == 1) PG8_BAR;
        PG8_WAIT_V(2); PG8_BAR;
        PG8_STAGE(PG8_SB(1, 0), cB + kstep, voffB); PG8_STAGE(PG8_SA(1, 0), cA + kstep, voffA); PG8_STAGE(PG8_SB(1, 1), cB + hstepB + kstep, voffB);
        PG8_WAIT_V(6); PG8_BAR;
    } else {
        PG8_STAGE(PG8_SB(0, 0), cB, voffB); PG8_STAGE(PG8_SA(0, 0), cA, voffA); PG8_STAGE(PG8_SB(0, 1), cB + hstepB, voffB); PG8_STAGE(PG8_SA(0, 1), cA + hstepA, voffA);
        if (wr == 1) PG8_BAR;
        PG8_WAIT_V(4); PG8_BAR;
        PG8_STAGE(PG8_SB(1, 0), cB + kstep, voffB); PG8_STAGE(PG8_SA(1, 0), cA + kstep, voffA); PG8_STAGE(PG8_SB(1, 1), cB + hstepB + kstep, voffB);
        PG8_WAIT_V(6); PG8_BAR;
    }
    for (;;) {
        const bool has_next = S.next(ui + 1, nxt);
        const char* nA = has_next ? (const char*)g.A + (size_t)nxt.pm * tstepA : cA; const char* nB = has_next ? (const char*)g.Bt + (size_t)nxt.pn * tstepB : cB;
        for (int t = 0; t < nt; t += 2) {
            const bool last = (t == nt - 2);
            const char* a1 = cA + (size_t)(t + 1) * kstep;
            const char* a2 = last ? nA : cA + (size_t)(t + 2) * kstep; const char* b2 = last ? nB : cB + (size_t)(t + 2) * kstep;
            const char* a3 = a2 + kstep; const char* b3 = b2 + kstep;
            if (last && has_next) S.a_ready(nxt);
            if constexpr (SP2) {
            PG8_LDB(B0, 0, 0); PG8_LDB(B1, 0, 1); PG8_SCHED; PG8_LDA(At, 0, 0); PG8_STAGE(PG8_SA(1, 1), a1 + hstepA, voffA);
            PG8_WAIT_V(8); PG8_WAIT_L(0); PG8_BAR; PG8_MMA(0, 0, At, B0); PG8_MMA(0, 1, At, B1); PG8_BAR; PG8_SCHED;
            PG8_LDA(At, 0, 1); PG8_STAGE(PG8_SB(0, 0), b2, voffB); PG8_STAGE(PG8_SB(0, 1), b2 + hstepB, voffB); PG8_STAGE(PG8_SA(0, 0), a2, voffA);
            PG8_WAIT_V(8); PG8_WAIT_L(0); PG8_BAR; PG8_MMA(1, 0, At, B0); PG8_MMA(1, 1, At, B1); PG8_BAR; PG8_SCHED;
            PG8_LDB(B0, 1, 0); PG8_LDB(B1, 1, 1); PG8_SCHED; PG8_LDA(At, 1, 0); PG8_STAGE(PG8_SA(0, 1), a2 + hstepA, voffA);
            PG8_WAIT_V(8); PG8_WAIT_L(0); PG8_BAR; PG8_MMA(0, 0, At, B0); PG8_MMA(0, 1, At, B1); PG8_BAR; PG8_SCHED;
            PG8_LDA(At, 1, 1); PG8_STAGE(PG8_SB(1, 0), b3, voffB); PG8_STAGE(PG8_SB(1, 1), b3 + hstepB, voffB); PG8_STAGE(PG8_SA(1, 0), a3, voffA);
            PG8_WAIT_V(8); PG8_WAIT_L(0); PG8_BAR; PG8_MMA(1, 0, At, B0); PG8_MMA(1, 1, At, B1); PG8_BAR; PG8_SCHED;
            } else {
            PG8_LDB(B0, 0, 0); PG8_SCHED; PG8_LDA(At, 0, 0); PG8_STAGE(PG8_SA(1, 1), a1 + hstepA, voffA);
            PG8_WAIT_L(8); PG8_BAR; PG8_WAIT_L(0); PG8_MMA(0, 0, At, B0); PG8_BAR; PG8_SCHED;
            PG8_LDB(B1, 0, 1); PG8_STAGE(PG8_SB(0, 0), b2, voffB);
            PG8_BAR; PG8_WAIT_L(0); PG8_MMA(0, 1, At, B1); PG8_BAR;
            PG8_LDA(At, 0, 1); PG8_STAGE(PG8_SA(0, 0), a2, voffA);
            PG8_BAR; PG8_WAIT_L(0); PG8_MMA(1, 0, At, B0); PG8_BAR; PG8_SCHED;
            PG8_STAGE(PG8_SB(0, 1), b2 + hstepB, voffB);
            PG8_WAIT_V(6); PG8_BAR; PG8_MMA(1, 1, At, B1); PG8_BAR;
            PG8_LDB(B0, 1, 0); PG8_SCHED; PG8_LDA(At, 1, 0); PG8_STAGE(PG8_SA(0, 1), a2 + hstepA, voffA);
            PG8_WAIT_L(8); PG8_BAR; PG8_WAIT_L(0); PG8_MMA(0, 0, At, B0); PG8_BAR; PG8_SCHED;
            PG8_LDB(B1, 1, 1); PG8_STAGE(PG8_SB(1, 0), b3, voffB);
            PG8_BAR; PG8_WAIT_L(0); PG8_MMA(0, 1, At, B1); PG8_BAR;
            PG8_LDA(At, 1, 1); PG8_STAGE(PG8_SA(1, 0), a3, voffA);
            PG8_BAR; PG8_WAIT_L(0); PG8_MMA(1, 0, At, B0); PG8_BAR; PG8_SCHED;
            PG8_STAGE(PG8_SB(1, 1), b3 + hstepB, voffB);
            PG8_WAIT_V(6); PG8_BAR; PG8_MMA(1, 1, At, B1); PG8_BAR;
            }
        }
        if constexpr (ALIGN_EPI) { if (wr == 0) PG8_BAR; }
        if constexpr (!Epi::AFTER_DRAIN) { if constexpr (Epi::I8) { f32x4 accf[2][2][4][2];
            const f32x4* cp_ = (const f32x4*)(E.qcol + cur.pn * BM + wc * 64 + 8 * fq); const f32x4 cs_[2][2] = {{cp_[0], cp_[1]}, {cp_[8], cp_[9]}};
            f32x4 of_[2][2] = {};
            if constexpr (Epi::OFFS) { const f32x4* op_ = (const f32x4*)(E.qoff + cur.pn * BM + wc * 64 + 8 * fq); of_[0][0] = op_[0]; of_[0][1] = op_[1]; of_[1][0] = op_[8]; of_[1][1] = op_[9]; }
#pragma unroll
            for (int a = 0; a < 2; ++a)
#pragma unroll
                for (int b = 0; b < 2; ++b)
#pragma unroll
                    for (int m = 0; m < 4; ++m)
#pragma unroll
                        for (int n = 0; n < 2; ++n) accf[a][b][m][n] = Epi::OFFS ? (__builtin_convertvector(acc[a][b][m][n], f32x4) + of_[b][n]) * cs_[b][n] : __builtin_convertvector(acc[a][b][m][n], f32x4) * cs_[b][n];
            E(accf, cur, wr, wc, fr, fq); } else { E(acc, cur, wr, wc, fr, fq); } S.done(cur); }
        if (!has_next) break;
#pragma unroll
        for (int a = 0; a < 2; ++a)
#pragma unroll
            for (int b = 0; b < 2; ++b)
#pragma unroll
                for (int m = 0; m < 4; ++m)
#pragma unroll
                    for (int n = 0; n < 2; ++n) acc[a][b][m][n] = (acc_t){0, 0, 0, 0};
        cur = nxt; cA = nA; cB = nB; ++ui;
        if constexpr (ALIGN_EPI) { if (wr == 1) PG8_BAR; }
    }
    PG8_WAIT_V(0);
    if constexpr (!ALIGN_EPI) { if (wr == 0) PG8_BAR; }
    PG8_BAR;
    if constexpr (Epi::AFTER_DRAIN && !Epi::I8) { E.fused(acc, cur, wr, wc, fr, fq, lds, wid, lane); S.done(cur); }
#undef PG8_SA
#undef PG8_SB
#undef PG8_STAGE
#undef PG8_LDA
#undef PG8_LDB
#undef PG8_MMA
#undef PG8_WAIT_V
#undef PG8_WAIT_L
#undef PG8_BAR
#undef PG8_SCHED
}
}

namespace pg8 {
__device__ __forceinline__ unsigned cvt_pk_bf16(float lo, float hi) { unsigned r; asm volatile("v_cvt_pk_bf16_f32 %0, %1, %2" : "=v"(r) : "v"(lo), "v"(hi)); return r; }
__device__ __forceinline__ float zrow_rstd(const bf16_t* z) { float s = 0.f;
#pragma unroll 1
    for (int c = 0; c < 64; ++c) { const u32x4 w = *(const u32x4*)(z + c * 8);
        const float a0 = __uint_as_float(w.x << 16), a1 = __uint_as_float(w.x & 0xffff0000u), a2 = __uint_as_float(w.y << 16), a3 = __uint_as_float(w.y & 0xffff0000u), a4 = __uint_as_float(w.z << 16), a5 = __uint_as_float(w.z & 0xffff0000u), a6 = __uint_as_float(w.w << 16), a7 = __uint_as_float(w.w & 0xffff0000u);
        s += ((a0 * a0 + a1 * a1) + (a2 * a2 + a3 * a3)) + ((a4 * a4 + a5 * a5) + (a6 * a6 + a7 * a7)); }
    return 1.0f / sqrtf(s * (1.0f / 512.0f) + 1e-6f); }
typedef unsigned u32x2 __attribute__((ext_vector_type(2)));
template <int ACT, bool I8_ = false> struct EpiBf16 {
    static constexpr bool PERM = true, AFTER_DRAIN = false, I8 = I8_, OFFS = false;
    bf16_t* O; int ldc; const PG8_LAS float* rstab; int tab_pm; const float* part; const bf16_t* zsrc; int zld; const float* qrow; const float* qcol;
    __device__ __forceinline__ void operator()(const f32x4 (&acc)[2][2][4][2], const Unit& u, int wr, int wc, int fr, int fq) const {
        const int row0 = u.pm * BM + wr * 64 + fr; const int col0 = u.pn * BM + wc * 64 + 8 * fq;
        float rs[2][4];
#pragma unroll
        for (int ai = 0; ai < 2; ++ai)
#pragma unroll
            for (int m = 0; m < 4; ++m) { rs[ai][m] = 1.0f;
                if (rstab) { if (u.pm == tab_pm) rs[ai][m] = rstab[ai * HALF + wr * 64 + m * 16 + fr];
                    else if (part) { const f32x4* pp = (const f32x4*)(part + (size_t)(row0 + ai * HALF + m * 16) * 32); float s = 0.f;
#pragma unroll 1
                        for (int j = 0; j < 8; ++j) { const f32x4 t = pp[j]; s += (t[0] + t[1]) + (t[2] + t[3]); }
                        rs[ai][m] = 1.0f / sqrtf(s * (1.0f / 2048.0f) + 1e-6f); if (I8_) rs[ai][m] *= qrow[row0 + ai * HALF + m * 16]; }
                    else rs[ai][m] = zrow_rstd(zsrc + (size_t)(row0 + ai * HALF + m * 16) * zld); } }
#pragma unroll
        for (int ai = 0; ai < 2; ++ai)
#pragma unroll
            for (int m = 0; m < 4; ++m) { bf16_t* rowp = O + (size_t)(row0 + ai * HALF + m * 16) * ldc + col0;
#pragma unroll
                for (int bj = 0; bj < 2; ++bj) { f32x4 v0 = acc[ai][bj][m][0] * rs[ai][m], v1 = acc[ai][bj][m][1] * rs[ai][m];
                    if (ACT == 1) {
#pragma unroll
                        for (int j = 0; j < 4; ++j) { const float a = fmaxf(v0[j], 0.f), b = fmaxf(v1[j], 0.f); v0[j] = a * a; v1[j] = b * b; } }
                    u32x4 w; w.x = cvt_pk_bf16(v0[0], v0[1]); w.y = cvt_pk_bf16(v0[2], v0[3]); w.z = cvt_pk_bf16(v1[0], v1[1]); w.w = cvt_pk_bf16(v1[2], v1[3]);
                    *(u32x4*)(rowp + bj * 32) = w; } }
    }
};
__device__ __forceinline__ unsigned q4u_(float a, float b, float c, float d) { return ((unsigned)((int)__builtin_rintf(a) - 128) & 255u) | (((unsigned)((int)__builtin_rintf(b) - 128) & 255u) << 8) | (((unsigned)((int)__builtin_rintf(c) - 128) & 255u) << 16) | ((unsigned)((int)__builtin_rintf(d) - 128) << 24); }
struct EpiU8 {
    static constexpr bool PERM = true, AFTER_DRAIN = false, I8 = true, OFFS = false;
    unsigned char* O8; float* bs; const PG8_LAS float* rstab; int tab_pm; const float* part; const float* qrow; const float* qcol;
    __device__ __forceinline__ void operator()(const f32x4 (&acc)[2][2][4][2], const Unit& u, int wr, int wc, int fr, int fq) const {
        const int row0 = u.pm * BM + wr * 64 + fr; const int col0 = u.pn * BM + wc * 64 + 8 * fq;
#pragma unroll
        for (int ai = 0; ai < 2; ++ai)
#pragma unroll
            for (int m = 0; m < 4; ++m) { const int row = row0 + ai * HALF + m * 16; float rs;
                if (u.pm == tab_pm) rs = rstab[ai * HALF + wr * 64 + m * 16 + fr];
                else { const f32x4* pp = (const f32x4*)(part + (size_t)row * 32); float s = 0.f;
#pragma unroll 1
                    for (int j = 0; j < 8; ++j) { const f32x4 t = pp[j]; s += (t[0] + t[1]) + (t[2] + t[3]); }
                    rs = (1.0f / sqrtf(s * (1.0f / 2048.0f) + 1e-6f)) * qrow[row]; }
                float h[2][8]; float mx = 0.f;
#pragma unroll
                for (int bj = 0; bj < 2; ++bj)
#pragma unroll
                    for (int j = 0; j < 8; ++j) { const float a = fmaxf(acc[ai][bj][m][j >> 2][j & 3] * rs, 0.f); h[bj][j] = a * a; mx = fmaxf(mx, h[bj][j]); }
                { auto r = __builtin_amdgcn_permlane16_swap(__float_as_uint(mx), __float_as_uint(mx), false, false); mx = fmaxf(__uint_as_float(r[0]), __uint_as_float(r[1])); }
                { auto r = __builtin_amdgcn_permlane32_swap(__float_as_uint(mx), __float_as_uint(mx), false, false); mx = fmaxf(__uint_as_float(r[0]), __uint_as_float(r[1])); }
                const float inv = mx > 0.f ? 255.0f / mx : 0.f;
                unsigned char* rowp = O8 + (size_t)row * 8192 + col0;
#pragma unroll
                for (int bj = 0; bj < 2; ++bj) { u32x2 w; w.x = q4u_(h[bj][0] * inv, h[bj][1] * inv, h[bj][2] * inv, h[bj][3] * inv); w.y = q4u_(h[bj][4] * inv, h[bj][5] * inv, h[bj][6] * inv, h[bj][7] * inv);
                    *(u32x2*)(rowp + bj * 32) = w; }
                if (fq == 0) bs[(size_t)row * 128 + u.pn * 4 + wc] = mx * (1.0f / 255.0f); }
    }
};
struct EpiKV {
    static constexpr bool PERM = true, AFTER_DRAIN = false, I8 = false, OFFS = false;
    bf16_t* KBp; bf16_t* VBp; const PG8_LAS float* rstab; int tab_pm; const bf16_t* zsrc; int zld;
    __device__ __forceinline__ void operator()(const f32x4 (&acc)[2][2][4][2], const Unit& u, int wr, int wc, int fr, int fq) const {
        const int row0 = u.pm * BM + wr * 64 + fr; const int c0 = (wc & 1) * 64 + 8 * fq;
#pragma unroll
        for (int ai = 0; ai < 2; ++ai)
#pragma unroll
            for (int m = 0; m < 4; ++m) { const size_t row = (size_t)(row0 + ai * HALF + m * 16);
                const float rs = (u.pm == tab_pm) ? rstab[ai * HALF + wr * 64 + m * 16 + fr] : zrow_rstd(zsrc + row * zld);
#pragma unroll
                for (int bj = 0; bj < 2; ++bj) { const f32x4 v0 = acc[ai][bj][m][0] * rs, v1 = acc[ai][bj][m][1] * rs;
                    u32x4 w; w.x = cvt_pk_bf16(v0[0], v0[1]); w.y = cvt_pk_bf16(v0[2], v0[3]); w.z = cvt_pk_bf16(v1[0], v1[1]); w.w = cvt_pk_bf16(v1[2], v1[3]);
                    bf16_t* dst = (wc < 2 ? KBp + row * 1536 + u.pn * 192 : VBp + row * 1024 + u.pn * 128) + c0 + bj * 32;
                    *(u32x4*)dst = w; } }
    }
};
__device__ __forceinline__ float bfl(unsigned w) { return __uint_as_float(w << 16); }
__device__ __forceinline__ float bfh(unsigned w) { return __uint_as_float(w & 0xffff0000u); }
template <bool I8_ = false, bool OFFS_ = false> struct EpiResSplitT {
    static constexpr bool PERM = true, AFTER_DRAIN = false, I8 = I8_, OFFS = OFFS_;
    bf16_t* XH; bf16_t* XL; float* part; const float* qrow; const float* qcol; const float* qoff;
    __device__ __forceinline__ void operator()(const f32x4 (&acc)[2][2][4][2], const Unit& u, int wr, int wc, int fr, int fq) const {
        const int row0 = u.pm * BM + wr * 64 + fr, col0 = u.pn * BM + wc * 64 + 8 * fq;
#pragma unroll
        for (int ai = 0; ai < 2; ++ai) { u32x4 hx[4][2];
#pragma unroll
            for (int m = 0; m < 4; ++m)
#pragma unroll
                for (int bj = 0; bj < 2; ++bj) hx[m][bj] = *(const u32x4*)(XH + (size_t)(row0 + ai * HALF + m * 16) * 2048 + col0 + bj * 32);
            float qs[4] = {1.f, 1.f, 1.f, 1.f};
            if (I8_) {
#pragma unroll
                for (int m = 0; m < 4; ++m) qs[m] = qrow[row0 + ai * HALF + m * 16]; }
            asm volatile("" ::: "memory");
#pragma unroll
            for (int m = 0; m < 4; ++m) { const int row = row0 + ai * HALF + m * 16; const size_t off = (size_t)row * 2048 + col0; float ss = 0.f; const float qf = qs[m];
#pragma unroll
                for (int bj = 0; bj < 2; ++bj) { const u32x4 h = hx[m][bj]; u32x4 l = {0u, 0u, 0u, 0u}; if (XL) l = *(const u32x4*)(XL + off + bj * 32);
                    const f32x4 a0 = I8_ ? acc[ai][bj][m][0] * qf : acc[ai][bj][m][0], a1 = I8_ ? acc[ai][bj][m][1] * qf : acc[ai][bj][m][1]; float x[8];
                    x[0] = (bfl(h.x) + bfl(l.x)) + a0[0]; x[1] = (bfh(h.x) + bfh(l.x)) + a0[1]; x[2] = (bfl(h.y) + bfl(l.y)) + a0[2]; x[3] = (bfh(h.y) + bfh(l.y)) + a0[3];
                    x[4] = (bfl(h.z) + bfl(l.z)) + a1[0]; x[5] = (bfh(h.z) + bfh(l.z)) + a1[1]; x[6] = (bfl(h.w) + bfl(l.w)) + a1[2]; x[7] = (bfh(h.w) + bfh(l.w)) + a1[3];
                    ss += ((x[0] * x[0] + x[1] * x[1]) + (x[2] * x[2] + x[3] * x[3])) + ((x[4] * x[4] + x[5] * x[5]) + (x[6] * x[6] + x[7] * x[7]));
                    u32x4 nh; nh.x = cvt_pk_bf16(x[0], x[1]); nh.y = cvt_pk_bf16(x[2], x[3]); nh.z = cvt_pk_bf16(x[4], x[5]); nh.w = cvt_pk_bf16(x[6], x[7]);
                    *(u32x4*)(XH + off + bj * 32) = nh;
                    if (XL) { u32x4 nl; nl.x = cvt_pk_bf16(x[0] - bfl(nh.x), x[1] - bfh(nh.x)); nl.y = cvt_pk_bf16(x[2] - bfl(nh.y), x[3] - bfh(nh.y)); nl.z = cvt_pk_bf16(x[4] - bfl(nh.z), x[5] - bfh(nh.z)); nl.w = cvt_pk_bf16(x[6] - bfl(nh.w), x[7] - bfh(nh.w));
                        *(u32x4*)(XL + off + bj * 32) = nl; } }
                { auto r = __builtin_amdgcn_permlane16_swap(__float_as_uint(ss), __float_as_uint(ss), false, false); ss = __uint_as_float(r[0]) + __uint_as_float(r[1]); }
                { auto r = __builtin_amdgcn_permlane32_swap(__float_as_uint(ss), __float_as_uint(ss), false, false); ss = __uint_as_float(r[0]) + __uint_as_float(r[1]); }
                if (fq == 0) part[(size_t)row * 32 + u.pn * 4 + wc] = ss; }
            asm volatile("" ::: "memory"); }
    }
};
typedef EpiResSplitT<false, false> EpiResSplit;
}

constexpr int NWAVES = 8, NTHR = NWAVES * 64;
constexpr int DM = 2048, BATCH = 4, SEQ = 4096, MTOK = BATCH * SEQ, DEPTH = 4, FF = 8192;
constexpr float NORM_EPS = 1e-6f;
constexpr int NZE = 4352, NZO = 5888;
constexpr int ZE_QLAT = 0, ZE_KVLAT = 512, ZE_QB = 1024, ZE_KB = 2048, ZE_VB = 3072, ZE_KPE = 4096;
constexpr int ZO_QC = 0, ZO_KC = 1536, ZO_VC = 3072, ZO_QD = 4608, ZO_KD = 5632, ZO_VD = 5760;
constexpr int NQMLA = 1536, NKVU = 2048, NCAT_E = 2048, NCAT_O = 1536;

constexpr size_t MiB = 1u << 20;
constexpr size_t WS_CTL = 0, CTL_ZERO_BYTES = 1 * MiB;
constexpr size_t WS_ROPE = 1 * MiB;
constexpr size_t WS_KTN = 2 * MiB + 128 * 1024;
constexpr size_t WS_KM = 2 * MiB;
constexpr size_t WS_LSE = 3 * MiB;
constexpr size_t WS_WUP = 4 * MiB, WS_WDN = 132 * MiB, WS_WINE = 260 * MiB, WS_WUQ = 294 * MiB, WS_WUKV = 297 * MiB, WS_WOUTE = 301 * MiB, WS_WINO = 317 * MiB, WS_WOUTO = 363 * MiB;
constexpr size_t WS_H = 376 * MiB, WS_Z = 440 * MiB, WS_QKVN = 624 * MiB, WS_QMLA = 656 * MiB, WS_KB = 704 * MiB, WS_VB = 752 * MiB, WS_CAT = 784 * MiB, WS_OD = 848 * MiB, WS_XL = 896 * MiB, WS_PA = 960 * MiB, WS_PB = 962 * MiB, WS_END = 964 * MiB;
constexpr size_t WS_XQ = 896 * MiB, WS_CATQ = 928 * MiB;
constexpr size_t WS_XQS = 3 * MiB + 768 * 1024, WS_CATQS = WS_XQS + 65536;
constexpr size_t WS_WQINE = 964 * MiB, WS_WQINO = 980 * MiB, WS_WQOUTE = 1003 * MiB, WS_WQOUTO = 1011 * MiB, WS_END2 = 1018 * MiB;
constexpr size_t WS_CSTEP = 1017 * MiB;
constexpr int CS_INE = 0, CS_INO = 8192, CS_OUTE = 8192 + 11776, CS_OUTO = CS_OUTE + 4096;
constexpr int CW_WMAX = 12288;
constexpr size_t WS_U = 440 * MiB;
static_assert(WS_U + (size_t)MTOK * FF * 2 <= WS_KB && WS_H + (size_t)MTOK * DM * 2 <= WS_Z && WS_Z + (size_t)MTOK * NZO * 2 <= WS_QKVN, "ws map");
constexpr int CW_QUEUE = 8192;
constexpr int CW_BAR = 4096;

constexpr int RING_OFF = 0, RING_BYTES = 131072, QBUF_OFF = 131072, LDSCTL_OFF = 139264, LDS_BYTES = 147456;

#define GAS __attribute__((address_space(1)))
#define LAS __attribute__((address_space(3)))
typedef unsigned short bf16;
typedef unsigned v4u __attribute__((ext_vector_type(4)));
typedef unsigned v2u __attribute__((ext_vector_type(2)));
typedef float f32x4 __attribute__((ext_vector_type(4)));
#define LDS_WAIT() asm volatile("s_waitcnt lgkmcnt(0)" ::: "memory")
#define VM_WAIT() asm volatile("s_waitcnt vmcnt(0)" ::: "memory")
__device__ __forceinline__ unsigned f2bf(float f) { unsigned u = __builtin_bit_cast(unsigned, f); return (u + 0x7fffu + ((u >> 16) & 1u)) >> 16; }
__device__ __forceinline__ unsigned pk2(float lo, float hi) { return f2bf(lo) | (f2bf(hi) << 16); }
__device__ __forceinline__ float bf_lo(unsigned w) { return __uint_as_float(w << 16); }
__device__ __forceinline__ float bf_hi(unsigned w) { return __uint_as_float(w & 0xffff0000u); }
__device__ __forceinline__ float bf1(bf16 b) { return __uint_as_float(((unsigned)b) << 16); }
#define DPP_ADD(v, ctrl) ((v) + __int_as_float(__builtin_amdgcn_update_dpp(0, __float_as_int(v), (ctrl), 0xf, 0xf, false)))
__device__ __forceinline__ float wave_sum_v(float v) {
    v = DPP_ADD(v, 0xB1); v = DPP_ADD(v, 0x4E); v = DPP_ADD(v, 0x141); v = DPP_ADD(v, 0x140);
    { auto r = __builtin_amdgcn_permlane16_swap(__float_as_uint(v), __float_as_uint(v), false, false); v = __uint_as_float(r[0]) + __uint_as_float(r[1]); }
    { auto r = __builtin_amdgcn_permlane32_swap(__float_as_uint(v), __float_as_uint(v), false, false); v = __uint_as_float(r[0]) + __uint_as_float(r[1]); }
    return v;
}
#define DPP_MAX(v, ctrl) fmaxf((v), __int_as_float(__builtin_amdgcn_update_dpp(0, __float_as_int(v), (ctrl), 0xf, 0xf, false)))
__device__ __forceinline__ float wave_max_v(float v) {
    v = DPP_MAX(v, 0xB1); v = DPP_MAX(v, 0x4E); v = DPP_MAX(v, 0x141); v = DPP_MAX(v, 0x140);
    { auto r = __builtin_amdgcn_permlane16_swap(__float_as_uint(v), __float_as_uint(v), false, false); v = fmaxf(__uint_as_float(r[0]), __uint_as_float(r[1])); }
    { auto r = __builtin_amdgcn_permlane32_swap(__float_as_uint(v), __float_as_uint(v), false, false); v = fmaxf(__uint_as_float(r[0]), __uint_as_float(r[1])); }
    return v;
}
__device__ __forceinline__ float shfl_xor_l(float v, int o, int lane) { return __int_as_float(__builtin_amdgcn_ds_bpermute((lane ^ o) << 2, __float_as_int(v))); }
__device__ __forceinline__ float wave_sum_l(float v, int lane) {
#pragma unroll
    for (int o = 1; o < 64; o <<= 1) v += shfl_xor_l(v, o, lane);
    return v;
}
__device__ __forceinline__ float wave_max_l(float v, int lane) {
#pragma unroll
    for (int o = 1; o < 64; o <<= 1) v = fmaxf(v, shfl_xor_l(v, o, lane));
    return v;
}

#define XB_TMO      128
#define XB_XCNT(j)  (256  + 64 * (j))
#define XB_XSUB(j)  (1280 + 64 * (j))
#define XB_XGEN(j)  (2304 + 64 * (j))
#define XB_TOP      3328
#define XB_TOPGEN   3392
#define XCD_BAR_WORDS 3456
#define XB_SPIN_CAP (1u << 22)
__device__ __forceinline__ unsigned xb_ld(unsigned* p)              { return __hip_atomic_load(p, __ATOMIC_RELAXED, __HIP_MEMORY_SCOPE_AGENT); }
__device__ __forceinline__ unsigned xb_add(unsigned* p, unsigned v) { return __hip_atomic_fetch_add(p, v, __ATOMIC_RELAXED, __HIP_MEMORY_SCOPE_AGENT); }
__device__ __forceinline__ unsigned xb_xcc_id() { return (unsigned)__builtin_amdgcn_s_getreg((3 << 11) | 20) & 0xFu; }
#define XB_SPIN(cond, bar) do { unsigned _sp = 0; while (cond) { __builtin_amdgcn_s_sleep(1); \
    if ((++_sp & 255u) == 0u) { if (xb_ld(&(bar)[XB_TMO])) break; if (_sp > XB_SPIN_CAP) { atomicAdd(&(bar)[XB_TMO], 1u); break; } } } } while (0)
struct XcdBarrier { unsigned* bar; unsigned x; volatile LAS unsigned* st; };
__device__ __forceinline__ XcdBarrier xcd_barrier_post(unsigned* bar, volatile LAS unsigned* st) {
    XcdBarrier b; b.bar = bar; b.x = xb_xcc_id(); b.st = st;
    if (threadIdx.x == 0) st[2] = xb_add(&bar[XB_XCNT(b.x)], 1u);
    return b;
}
__device__ __forceinline__ void xcd_barrier_complete(unsigned* bar, unsigned x, unsigned& nloc, unsigned& nx) {
    const unsigned G = gridDim.x * gridDim.y * gridDim.z;
    unsigned sum, cnt, mine, sp = 0u;
    for (;;) {
        sum = 0u; cnt = 0u; mine = 0u;
#pragma unroll
        for (unsigned j = 0; j < 16; ++j) { const unsigned c = xb_ld(&bar[XB_XCNT(j)]); sum += c; cnt += (c > 0u) ? 1u : 0u; mine = (j == x) ? c : mine; }
        if (sum == G) break;
        __builtin_amdgcn_s_sleep(1);
        if ((++sp & 255u) == 0u) { if (xb_ld(&bar[XB_TMO])) break; if (sp > XB_SPIN_CAP) { atomicAdd(&bar[XB_TMO], 1u); break; } }
    }
    nloc = mine > 0u ? mine : 1u; nx = cnt > 0u ? cnt : 1u;
}
__device__ __forceinline__ void xcd_barrier(const XcdBarrier& b) {
    asm volatile("s_waitcnt vmcnt(0)" ::: "memory");
    __syncthreads();
    if (threadIdx.x == 0) {
        unsigned* bar = b.bar;
        __builtin_amdgcn_s_waitcnt(0);
        unsigned nloc = b.st[0], nx = b.st[1];
        if (nloc == 0u) { xcd_barrier_complete(bar, b.x, nloc, nx); b.st[0] = nloc; b.st[1] = nx; }
        const unsigned old = xb_add(&bar[XB_XSUB(b.x)], 1u);
        const unsigned gen = old / nloc;
        if (old + 1u == (gen + 1u) * nloc) {
            __builtin_amdgcn_fence(__ATOMIC_RELEASE, "agent");
            asm volatile("s_waitcnt vmcnt(0)" ::: "memory");
            const unsigned og = xb_add(&bar[XB_TOP], 1u);
            const unsigned tg = og / nx;
            if (og + 1u == (tg + 1u) * nx) xb_add(&bar[XB_TOPGEN], 1u);
            else XB_SPIN(xb_ld(&bar[XB_TOPGEN]) == tg, bar);
            __builtin_amdgcn_fence(__ATOMIC_ACQUIRE, "agent");
            xb_add(&bar[XB_XGEN(b.x)], 1u);
            asm volatile("s_waitcnt vmcnt(0)" ::: "memory");
        } else {
            XB_SPIN(xb_ld(&bar[XB_XGEN(b.x)]) == gen, bar);
            __builtin_amdgcn_fence(__ATOMIC_ACQUIRE, "agent");
            asm volatile("s_waitcnt vmcnt(0)" ::: "memory");
        }
    }
    __syncthreads();
}

struct Args { const float* in[15]; float* out; unsigned char* ws; int ph_lo, ph_hi; };
typedef __attribute__((address_space(4))) const Args* KArgs;
__device__ __forceinline__ KArgs kargs() { KArgs p = (KArgs)__builtin_amdgcn_kernarg_segment_ptr(); asm volatile("" : "+s"(p)); return p; }
__device__ __forceinline__ int tid_now_() { int t = threadIdx.x; asm volatile("" : "+v"(t)); return t; }
struct Env { int lane, wave, gw, NGW, G; };
__device__ __forceinline__ Env make_env() { int tid = threadIdx.x; asm volatile("" : "+v"(tid)); Env e; e.lane = tid & 63; e.wave = __builtin_amdgcn_readfirstlane(tid >> 6); e.G = gridDim.x; e.gw = blockIdx.x * NWAVES + e.wave; e.NGW = e.G * NWAVES; return e; }
enum { I_X = 0, I_ATTN_NORM, I_MLP_NORM, I_WUP, I_WDN, I_EV_WIN, I_EV_QNORM, I_EV_WUQ, I_EV_KVNORM, I_EV_WUKV, I_EV_WOUT, I_OD_WIN, I_OD_SINKS, I_OD_WOUT, I_FINAL_NORM };

#ifndef IN_I8_MASK
#define IN_I8_MASK 14
#endif
#ifndef DN_I8_MASK
#define DN_I8_MASK 14
#endif
#ifndef UP_I8_MASK
#define UP_I8_MASK 14
#endif
struct Job { const float* W; bf16* WT; const float* gain; int K, ldw, scol0, drow0, ncols, qid; };
constexpr int NJOBS = 24;
__device__ __forceinline__ Job make_job(KArgs a, int j) {
    Job J; unsigned char* ws = a->ws; J.gain = nullptr; J.qid = -1;
    if (j < 4) { J.W = a->in[I_WUP] + (size_t)j * DM * FF; J.WT = (bf16*)(ws + WS_WUP) + (size_t)j * FF * DM; J.K = DM; J.ldw = FF; J.scol0 = 0; J.drow0 = 0; J.ncols = ((UP_I8_MASK >> j) & 1) ? 0 : FF; J.gain = a->in[I_MLP_NORM] + j * DM; return J; }
    if (j < 8) { const int l = j - 4; J.W = a->in[I_WDN] + (size_t)l * FF * DM; J.WT = (bf16*)(ws + WS_WDN) + (size_t)l * DM * FF; J.K = FF; J.ldw = DM; J.scol0 = 0; J.drow0 = 0; J.ncols = DM; return J; }
    const int i = (j - 8) >> 3, sub = (j - 8) & 7;
    if (sub < 3) { J.W = a->in[I_EV_WIN] + (size_t)i * DM * 4160; J.WT = (bf16*)(ws + WS_WINE) + (size_t)i * NZE * DM; J.K = DM; J.ldw = 4160; J.gain = a->in[I_ATTN_NORM] + (2 * i) * DM;
        if (sub == 0) { J.scol0 = 0; J.drow0 = 0; J.ncols = 1024; J.qid = i; } else if (sub == 1) { J.scol0 = 1088; J.drow0 = 1024; J.ncols = 3072; J.qid = i; } else { J.scol0 = 1024; J.drow0 = 4096; J.ncols = 64; }
        if (sub < 2 && ((IN_I8_MASK >> (2 * i)) & 1)) J.ncols = 0;
        return J; }
    J.scol0 = 0; J.drow0 = 0;
    if (sub == 3) { J.W = a->in[I_EV_WUQ] + (size_t)i * 512 * NQMLA; J.WT = (bf16*)(ws + WS_WUQ) + (size_t)i * NQMLA * 512; J.K = 512; J.ldw = NQMLA; J.ncols = NQMLA; J.gain = a->in[I_EV_QNORM] + i * 512; return J; }
    if (sub == 4) { J.W = a->in[I_EV_WUKV] + (size_t)i * 512 * NKVU; J.WT = (bf16*)(ws + WS_WUKV) + (size_t)i * NKVU * 512; J.K = 512; J.ldw = NKVU; J.ncols = NKVU; J.gain = a->in[I_EV_KVNORM] + i * 512; return J; }
    if (sub == 5) { J.W = a->in[I_EV_WOUT] + (size_t)i * NCAT_E * DM; J.WT = (bf16*)(ws + WS_WOUTE) + (size_t)i * DM * NCAT_E; J.K = NCAT_E; J.ldw = DM; J.ncols = 0; J.qid = 4 + i; return J; }
    if (sub == 6) { J.W = a->in[I_OD_WIN] + (size_t)i * DM * NZO; J.WT = (bf16*)(ws + WS_WINO) + (size_t)i * NZO * DM; J.K = DM; J.ldw = NZO; J.ncols = NZO; J.gain = a->in[I_ATTN_NORM] + (2 * i + 1) * DM; J.qid = 2 + i; if ((IN_I8_MASK >> (2 * i + 1)) & 1) J.ncols = 0; return J; }
    J.W = a->in[I_OD_WOUT] + (size_t)i * NCAT_O * DM; J.WT = (bf16*)(ws + WS_WOUTO) + (size_t)i * DM * NCAT_O; J.K = NCAT_O; J.ldw = DM; J.ncols = 0; J.qid = 6 + i; return J;
}
__device__ __forceinline__ void tile_load(const Job& J, int item, int lane, f32x4 (&v)[8], unsigned* ctl) {
    const int nblk = J.ncols / 32, kb = item / nblk, nb = item % nblk, k0 = 64 * kb, n0 = 32 * nb;
    const GAS float* W = (const GAS float*)J.W + (size_t)(k0 + (lane >> 3)) * J.ldw + J.scol0 + n0 + 4 * (lane & 7);
#pragma unroll
    for (int i = 0; i < 8; ++i) v[i] = __builtin_nontemporal_load((const GAS f32x4*)(W + (size_t)(8 * i) * J.ldw));
    if (J.gain) {
#pragma unroll
        for (int i = 0; i < 8; ++i) v[i] = v[i] * ((const GAS float*)J.gain)[k0 + 8 * i + (lane >> 3)]; }
}
__device__ __forceinline__ void tile_store(const Job& J, LAS float* scr, int item, int lane, const f32x4 (&v)[8]) {
    const int nblk = J.ncols / 32, kb = item / nblk, nb = item % nblk, k0 = 64 * kb, n0 = 32 * nb;
#pragma unroll
    for (int i = 0; i < 8; ++i) { LAS float* d = scr + (8 * i + (lane >> 3)) * 33 + 4 * (lane & 7); d[0] = v[i][0]; d[1] = v[i][1]; d[2] = v[i][2]; d[3] = v[i][3]; }
    LDS_WAIT(); asm volatile("" ::: "memory");
    const int c = lane & 7;
#pragma unroll
    for (int j = 0; j < 4; ++j) { const int n = (lane >> 3) + 8 * j; const LAS float* s = scr + (8 * c) * 33 + n;
        v4u o; o.x = pk2(s[0 * 33], s[1 * 33]); o.y = pk2(s[2 * 33], s[3 * 33]); o.z = pk2(s[4 * 33], s[5 * 33]); o.w = pk2(s[6 * 33], s[7 * 33]);
        *(GAS v4u*)(J.WT + (size_t)(J.drow0 + n0 + n) * J.K + k0 + 8 * c) = o; }
    LDS_WAIT(); asm volatile("" ::: "memory");
}
__device__ __forceinline__ void prologue_phase(KArgs a, LAS unsigned char* lds, int gw, int NGW, int wave, int lane) {
    LAS float* scr = (LAS float*)(lds + RING_OFF + wave * 16384); unsigned* ctl_ = (unsigned*)(a->ws + WS_CTL);
    int total = 0;
    for (int j = 0; j < NJOBS; ++j) { const Job J = make_job(a, j); total += (J.K / 64) * (J.ncols / 32); }
    int jc = 0, basec = 0; Job Jc = make_job(a, 0); int nitc = (Jc.K / 64) * (Jc.ncols / 32);
#define PRO_LOCATE(gi) do { while ((gi) - basec >= nitc) { basec += nitc; ++jc; Jc = make_job(a, jc); nitc = (Jc.K / 64) * (Jc.ncols / 32); } } while (0)
    f32x4 v[8]; int gi = gw;
    if (gi < total) { PRO_LOCATE(gi); tile_load(Jc, gi - basec, lane, v, ctl_); }
    while (gi < total) {
        const Job Jt = Jc; const int itt = gi - basec; const int gn = gi + NGW;
        f32x4 vn[8];
        if (gn < total) { PRO_LOCATE(gn); tile_load(Jc, gn - basec, lane, vn, ctl_); }
        tile_store(Jt, scr, itt, lane, v);
        if (gn < total) {
#pragma unroll
            for (int i = 0; i < 8; ++i) v[i] = vn[i]; }
        gi = gn;
    }
#undef PRO_LOCATE
    for (int i = 0; i < 2; ++i) { GAS v4u* p = (GAS v4u*)((bf16*)(a->ws + WS_WINE) + (size_t)i * NZE * DM + (size_t)4160 * DM); const int n16 = 192 * DM / 8;
        for (int e = gw * 64 + lane; e < n16; e += NGW * 64) p[e] = (v4u){0u, 0u, 0u, 0u}; }
    { GAS float* ct = (GAS float*)(a->ws + WS_ROPE); GAS float* st = ct + SEQ * 32;
        for (int e = gw * 64 + lane; e < SEQ * 32; e += NGW * 64) { const int pos = e >> 5, i = e & 31; const double inv = exp2(-(double)i * (13.287712379549449 / 32.0)); const double ang = (double)pos * inv;
            ct[e] = (float)cos(ang); st[e] = (float)sin(ang); } }
}

__device__ __forceinline__ void init_phase(const float* X, bf16* XH, bf16* XL, float* PB, int gw, int NGW, int lane) {
    f32x4 v[8];
    if (gw < MTOK) { const GAS f32x4* xr = (const GAS f32x4*)(X + (size_t)gw * DM) + lane;
#pragma unroll
        for (int j = 0; j < 8; ++j) v[j] = xr[64 * j]; }
    for (int m = gw; m < MTOK; m += NGW) {
        f32x4 vn[8]; const int mn = m + NGW < MTOK ? m + NGW : m;
        { const GAS f32x4* xr = (const GAS f32x4*)(X + (size_t)mn * DM) + lane;
#pragma unroll
          for (int j = 0; j < 8; ++j) vn[j] = xr[64 * j]; }
        float s = 0.f;
#pragma unroll
        for (int j = 0; j < 8; ++j) s += (v[j].x * v[j].x + v[j].y * v[j].y) + (v[j].z * v[j].z + v[j].w * v[j].w);
        s = wave_sum_v(s);
        GAS v2u* oh = (GAS v2u*)(XH + (size_t)m * DM) + lane; GAS v2u* ol = (GAS v2u*)(XL + (size_t)m * DM) + lane;
#pragma unroll
        for (int j = 0; j < 8; ++j) { v2u h; h.x = pk2(v[j].x, v[j].y); h.y = pk2(v[j].z, v[j].w);
            v2u l; l.x = pk2(v[j].x - bf_lo(h.x), v[j].y - bf_hi(h.x)); l.y = pk2(v[j].z - bf_lo(h.y), v[j].w - bf_hi(h.y)); oh[64 * j] = h; if (XL) ol[64 * j] = l; }
        if (lane < 32) ((GAS float*)PB)[(size_t)m * 32 + lane] = lane == 0 ? s : 0.f;
#pragma unroll
        for (int j = 0; j < 8; ++j) v[j] = vn[j];
    }
}
__device__ __forceinline__ void final_norm_phase(const bf16* XH, const bf16* XL, float* out, const float* g, int gw, int NGW, int lane) {
    f32x4 gv[8];
#pragma unroll
    for (int j = 0; j < 8; ++j) gv[j] = ((const GAS f32x4*)g)[64 * j + lane];
    v2u hc[8];
    if (gw < MTOK) { const GAS v2u* ph = (const GAS v2u*)(XH + (size_t)gw * DM) + lane;
#pragma unroll
        for (int j = 0; j < 8; ++j) hc[j] = ph[64 * j]; }
    for (int m = gw; m < MTOK; m += NGW) {
        v2u hn[8]; const int mn = m + NGW < MTOK ? m + NGW : m;
        { const GAS v2u* ph = (const GAS v2u*)(XH + (size_t)mn * DM) + lane;
#pragma unroll
          for (int j = 0; j < 8; ++j) hn[j] = ph[64 * j]; }
        const GAS v2u* pl = (const GAS v2u*)(XL + (size_t)m * DM) + lane;
        f32x4 v[8]; float s = 0.f;
#pragma unroll
        for (int j = 0; j < 8; ++j) { const v2u h = hc[j]; v2u l = {0u, 0u}; if (XL) l = pl[64 * j]; v[j].x = bf_lo(h.x) + bf_lo(l.x); v[j].y = bf_hi(h.x) + bf_hi(l.x); v[j].z = bf_lo(h.y) + bf_lo(l.y); v[j].w = bf_hi(h.y) + bf_hi(l.y);
            s += (v[j].x * v[j].x + v[j].y * v[j].y) + (v[j].z * v[j].z + v[j].w * v[j].w); }
        const float rstd = 1.0f / sqrtf(wave_sum_v(s) * (1.f / DM) + NORM_EPS);
        GAS f32x4* xo = (GAS f32x4*)(out + (size_t)m * DM) + lane;
#pragma unroll
        for (int j = 0; j < 8; ++j) xo[64 * j] = v[j] * rstd * gv[j];
#pragma unroll
        for (int j = 0; j < 8; ++j) hc[j] = hn[j];
    }
}
__device__ __forceinline__ unsigned q4(float a, float b, float c, float d) { return ((unsigned)(int)__builtin_rintf(a) & 255u) | (((unsigned)(int)__builtin_rintf(b) & 255u) << 8) | (((unsigned)(int)__builtin_rintf(c) & 255u) << 16) | ((unsigned)(int)__builtin_rintf(d) << 24); }
template <int NCH>
__device__ __forceinline__ void quant_rows(const bf16* src, int ld, signed char* dst, float* step, int nrows, int gw, int NGW, int lane) {
    v4u c[NCH];
    if (gw < nrows) { const GAS v4u* ps = (const GAS v4u*)(src + (size_t)gw * ld) + lane;
#pragma unroll
        for (int j = 0; j < NCH; ++j) c[j] = ps[64 * j]; }
    for (int m = gw; m < nrows; m += NGW) {
        v4u n[NCH]; const int mn = m + NGW < nrows ? m + NGW : m;
        { const GAS v4u* ps = (const GAS v4u*)(src + (size_t)mn * ld) + lane;
#pragma unroll
          for (int j = 0; j < NCH; ++j) n[j] = ps[64 * j]; }
        float mx = 0.f;
#pragma unroll
        for (int j = 0; j < NCH; ++j) mx = fmaxf(mx, fmaxf(fmaxf(fmaxf(fabsf(bf_lo(c[j].x)), fabsf(bf_hi(c[j].x))), fmaxf(fabsf(bf_lo(c[j].y)), fabsf(bf_hi(c[j].y)))), fmaxf(fmaxf(fabsf(bf_lo(c[j].z)), fabsf(bf_hi(c[j].z))), fmaxf(fabsf(bf_lo(c[j].w)), fabsf(bf_hi(c[j].w))))));
        mx = wave_max_v(mx);
        const float inv = mx > 0.f ? 127.0f / mx : 0.f;
        GAS v2u* pd = (GAS v2u*)(dst + (size_t)m * (NCH * 512)) + lane;
#pragma unroll
        for (int j = 0; j < NCH; ++j) { v2u o; o.x = q4(bf_lo(c[j].x) * inv, bf_hi(c[j].x) * inv, bf_lo(c[j].y) * inv, bf_hi(c[j].y) * inv); o.y = q4(bf_lo(c[j].z) * inv, bf_hi(c[j].z) * inv, bf_lo(c[j].w) * inv, bf_hi(c[j].w) * inv); pd[64 * j] = o; }
        if (lane == 0) ((GAS float*)step)[m] = mx * (1.0f / 127.0f);
#pragma unroll
        for (int j = 0; j < NCH; ++j) c[j] = n[j];
    }
}
template <int NCH>
__device__ __forceinline__ void quant_weight(const bf16* src, int ld, signed char* dst, float* cstep, int nrows, int gw, int NGW, int lane) {
    for (int m = gw; m < nrows; m += NGW) { const GAS v4u* ps = (const GAS v4u*)(src + (size_t)m * ld) + lane; GAS v2u* pd = (GAS v2u*)(dst + (size_t)m * (NCH * 512)) + lane; v4u c[NCH];
#pragma unroll
        for (int j = 0; j < NCH; ++j) c[j] = ps[64 * j];
        float mx = 0.f;
#pragma unroll
        for (int j = 0; j < NCH; ++j) mx = fmaxf(mx, fmaxf(fmaxf(fmaxf(fabsf(bf_lo(c[j].x)), fabsf(bf_hi(c[j].x))), fmaxf(fabsf(bf_lo(c[j].y)), fabsf(bf_hi(c[j].y)))), fmaxf(fmaxf(fabsf(bf_lo(c[j].z)), fabsf(bf_hi(c[j].z))), fmaxf(fabsf(bf_lo(c[j].w)), fabsf(bf_hi(c[j].w))))));
        mx = wave_max_v(mx);
        const float inv = mx > 0.f ? 127.0f / mx : 0.f;
#pragma unroll
        for (int j = 0; j < NCH; ++j) { v2u o; o.x = q4(bf_lo(c[j].x) * inv, bf_hi(c[j].x) * inv, bf_lo(c[j].y) * inv, bf_hi(c[j].y) * inv); o.y = q4(bf_lo(c[j].z) * inv, bf_hi(c[j].z) * inv, bf_lo(c[j].w) * inv, bf_hi(c[j].w) * inv); pd[64 * j] = o; }
        if (lane == 0) ((GAS float*)cstep)[m] = mx * (1.0f / 127.0f); }
}
struct SJob { const float* W; const float* gain; signed char* dst; float* cstep; int K, ldw, scol0, drow0, ncols; };
constexpr int NSJOBS = 14;
__device__ __forceinline__ SJob make_sjob(KArgs a, int j) {
    SJob J; unsigned char* ws = a->ws; J.W = nullptr; J.gain = nullptr; J.dst = nullptr; J.cstep = nullptr; J.K = DM; J.ldw = DM; J.scol0 = 0; J.drow0 = 0; J.ncols = 0;
    float* cst = (float*)(ws + WS_CSTEP);
    if (j < 4) { if ((UP_I8_MASK >> j) & 1) { J.W = a->in[I_WUP] + (size_t)j * DM * FF; J.gain = a->in[I_MLP_NORM] + j * DM; J.dst = (signed char*)(ws + WS_WUP) + (size_t)j * FF * DM * 2; J.cstep = (float*)(J.dst + (size_t)FF * DM); J.ldw = FF; J.ncols = FF; } return J; }
    const int i = (j - 4) / 5, sub = (j - 4) % 5;
    if (sub < 2) { if ((IN_I8_MASK >> (2 * i)) & 1) { J.W = a->in[I_EV_WIN] + (size_t)i * DM * 4160; J.gain = a->in[I_ATTN_NORM] + (2 * i) * DM; J.dst = (signed char*)(ws + WS_WQINE) + (size_t)i * 4096 * DM; J.cstep = cst + CS_INE + i * 4096; J.ldw = 4160;
                       if (sub == 0) { J.scol0 = 0; J.drow0 = 0; J.ncols = 1024; } else { J.scol0 = 1088; J.drow0 = 1024; J.ncols = 3072; } } return J; }
    if (sub == 2) { if ((IN_I8_MASK >> (2 * i + 1)) & 1) { J.W = a->in[I_OD_WIN] + (size_t)i * DM * NZO; J.gain = a->in[I_ATTN_NORM] + (2 * i + 1) * DM; J.dst = (signed char*)(ws + WS_WQINO) + (size_t)i * NZO * DM; J.cstep = cst + CS_INO + i * NZO; J.ldw = NZO; J.ncols = NZO; } return J; }
    if (sub == 3) { J.W = a->in[I_EV_WOUT] + (size_t)i * NCAT_E * DM; J.dst = (signed char*)(ws + WS_WQOUTE) + (size_t)i * DM * NCAT_E; J.cstep = cst + CS_OUTE + i * DM; J.K = NCAT_E; J.ncols = DM; return J; }
    J.W = a->in[I_OD_WOUT] + (size_t)i * NCAT_O * DM; J.dst = (signed char*)(ws + WS_WQOUTO) + (size_t)i * DM * NCAT_O; J.cstep = cst + CS_OUTO + i * DM; J.K = NCAT_O; J.ncols = DM; return J;
}
__device__ __forceinline__ void slab_quant(const SJob& J, int slab, LAS unsigned char* lds, int tid) {
    constexpr int PD = 1026;
    LAS unsigned* T = (LAS unsigned*)(lds + RING_OFF); LAS float* wmax = (LAS float*)(T + 32 * PD);
    const int n0 = 32 * slab, c4 = tid & 7, rp = tid >> 3, wave = __builtin_amdgcn_readfirstlane(tid >> 6), lane = tid & 63;
    const GAS float* W = (const GAS float*)J.W + (size_t)(2 * rp) * J.ldw + J.scol0 + n0 + 4 * c4;
    float mx0 = 0.f, mx1 = 0.f, mx2 = 0.f, mx3 = 0.f;
#pragma unroll 1
    for (int bt = 0; bt < J.K / 512; ++bt) {
        f32x4 v[4][2]; float g[4][2];
#pragma unroll
        for (int it = 0; it < 4; ++it) { const GAS float* p = W + (size_t)(bt * 512 + it * 128) * J.ldw; v[it][0] = __builtin_nontemporal_load((const GAS f32x4*)p); v[it][1] = __builtin_nontemporal_load((const GAS f32x4*)(p + J.ldw)); }
#pragma unroll
        for (int it = 0; it < 4; ++it) { const int k = bt * 512 + it * 128 + 2 * rp; g[it][0] = J.gain ? ((const GAS float*)J.gain)[k] : 1.f; g[it][1] = J.gain ? ((const GAS float*)J.gain)[k + 1] : 1.f; }
#pragma unroll
        for (int it = 0; it < 4; ++it) { const int kd = bt * 256 + it * 64 + rp;
            const unsigned d0 = pk2(v[it][0][0] * g[it][0], v[it][1][0] * g[it][1]), d1 = pk2(v[it][0][1] * g[it][0], v[it][1][1] * g[it][1]), d2 = pk2(v[it][0][2] * g[it][0], v[it][1][2] * g[it][1]), d3 = pk2(v[it][0][3] * g[it][0], v[it][1][3] * g[it][1]);
            T[(4 * c4 + 0) * PD + kd] = d0; T[(4 * c4 + 1) * PD + kd] = d1; T[(4 * c4 + 2) * PD + kd] = d2; T[(4 * c4 + 3) * PD + kd] = d3;
            mx0 = fmaxf(mx0, fmaxf(fabsf(bf_lo(d0)), fabsf(bf_hi(d0)))); mx1 = fmaxf(mx1, fmaxf(fabsf(bf_lo(d1)), fabsf(bf_hi(d1)))); mx2 = fmaxf(mx2, fmaxf(fabsf(bf_lo(d2)), fabsf(bf_hi(d2)))); mx3 = fmaxf(mx3, fmaxf(fabsf(bf_lo(d3)), fabsf(bf_hi(d3)))); }
    }
#pragma unroll
    for (int o = 8; o < 64; o <<= 1) { mx0 = fmaxf(mx0, __shfl_xor(mx0, o)); mx1 = fmaxf(mx1, __shfl_xor(mx1, o)); mx2 = fmaxf(mx2, __shfl_xor(mx2, o)); mx3 = fmaxf(mx3, __shfl_xor(mx3, o)); }
    if (lane < 8) { wmax[wave * 32 + 4 * lane + 0] = mx0; wmax[wave * 32 + 4 * lane + 1] = mx1; wmax[wave * 32 + 4 * lane + 2] = mx2; wmax[wave * 32 + 4 * lane + 3] = mx3; }
    __syncthreads();
#pragma unroll 1
    for (int cc = 0; cc < 4; ++cc) { const int col = 4 * wave + cc; float mx = 0.f;
#pragma unroll
        for (int w2 = 0; w2 < 8; ++w2) mx = fmaxf(mx, wmax[w2 * 32 + col]);
        const float inv = mx > 0.f ? 127.0f / mx : 0.f; const int n = J.drow0 + n0 + col; GAS v2u* pd = (GAS v2u*)(J.dst + (size_t)n * J.K) + lane;
#pragma unroll 1
        for (int ch = 0; ch < J.K / 512; ++ch) { const LAS v2u* sp = (const LAS v2u*)(T + col * PD + ch * 256 + lane * 4); const v2u x = sp[0], y = sp[1];
            v2u o; o.x = q4(bf_lo(x.x) * inv, bf_hi(x.x) * inv, bf_lo(x.y) * inv, bf_hi(x.y) * inv); o.y = q4(bf_lo(y.x) * inv, bf_hi(y.x) * inv, bf_lo(y.y) * inv, bf_hi(y.y) * inv); pd[64 * ch] = o; }
        if (lane == 0) ((GAS float*)J.cstep)[n] = mx * (1.0f / 127.0f); }
    __syncthreads();
}
__device__ __forceinline__ void slab_phase(KArgs a, LAS unsigned char* lds, int tid) {
    int total = 0;
    for (int j = 0; j < NSJOBS; ++j) total += make_sjob(a, j).ncols / 32;
#pragma unroll 1
    for (int s = blockIdx.x; s < total; s += gridDim.x) { int j = 0, base = 0; SJob J = make_sjob(a, 0);
        while (s - base >= J.ncols / 32) { base += J.ncols / 32; ++j; J = make_sjob(a, j); }
        slab_quant(J, s - base, lds, tid); }
}
__device__ __forceinline__ unsigned q4u(float a, float b, float c, float d) { return ((unsigned)((int)__builtin_rintf(a) - 128) & 255u) | (((unsigned)((int)__builtin_rintf(b) - 128) & 255u) << 8) | (((unsigned)((int)__builtin_rintf(c) - 128) & 255u) << 16) | ((unsigned)((int)__builtin_rintf(d) - 128) << 24); }
__device__ __forceinline__ void quant_hidden(bf16* U, float* step, int gw, int NGW, int lane) {
    for (int m = gw; m < MTOK; m += NGW) { const GAS v4u* ps = (const GAS v4u*)(U + (size_t)m * FF) + lane; v4u c[16];
#pragma unroll
        for (int j = 0; j < 16; ++j) c[j] = ps[64 * j];
        float mx = 0.f;
#pragma unroll
        for (int j = 0; j < 16; ++j) mx = fmaxf(mx, fmaxf(fmaxf(fmaxf(bf_lo(c[j].x), bf_hi(c[j].x)), fmaxf(bf_lo(c[j].y), bf_hi(c[j].y))), fmaxf(fmaxf(bf_lo(c[j].z), bf_hi(c[j].z)), fmaxf(bf_lo(c[j].w), bf_hi(c[j].w)))));
        mx = wave_max_v(mx);
        const float inv = mx > 0.f ? 255.0f / mx : 0.f;
        asm volatile("s_waitcnt vmcnt(0)" ::: "memory");
        GAS v2u* pd = (GAS v2u*)((signed char*)(U + (size_t)m * FF)) + lane;
#pragma unroll
        for (int j = 0; j < 16; ++j) { v2u o; o.x = q4u(bf_lo(c[j].x) * inv, bf_hi(c[j].x) * inv, bf_lo(c[j].y) * inv, bf_hi(c[j].y) * inv); o.y = q4u(bf_lo(c[j].z) * inv, bf_hi(c[j].z) * inv, bf_lo(c[j].w) * inv, bf_hi(c[j].w) * inv); pd[64 * j] = o; }
        if (lane == 0) ((GAS float*)step)[m] = mx * (1.0f / 255.0f); }
}
__device__ __forceinline__ unsigned rq4(unsigned w, float ratio) {
    const float a = (float)((int)(signed char)(w & 255u) + 128) * ratio, b = (float)((int)(signed char)((w >> 8) & 255u) + 128) * ratio, c = (float)((int)(signed char)((w >> 16) & 255u) + 128) * ratio, d = (float)((int)(signed char)(w >> 24) + 128) * ratio;
    return q4u(a, b, c, d); }
__device__ __forceinline__ void requant_hidden(unsigned char* U8, const float* bs, float* step, int gw, int NGW, int lane) {
    for (int m = gw; m < MTOK; m += NGW) { GAS v4u* ps = (GAS v4u*)(U8 + (size_t)m * 8192) + lane; const GAS float* bp = (const GAS float*)bs + (size_t)m * 128; v4u c[8]; float bsv[8];
#pragma unroll
        for (int j = 0; j < 8; ++j) { c[j] = ps[64 * j]; bsv[j] = bp[j * 16 + (lane >> 2)]; }
        float mx = fmaxf(bp[lane], bp[64 + lane]);
        mx = wave_max_v(mx);
        const float inv = mx > 0.f ? 1.0f / mx : 0.f;
#pragma unroll
        for (int j = 0; j < 8; ++j) { const float ratio = bsv[j] * inv; v4u o; o.x = rq4(c[j].x, ratio); o.y = rq4(c[j].y, ratio); o.z = rq4(c[j].z, ratio); o.w = rq4(c[j].w, ratio); ps[64 * j] = o; }
        if (lane == 0) ((GAS float*)step)[m] = mx; }
}
__device__ __forceinline__ int q1i(float a) { return (int)__builtin_rintf(a); }
__device__ __forceinline__ void quant_weight_dn(const bf16* src, signed char* dst, float* cstep, float* coff, int gw, int NGW, int lane) {
    for (int m = gw; m < DM; m += NGW) { const GAS v4u* ps = (const GAS v4u*)(src + (size_t)m * FF) + lane; GAS v2u* pd = (GAS v2u*)(dst + (size_t)m * FF) + lane; v4u c[16];
#pragma unroll
        for (int j = 0; j < 16; ++j) c[j] = ps[64 * j];
        float mx = 0.f;
#pragma unroll
        for (int j = 0; j < 16; ++j) mx = fmaxf(mx, fmaxf(fmaxf(fmaxf(fabsf(bf_lo(c[j].x)), fabsf(bf_hi(c[j].x))), fmaxf(fabsf(bf_lo(c[j].y)), fabsf(bf_hi(c[j].y)))), fmaxf(fmaxf(fabsf(bf_lo(c[j].z)), fabsf(bf_hi(c[j].z))), fmaxf(fabsf(bf_lo(c[j].w)), fabsf(bf_hi(c[j].w))))));
        mx = wave_max_v(mx);
        const float inv = mx > 0.f ? 127.0f / mx : 0.f; float sum = 0.f;
#pragma unroll
        for (int j = 0; j < 16; ++j) { const int q0 = q1i(bf_lo(c[j].x) * inv), q1 = q1i(bf_hi(c[j].x) * inv), q2 = q1i(bf_lo(c[j].y) * inv), q3 = q1i(bf_hi(c[j].y) * inv), q4_ = q1i(bf_lo(c[j].z) * inv), q5 = q1i(bf_hi(c[j].z) * inv), q6 = q1i(bf_lo(c[j].w) * inv), q7 = q1i(bf_hi(c[j].w) * inv);
            sum += (float)(((q0 + q1) + (q2 + q3)) + ((q4_ + q5) + (q6 + q7)));
            v2u o; o.x = ((unsigned)q0 & 255u) | (((unsigned)q1 & 255u) << 8) | (((unsigned)q2 & 255u) << 16) | ((unsigned)q3 << 24); o.y = ((unsigned)q4_ & 255u) | (((unsigned)q5 & 255u) << 8) | (((unsigned)q6 & 255u) << 16) | ((unsigned)q7 << 24); pd[64 * j] = o; }
        sum = wave_sum_v(sum);
        if (lane == 0) { ((GAS float*)cstep)[m] = mx * (1.0f / 127.0f); ((GAS float*)coff)[m] = 128.0f * sum; } }
}
__device__ __forceinline__ void prep_rstab_z(const bf16* Zc, int zld, int pm, LAS float* rstab, int tid) {
    const int wave = __builtin_amdgcn_readfirstlane(tid >> 6), lane = tid & 63;
#pragma unroll 1
    for (int hf = 0; hf < 2; ++hf) { v4u w[16];
#pragma unroll
        for (int i = 0; i < 16; ++i) w[i] = *(const GAS v4u*)(Zc + (size_t)(pm * 256 + wave * 32 + hf * 16 + i) * zld + lane * 8);
#pragma unroll
        for (int i = 0; i < 16; ++i) { const v4u x = w[i];
            float s = ((bf_lo(x.x) * bf_lo(x.x) + bf_hi(x.x) * bf_hi(x.x)) + (bf_lo(x.y) * bf_lo(x.y) + bf_hi(x.y) * bf_hi(x.y))) + ((bf_lo(x.z) * bf_lo(x.z) + bf_hi(x.z) * bf_hi(x.z)) + (bf_lo(x.w) * bf_lo(x.w) + bf_hi(x.w) * bf_hi(x.w)));
            s = wave_sum_v(s);
            if (lane == 0) rstab[wave * 32 + hf * 16 + i] = 1.0f / sqrtf(s * (1.f / 512) + NORM_EPS); } }
    __syncthreads();
}
__device__ __forceinline__ void prep_rstab(const float* part, int pm, LAS float* rstab, int tid) {
    const int row = tid >> 1, half = tid & 1; const GAS f32x4* pp = (const GAS f32x4*)(part + (size_t)(pm * 256 + row) * 32 + half * 16);
    const f32x4 a = pp[0], b = pp[1], c = pp[2], d = pp[3];
    float s = (((a[0] + a[1]) + (a[2] + a[3])) + ((b[0] + b[1]) + (b[2] + b[3]))) + (((c[0] + c[1]) + (c[2] + c[3])) + ((d[0] + d[1]) + (d[2] + d[3])));
    s = DPP_ADD(s, 0xB1);
    if (half == 0) rstab[row] = 1.0f / sqrtf(s * (1.f / DM) + NORM_EPS);
    __syncthreads();
}
__device__ __forceinline__ void prep_rstab_q(const float* part, const float* qrow, int pm, LAS float* rstab, int tid) {
    const int row = tid >> 1, half = tid & 1; const GAS f32x4* pp = (const GAS f32x4*)(part + (size_t)(pm * 256 + row) * 32 + half * 16);
    const f32x4 a = pp[0], b = pp[1], c = pp[2], d = pp[3];
    float s = (((a[0] + a[1]) + (a[2] + a[3])) + ((b[0] + b[1]) + (b[2] + b[3]))) + (((c[0] + c[1]) + (c[2] + c[3])) + ((d[0] + d[1]) + (d[2] + d[3])));
    s = DPP_ADD(s, 0xB1);
    if (half == 0) rstab[row] = (1.0f / sqrtf(s * (1.f / DM) + NORM_EPS)) * ((const GAS float*)qrow)[pm * 256 + row];
    __syncthreads();
}
__device__ __forceinline__ void latent_phase(KArgs a, int ev, LAS unsigned char* lds, int gw, int NGW, int wave, int lane) {
    const bf16* Z = (const bf16*)(a->ws + WS_Z); bf16* KBp = (bf16*)(a->ws + WS_KB); bf16* KM = (bf16*)(a->ws + WS_KM);
    const GAS float* ct = (const GAS float*)(a->ws + WS_ROPE); const GAS float* st = ct + SEQ * 32;
    { typedef short bf16x8_t __attribute__((ext_vector_type(8))); typedef float f32x16_t __attribute__((ext_vector_type(16)));
      const bf16* Hb = (const bf16*)(a->ws + WS_H); const float* PBp = (const float*)(a->ws + WS_PB);     const bf16* Wpe = (const bf16*)(a->ws + WS_WINE) + (size_t)ev * NZE * DM + (size_t)4096 * DM;
      LAS float* red = (LAS float*)(lds + RING_OFF);
      const int r32 = lane & 31, hi = lane >> 5;
      for (int chunk = blockIdx.x; chunk < MTOK / 32; chunk += gridDim.x) { const int row0 = chunk * 32;
          f32x16_t c0 = {}, c1 = {};
          const bf16* ap = Hb + (size_t)(row0 + r32) * DM + wave * 256 + hi * 8; const bf16* bp0 = Wpe + (size_t)r32 * DM + wave * 256 + hi * 8; const bf16* bp1 = bp0 + (size_t)32 * DM;
#pragma unroll
          for (int ks = 0; ks < 16; ++ks) { const bf16x8_t av = *(const GAS bf16x8_t*)(ap + ks * 16), b0 = *(const GAS bf16x8_t*)(bp0 + ks * 16), b1 = *(const GAS bf16x8_t*)(bp1 + ks * 16);
              c0 = __builtin_amdgcn_mfma_f32_32x32x16_bf16(av, b0, c0, 0, 0, 0); c1 = __builtin_amdgcn_mfma_f32_32x32x16_bf16(av, b1, c1, 0, 0, 0); }
#pragma unroll
          for (int r = 0; r < 16; ++r) { red[(wave * 32 + r) * 64 + lane] = c0[r]; red[(wave * 32 + 16 + r) * 64 + lane] = c1[r]; }
          __syncthreads();
#pragma unroll
          for (int rr = 0; rr < 2; ++rr) { const int r = 2 * wave + rr; float x1 = 0.f, x2 = 0.f;
#pragma unroll
              for (int w = 0; w < 8; ++w) { x1 += red[(w * 32 + r) * 64 + lane]; x2 += red[(w * 32 + 16 + r) * 64 + lane]; }
              const int tok = row0 + (r & 3) + 8 * (r >> 2) + 4 * hi, pos = tok & (SEQ - 1); const float c = ct[pos * 32 + r32], s = st[pos * 32 + r32];
              { float ssq = ((const GAS float*)PBp)[(size_t)tok * 32 + r32];
                ssq = DPP_ADD(ssq, 0xB1); ssq = DPP_ADD(ssq, 0x4E); ssq = DPP_ADD(ssq, 0x141); ssq = DPP_ADD(ssq, 0x140);
                { auto rr2 = __builtin_amdgcn_permlane16_swap(__float_as_uint(ssq), __float_as_uint(ssq), false, false); ssq = __uint_as_float(rr2[0]) + __uint_as_float(rr2[1]); }
                const float rstd = 1.0f / sqrtf(ssq * (1.f / DM) + NORM_EPS); x1 *= rstd; x2 *= rstd; }
              const bf16 o1 = (bf16)f2bf(x1 * c - x2 * s), o2 = (bf16)f2bf(x2 * c + x1 * s);
#pragma unroll
              for (int h = 0; h < 8; ++h) { ((GAS bf16*)KBp)[(size_t)tok * 1536 + h * 192 + 128 + r32] = o1; ((GAS bf16*)KBp)[(size_t)tok * 1536 + h * 192 + 160 + r32] = o2; } }
          __syncthreads(); } }
    { float* KTN = (float*)(a->ws + WS_KTN);
      for (int t = gw; t < BATCH * 8 * 64; t += NGW) { const int tile = t & 63, h = (t >> 6) & 7, b = t >> 9;
          const bf16* kp = Z + (size_t)(b * SEQ + tile * 64 + lane) * NZE + ZE_KB + h * 128; float s = 0.f;
#pragma unroll
          for (int c = 0; c < 16; ++c) { const v4u w = *(const GAS v4u*)(kp + c * 8);
              s += bf_lo(w.x) * bf_lo(w.x) + bf_hi(w.x) * bf_hi(w.x) + bf_lo(w.y) * bf_lo(w.y) + bf_hi(w.y) * bf_hi(w.y) + bf_lo(w.z) * bf_lo(w.z) + bf_hi(w.z) * bf_hi(w.z) + bf_lo(w.w) * bf_lo(w.w) + bf_hi(w.w) * bf_hi(w.w); }
          s = wave_max_v(s);
          if (lane == 0) KTN[(size_t)(b * 8 + h) * 64 + tile] = sqrtf(s) * 1.0001f; } }
    { LAS float* red = (LAS float*)(lds + RING_OFF);
      const int rr = lane >> 4, cc = lane & 15;
      for (int st = gw; st < BATCH * 16 * 8 * 4; st += NGW) { const int t = st >> 2, sub = st & 3, h = t & 7, n = (t >> 3) & 15, b = t >> 7;
          const bf16* kp = Z + (size_t)(b * SEQ + n * 256 + sub * 64 + rr) * NZE + ZE_KB + h * 128 + cc * 8; v4u w[16];
#pragma unroll
          for (int i = 0; i < 16; ++i) w[i] = *(const GAS v4u*)(kp + (size_t)(4 * i) * NZE);
          float s[8] = {0.f, 0.f, 0.f, 0.f, 0.f, 0.f, 0.f, 0.f};
#pragma unroll
          for (int i = 0; i < 16; ++i) { s[0] += bf_lo(w[i].x); s[1] += bf_hi(w[i].x); s[2] += bf_lo(w[i].y); s[3] += bf_hi(w[i].y); s[4] += bf_lo(w[i].z); s[5] += bf_hi(w[i].z); s[6] += bf_lo(w[i].w); s[7] += bf_hi(w[i].w); }
#pragma unroll
          for (int j = 0; j < 8; ++j) {
              { auto r = __builtin_amdgcn_permlane16_swap(__float_as_uint(s[j]), __float_as_uint(s[j]), false, false); s[j] = __uint_as_float(r[0]) + __uint_as_float(r[1]); }
              { auto r = __builtin_amdgcn_permlane32_swap(__float_as_uint(s[j]), __float_as_uint(s[j]), false, false); s[j] = __uint_as_float(r[0]) + __uint_as_float(r[1]); } }
          if (rr == 0) {
#pragma unroll
              for (int j = 0; j < 8; ++j) red[wave * 128 + cc * 8 + j] = s[j]; }
          __syncthreads();
          if (sub == 0) { const float m0 = (red[wave * 128 + lane * 2] + red[(wave + 1) * 128 + lane * 2]) + (red[(wave + 2) * 128 + lane * 2] + red[(wave + 3) * 128 + lane * 2]);
              const float m1 = (red[wave * 128 + lane * 2 + 1] + red[(wave + 1) * 128 + lane * 2 + 1]) + (red[(wave + 2) * 128 + lane * 2 + 1] + red[(wave + 3) * 128 + lane * 2 + 1]);
              *(GAS unsigned*)(KM + ((size_t)((b * 8 + h) * 16 + n)) * 128 + lane * 2) = pk2(m0 * (1.f / 256), m1 * (1.f / 256)); }
          __syncthreads(); } }
}
__device__ __forceinline__ void qrope_phase(KArgs a, int gw, int NGW, int lane) {
    GAS bf16* Q = (GAS bf16*)(a->ws + WS_QMLA); const GAS float* ct = (const GAS float*)(a->ws + WS_ROPE); const GAS float* st = ct + SEQ * 32;
    for (int m = gw; m < MTOK; m += NGW) { const int pos = m & (SEQ - 1);
#pragma unroll
        for (int e = 0; e < 4; ++e) { const int p = e * 64 + lane, h = p >> 5, i = p & 31; GAS bf16* qp = Q + (size_t)m * NQMLA + h * 192 + 128 + i;
            const float x1 = bf1(qp[0]), x2 = bf1(qp[32]), c = ct[pos * 32 + i], s = st[pos * 32 + i];
            qp[0] = (bf16)f2bf(x1 * c - x2 * s); qp[32] = (bf16)f2bf(x2 * c + x1 * s); } }
}

__device__ __forceinline__ float dot8(const LAS float* q, v4u w) {
    return q[0] * bf_lo(w.x) + q[1] * bf_hi(w.x) + q[2] * bf_lo(w.y) + q[3] * bf_hi(w.y) + q[4] * bf_lo(w.z) + q[5] * bf_hi(w.z) + q[6] * bf_lo(w.w) + q[7] * bf_hi(w.w);
}
__device__ __forceinline__ float dot_row(const LAS float* q, const bf16* k, int n) { float s = 0.f; for (int c = 0; c < n; c += 8) s += dot8(q + c, *(const GAS v4u*)(k + c)); return s; }
__device__ __forceinline__ void load_q(LAS float* qs, const bf16* q, int n, int lane) { for (int c = lane; c < n; c += 64) qs[c] = bf1(((const GAS bf16*)q)[c]); LDS_WAIT(); asm volatile("" ::: "memory"); }
__device__ __forceinline__ float softmax_lds(LAS float* sc, int n, int lane, bool has_sink, float sink, float& lse) {
    float mx = has_sink ? sink : -__builtin_inff();
    for (int j = lane; j < n; j += 64) mx = fmaxf(mx, sc[j]);
    mx = wave_max_l(mx, lane); float sum = 0.f;
    for (int j = lane; j < n; j += 64) { const float p = __expf(sc[j] - mx); sc[j] = p; sum += p; }
    sum = wave_sum_l(sum, lane); if (has_sink) sum += __expf(sink - mx);
    LDS_WAIT(); asm volatile("" ::: "memory");
    lse = mx + __logf(sum);
    return 1.0f / sum;
}
__device__ __forceinline__ void naive_even_attn(KArgs a, LAS unsigned char* lds, int gw, int NGW, int wave, int lane) {
    LAS float* sc = (LAS float*)(lds + RING_OFF + wave * 16384); LAS float* qs = (LAS float*)(lds + QBUF_OFF + wave * 1024);
    const bf16* Z = (const bf16*)(a->ws + WS_Z); const bf16* QM = (const bf16*)(a->ws + WS_QMLA); const bf16* KBp = (const bf16*)(a->ws + WS_KB); const bf16* VBp = (const bf16*)(a->ws + WS_VB); const bf16* KM = (const bf16*)(a->ws + WS_KM);
    bf16* CAT = (bf16*)(a->ws + WS_CAT);
    for (int task = gw; task < MTOK * 16; task += NGW) {
        const int hh = task & 15, row = task >> 4, b = row >> 12, t = row & (SEQ - 1); float lse;
        if (hh < 8) {
            const int h = hh; load_q(qs, QM + (size_t)row * NQMLA + h * 192, 192, lane);
            const float scale = 0.07216878364870322f;
            for (int j = lane; j <= t; j += 64) { const size_t kr = (size_t)(b * SEQ + j);
                sc[j] = dot_row(qs, KBp + kr * 1536 + h * 192, 192) * scale; }
            LDS_WAIT(); asm volatile("" ::: "memory");
            const float inv = softmax_lds(sc, t + 1, lane, false, 0.f, lse);
            float o0 = 0.f, o1 = 0.f; const bf16* vp = VBp + (size_t)(b * SEQ) * 1024 + h * 128 + lane * 2;
            for (int j = 0; j <= t; ++j) { const unsigned w = *(const GAS unsigned*)(vp + (size_t)j * 1024); const float p = sc[j]; o0 += p * bf_lo(w); o1 += p * bf_hi(w); }
            *(GAS unsigned*)(CAT + (size_t)row * NCAT_E + h * 128 + lane * 2) = pk2(o0 * inv, o1 * inv);
        } else {
            const int h = hh - 8, own = t >> 8; load_q(qs, Z + (size_t)row * NZE + ZE_QB + h * 128, 128, lane);
            float g = -__builtin_inff();
            if (lane < own) g = dot_row(qs, KM + ((size_t)((b * 8 + h) * 16 + lane)) * 128, 128);
            int sel[4]; int nsel = 0;
#pragma unroll
            for (int r = 0; r < 3; ++r) { const float mx = wave_max_l(g, lane); const unsigned long long bal = __ballot(g == mx && mx > -__builtin_inff());
                if (bal) { const int idx = __builtin_ctzll(bal); sel[r] = idx; if (lane == idx) g = -__builtin_inff(); nsel = r + 1; } else sel[r] = -1; }
            sel[3] = own;
            const float scale = 0.08838834764831845f, slope = exp2f(-(float)(h + 1));
#pragma unroll
            for (int r = 0; r < 4; ++r) { const int n = sel[r];
                for (int jj = lane; jj < 256; jj += 64) { float s = -__builtin_inff();
                    if (n >= 0) { const int kpos = n * 256 + jj; if (kpos <= t) s = dot_row(qs, Z + (size_t)(b * SEQ + kpos) * NZE + ZE_KB + h * 128, 128) * scale - slope * (float)(t - kpos); }
                    sc[r * 256 + jj] = s; } }
            LDS_WAIT(); asm volatile("" ::: "memory");
            const float inv = softmax_lds(sc, 1024, lane, false, 0.f, lse);
            float o0 = 0.f, o1 = 0.f;
#pragma unroll
            for (int r = 0; r < 4; ++r) { const int n = sel[r]; if (n < 0) continue;
                const bf16* vp = Z + (size_t)(b * SEQ + n * 256) * NZE + ZE_VB + h * 128 + lane * 2; const int lim = (n == own) ? (t - n * 256 + 1) : 256;
                for (int jj = 0; jj < lim; ++jj) { const unsigned w = *(const GAS unsigned*)(vp + (size_t)jj * NZE); const float p = sc[r * 256 + jj]; o0 += p * bf_lo(w); o1 += p * bf_hi(w); } }
            *(GAS unsigned*)(CAT + (size_t)row * NCAT_E + 1024 + h * 128 + lane * 2) = pk2(o0 * inv, o1 * inv);
            (void)nsel;
        }
    }
}
__device__ __forceinline__ void naive_odd_attn(KArgs a, int od, LAS unsigned char* lds, int gw, int NGW, int wave, int lane) {
    LAS float* sc = (LAS float*)(lds + RING_OFF + wave * 16384); LAS float* qs = (LAS float*)(lds + QBUF_OFF + wave * 1024);
    const bf16* Z = (const bf16*)(a->ws + WS_Z); bf16* CAT = (bf16*)(a->ws + WS_CAT); bf16* OD = (bf16*)(a->ws + WS_OD); float* LSE = (float*)(a->ws + WS_LSE);
    const float* sinks = a->in[I_OD_SINKS] + od * 16;
    for (int task = gw; task < MTOK * 28; task += NGW) {
        const int row = task / 28, hh = task - row * 28, b = row >> 12, t = row & (SEQ - 1); float lse;
        if (hh < 12) {
            const int g = hh >> 2, j4 = hh & 3, dil = (g == 0) ? 1 : (g == 1 ? 4 : 16);
            load_q(qs, Z + (size_t)row * NZO + ZO_QC + hh * 128, 128, lane);
            const float scale = 0.08838834764831845f, slope = exp2f(-8.0f * (float)(hh + 1) / 12.0f);
            for (int k = lane; k < 129; k += 64) { const int kpos = t - dil * k; float s = -__builtin_inff();
                if (kpos >= 0) s = dot_row(qs, Z + (size_t)(b * SEQ + kpos) * NZO + ZO_KC + hh * 128, 128) * scale - slope * (float)(dil * k);
                sc[k] = s; }
            LDS_WAIT(); asm volatile("" ::: "memory");
            const float inv = softmax_lds(sc, 129, lane, false, 0.f, lse);
            float o0 = 0.f, o1 = 0.f;
            for (int k = 0; k < 129; ++k) { const int kpos = t - dil * k; if (kpos < 0) break;
                const unsigned w = *(const GAS unsigned*)(Z + (size_t)(b * SEQ + kpos) * NZO + ZO_VC + hh * 128 + lane * 2); const float p = sc[k]; o0 += p * bf_lo(w); o1 += p * bf_hi(w); }
            *(GAS unsigned*)(OD + ((size_t)g * MTOK + row) * 512 + j4 * 128 + lane * 2) = pk2(o0 * inv, o1 * inv);
            if (lane == 0) LSE[((size_t)g * MTOK + row) * 4 + j4] = lse;
        } else {
            const int hq = hh - 12, kvh = hq >> 3; load_q(qs, Z + (size_t)row * NZO + ZO_QD + hq * 64, 64, lane);
            const float scale = 0.125f, slope = exp2f(-0.5f * (float)(hq + 1)), sink = sinks[hq];
            for (int k = lane; k < 128; k += 64) { const int kpos = t - k; float s = -__builtin_inff();
                if (kpos >= 0) s = dot_row(qs, Z + (size_t)(b * SEQ + kpos) * NZO + ZO_KD + kvh * 64, 64) * scale - slope * (float)k;
                sc[k] = s; }
            LDS_WAIT(); asm volatile("" ::: "memory");
            const float inv = softmax_lds(sc, 128, lane, true, sink, lse);
            float o0 = 0.f;
            for (int k = 0; k < 128; ++k) { const int kpos = t - k; if (kpos < 0) break;
                o0 += sc[k] * bf1(((const GAS bf16*)Z)[(size_t)(b * SEQ + kpos) * NZO + ZO_VD + kvh * 64 + lane]); }
            ((GAS bf16*)CAT)[(size_t)row * NCAT_O + 512 + hq * 64 + lane] = (bf16)f2bf(o0 * inv);
        }
    }
}
__device__ __forceinline__ void merge_quant_phase(KArgs a, int gw, int NGW, int lane) {
    const bf16* OD = (const bf16*)(a->ws + WS_OD); const float* LSE = (const float*)(a->ws + WS_LSE); const bf16* CAT = (const bf16*)(a->ws + WS_CAT);
    signed char* CQ = (signed char*)(a->ws + WS_CATQ); float* CS = (float*)(a->ws + WS_CATQS);
    const int j4 = lane >> 4;
    for (int rb = gw; rb < MTOK; rb += 4 * NGW) {
        float ls[4][3]; v4u av[4][3], sw[4][2];
#pragma unroll
        for (int k = 0; k < 4; ++k) { const int row = rb + k * NGW < MTOK ? rb + k * NGW : rb;
#pragma unroll
            for (int g = 0; g < 3; ++g) { ls[k][g] = ((const GAS float*)LSE)[((size_t)g * MTOK + row) * 4 + j4]; av[k][g] = *(const GAS v4u*)(OD + ((size_t)g * MTOK + row) * 512 + lane * 8); }
            sw[k][0] = *(const GAS v4u*)(CAT + (size_t)row * NCAT_O + 512 + lane * 8); sw[k][1] = *(const GAS v4u*)(CAT + (size_t)row * NCAT_O + 1024 + lane * 8); }
#pragma unroll
        for (int k = 0; k < 4; ++k) { const int row = rb + k * NGW; if (row >= MTOK) break;
            const float l0 = ls[k][0], l1 = ls[k][1], l2 = ls[k][2]; const v4u a0 = av[k][0], a1 = av[k][1], a2 = av[k][2];
            const float mxl = fmaxf(l0, fmaxf(l1, l2)); float w0 = __expf(l0 - mxl), w1 = __expf(l1 - mxl), w2 = __expf(l2 - mxl); const float invw = 1.0f / (w0 + w1 + w2); w0 *= invw; w1 *= invw; w2 *= invw;
            float x[24];
            x[0] = w0 * bf_lo(a0.x) + w1 * bf_lo(a1.x) + w2 * bf_lo(a2.x); x[1] = w0 * bf_hi(a0.x) + w1 * bf_hi(a1.x) + w2 * bf_hi(a2.x);
            x[2] = w0 * bf_lo(a0.y) + w1 * bf_lo(a1.y) + w2 * bf_lo(a2.y); x[3] = w0 * bf_hi(a0.y) + w1 * bf_hi(a1.y) + w2 * bf_hi(a2.y);
            x[4] = w0 * bf_lo(a0.z) + w1 * bf_lo(a1.z) + w2 * bf_lo(a2.z); x[5] = w0 * bf_hi(a0.z) + w1 * bf_hi(a1.z) + w2 * bf_hi(a2.z);
            x[6] = w0 * bf_lo(a0.w) + w1 * bf_lo(a1.w) + w2 * bf_lo(a2.w); x[7] = w0 * bf_hi(a0.w) + w1 * bf_hi(a1.w) + w2 * bf_hi(a2.w);
#pragma unroll
            for (int c = 0; c < 2; ++c) { const v4u s = sw[k][c]; x[8 + 8 * c + 0] = bf_lo(s.x); x[8 + 8 * c + 1] = bf_hi(s.x); x[8 + 8 * c + 2] = bf_lo(s.y); x[8 + 8 * c + 3] = bf_hi(s.y);
                x[8 + 8 * c + 4] = bf_lo(s.z); x[8 + 8 * c + 5] = bf_hi(s.z); x[8 + 8 * c + 6] = bf_lo(s.w); x[8 + 8 * c + 7] = bf_hi(s.w); }
            float mx = 0.f;
#pragma unroll
            for (int i = 0; i < 24; ++i) mx = fmaxf(mx, fabsf(x[i]));
            mx = wave_max_v(mx);
            const float inv = mx > 0.f ? 127.0f / mx : 0.f;
            GAS v2u* pd = (GAS v2u*)(CQ + (size_t)row * NCAT_O) + lane;
#pragma unroll
            for (int c = 0; c < 3; ++c) { v2u o; o.x = q4(x[8 * c] * inv, x[8 * c + 1] * inv, x[8 * c + 2] * inv, x[8 * c + 3] * inv); o.y = q4(x[8 * c + 4] * inv, x[8 * c + 5] * inv, x[8 * c + 6] * inv, x[8 * c + 7] * inv); pd[64 * c] = o; }
            if (lane == 0) ((GAS float*)CS)[row] = mx * (1.0f / 127.0f); } }
}

#ifndef PROBE_DUP_DN
#define PROBE_DUP_DN 0
#endif
#ifndef PROBE_DUP_UP
#define PROBE_DUP_UP 0
#endif
#ifndef PROBE_DUP_EVATT
#define PROBE_DUP_EVATT 0
#endif
#ifndef PROBE_DUP_PRO
#define PROBE_DUP_PRO 0
#endif
#ifndef FAST_EVEN
#define FAST_EVEN 1
#endif
#ifndef FAST_ODD
#define FAST_ODD 1
#endif


namespace fa {
typedef short bf16x8 __attribute__((ext_vector_type(8)));
typedef short s16x4 __attribute__((ext_vector_type(4)));
typedef float f32x16 __attribute__((ext_vector_type(16)));
typedef unsigned u32x4 __attribute__((ext_vector_type(4)));
enum { MODE_CAUSAL = 0, MODE_MOBA = 1, MODE_BAND_LSE = 2, MODE_BAND_SINK = 3 };
struct Desc {
    const bf16* q; long q_rs;
    const bf16* k; long k_rs;
    const bf16* v; long v_rs;
    bf16* o; long o_rs;
    float* lse; long lse_rs;
    const bf16* km;
    const float* rope;
    const float* ktn;
    int q0, t_lo, t_hi, W, own;
    float c2, slc, sink2;
};
typedef float f32x2_t __attribute__((ext_vector_type(2))); typedef __bf16 bf16x2_t __attribute__((ext_vector_type(2)));
__device__ __forceinline__ unsigned cvtpk(float lo, float hi) { const f32x2_t v = {lo, hi}; const bf16x2_t b = __builtin_convertvector(v, bf16x2_t); return __builtin_bit_cast(unsigned, b); }
__device__ __forceinline__ int v_rd_base(int lane) { return ((lane & 3) << 3) | (((lane >> 2) & 3) << 6) | (((lane >> 4) & 1) << 5) | (((lane >> 5) & 1) << 8); }
template <int NCG> __device__ __forceinline__ int v_st(int k, int c) { const int kk = (k & ~0xC) | ((k & 4) << 1) | ((k & 8) >> 1); return ((kk >> 3) * NCG + (c >> 5)) * 512 + ((kk & 7) * 32 + (c & 31)) * 2; }

template <int DQK, int DV, int MODE>
__device__ __forceinline__ void attn_unit(const Desc& D, LAS unsigned char* lds, int tid) {
    constexpr int KPITCH = DQK * 2, SHM_K = 64 * KPITCH, SHM_V = 64 * DV * 2, NCG = DV / 32, NKS = DQK / 16, ND0 = DV / 32;
    constexpr int KCH = DQK / 8, NKC = 64 * KCH / 512, VCH = DV / 8, NVC = 64 * VCH / 512;
    constexpr int NOPE = (DQK >= 128) ? 128 : 0, ROPE = DQK - NOPE, NOPE_SLOTS = 64 * (NOPE / 8), NOPE_BYTES = 64 * NOPE * 2, NKS_N = NOPE / 16;
    static_assert(ROPE == 0 || ROPE == 64, "K tile images");
    constexpr int OFF_V = 0, OFF_K = 2 * SHM_V, OFF_G = 2 * SHM_V + 2 * SHM_K;
    constexpr bool BIAS = (MODE != MODE_CAUSAL);
    constexpr float THR2 = 11.0f;
    const int wid = __builtin_amdgcn_readfirstlane(tid >> 6), lane = tid & 63, r32 = lane & 31, hi = lane >> 5;
    const int grp = wid >> 2;
    const float NEG = -__builtin_inff();
    unsigned kgo[NKC], vgo[NVC];
#pragma unroll
    for (int i = 0; i < NKC; ++i) { const int s = (i * 8 + wid) * 64 + lane; int row, ch;
        if (s < NOPE_SLOTS) { row = s >> 4; ch = (s & 15) ^ (row & 15); }
        else { const int s2 = s - NOPE_SLOTS; row = s2 >> 3; ch = NOPE / 8 + ((s2 & 7) ^ ((row >> 1) & 7)); }
        kgo[i] = (unsigned)(row * (int)D.k_rs + ch * 8) * 2u; }
#pragma unroll
    for (int i = 0; i < NVC; ++i) { const int s = (i * 8 + wid) * 64 + lane, sub = s >> 5, kk = (sub / NCG) * 8 + ((s & 31) >> 2), c = (sub % NCG) * 32 + (s & 3) * 8, k = (kk & ~0xC) | ((kk & 4) << 1) | ((kk & 8) >> 1);
        vgo[i] = (unsigned)(k * (int)D.v_rs + c) * 2u; }
#define FA_TI(s) ((MODE == MODE_MOBA) ? (D.t_hi - 1 - (s)) : (D.t_lo + (s)))
#define FA_LOADK(s) do { const char* kt_ = (const char*)D.k + (size_t)FA_TI(s) * 64 * D.k_rs * 2; \
        _Pragma("unroll") for (int i = 0; i < NKC; ++i) __builtin_amdgcn_global_load_lds((const unsigned*)(kt_ + kgo[i]), (LAS unsigned*)(lds + OFF_K + ((s) & 1) * SHM_K + (i * 8 + wid) * 1024), 16, 0, 0); } while (0)
#define FA_LOADV(s) do { const char* vt_ = (const char*)D.v + (size_t)FA_TI(s) * 64 * D.v_rs * 2; \
        _Pragma("unroll") for (int i = 0; i < NVC; ++i) __builtin_amdgcn_global_load_lds((const unsigned*)(vt_ + vgo[i]), (LAS unsigned*)(lds + OFF_V + ((s) & 1) * SHM_V + (i * 8 + wid) * 1024), 16, 0, 0); } while (0)
    FA_LOADK(0); FA_LOADV(0);
    const int qi = D.q0 + wid * 32 + r32;
    bf16x8 qr[NKS];
    { const bf16* qp = D.q + (long)qi * D.q_rs + hi * 8;
#pragma unroll
      for (int d0 = 0; d0 < NKS; ++d0) qr[d0] = *(const GAS bf16x8*)(qp + d0 * 16); }
    if constexpr (MODE == MODE_CAUSAL && DQK == 192) {
#pragma unroll
        for (int dd = 0; dd < 2; ++dd) { const float* cp = D.rope + (size_t)qi * 32 + dd * 16 + hi * 8; const float* sp = cp + SEQ * 32;
            const f32x4 c0 = *(const GAS f32x4*)cp, c1 = *(const GAS f32x4*)(cp + 4), s0 = *(const GAS f32x4*)sp, s1 = *(const GAS f32x4*)(sp + 4);
            const float cc[8] = {c0[0], c0[1], c0[2], c0[3], c1[0], c1[1], c1[2], c1[3]}, ss[8] = {s0[0], s0[1], s0[2], s0[3], s1[0], s1[1], s1[2], s1[3]};
            const u32x4 a = __builtin_bit_cast(u32x4, qr[8 + dd]), b = __builtin_bit_cast(u32x4, qr[10 + dd]); u32x4 oa, ob;
#pragma unroll
            for (int w = 0; w < 4; ++w) { const float x1l = bf_lo(a[w]), x1h = bf_hi(a[w]), x2l = bf_lo(b[w]), x2h = bf_hi(b[w]);
                oa[w] = pk2(x1l * cc[2 * w] - x2l * ss[2 * w], x1h * cc[2 * w + 1] - x2h * ss[2 * w + 1]);
                ob[w] = pk2(x2l * cc[2 * w] + x1l * ss[2 * w], x2h * cc[2 * w + 1] + x1h * ss[2 * w + 1]); }
            qr[8 + dd] = __builtin_bit_cast(bf16x8, oa); qr[10 + dd] = __builtin_bit_cast(bf16x8, ob); }
    }
    const int qlo = D.q0 + wid * 32;
    float qn = 0.f;
    if constexpr (MODE == MODE_MOBA) {
#pragma unroll
        for (int d0 = 0; d0 < NKS; ++d0) { const u32x4 w = __builtin_bit_cast(u32x4, qr[d0]);
#pragma unroll
            for (int e = 0; e < 4; ++e) { const float lo = bf_lo(w[e]), hh = bf_hi(w[e]); qn = fmaf(lo, lo, fmaf(hh, hh, qn)); } }
        { auto rr = __builtin_amdgcn_permlane32_swap(__float_as_uint(qn), __float_as_uint(qn), false, false); qn = __uint_as_float(rr[0]) + __uint_as_float(rr[1]); }
        qn = sqrtf(qn) * 1.0001f;
    }
    const int kbN = r32 * 256, mmN = hi ^ (r32 & 15), kbR = NOPE_BYTES + r32 * 128, mmR = hi ^ ((r32 >> 1) & 7);
#define FA_KADDR(d0) (((d0) < NKS_N) ? (kbN + (((2 * (d0)) ^ mmN) << 4)) : (kbR + (((2 * ((d0) - NKS_N)) ^ mmR) << 4)))
#define FA_KHALF(d0) (((d0) < NKS_N) ? 32 * 256 : 32 * 128)
    constexpr int KPF = 3;
    const unsigned kb_lds = (unsigned)(uintptr_t)(lds + OFF_K);
#define FA_KRD2(R, base, d) do { const unsigned a_ = (base) + (unsigned)FA_KADDR(d); asm volatile("ds_read_b128 %0, %1" : "=v"(R[0]) : "v"(a_) : "memory"); \
        if ((d) < NKS_N) asm volatile("ds_read_b128 %0, %1 offset:8192" : "=v"(R[1]) : "v"(a_) : "memory"); else asm volatile("ds_read_b128 %0, %1 offset:4096" : "=v"(R[1]) : "v"(a_) : "memory"); } while (0)
    const int vb0 = (int)(unsigned)(uintptr_t)(lds + OFF_V) + v_rd_base(lane);

    unsigned selmask = 0u;
    if constexpr (MODE == MODE_MOBA) {
        if (D.own > 0) {
            if (tid < 256) { const int row = tid >> 4, ch = tid & 15; *(LAS bf16x8*)(lds + OFF_G + row * 256 + ((ch ^ (row & 15)) << 4)) = *(const GAS bf16x8*)(D.km + row * 128 + ch * 8); }
            __syncthreads();
            f32x16 gp = {};
#pragma unroll
            for (int d0 = 0; d0 < 8; ++d0) { const bf16x8 kf = *(const LAS bf16x8*)(lds + OFF_G + r32 * 256 + (((2 * d0) ^ hi ^ (r32 & 15)) << 4)); gp = __builtin_amdgcn_mfma_f32_32x32x16_bf16(kf, qr[d0], gp, 0, 0, 0); }
            float g[16];
#pragma unroll
            for (int r = 0; r < 8; ++r) { const unsigned x = __float_as_uint(gp[r]); auto sw = __builtin_amdgcn_permlane32_swap(x, x, false, false);
                g[(r & 3) + 8 * (r >> 2)] = __uint_as_float(sw[0]); g[(r & 3) + 8 * (r >> 2) + 4] = __uint_as_float(sw[1]); }
#pragma unroll
            for (int n = 0; n < 16; ++n) if (n >= D.own) g[n] = NEG;
#pragma unroll
            for (int pass = 0; pass < 3; ++pass) { float best = NEG; int bi = -1;
#pragma unroll
                for (int n = 0; n < 16; ++n) if (g[n] > best) { best = g[n]; bi = n; }
                if (bi >= 0) selmask |= 1u << bi;
#pragma unroll
                for (int n = 0; n < 16; ++n) if (n == bi) g[n] = NEG; }
        }
    }

    float m_reg = -1e30f, l_reg = 0.f; f32x16 o[ND0];
#pragma unroll
    for (int d0 = 0; d0 < ND0; ++d0) o[d0] = f32x16{};
    const int NT = D.t_hi - D.t_lo;
#define FA_TILE_FLAGS(t) const int buf = (t) & 1, kbase = FA_TI(t) * 64; bool act, need_mask; bool lane_sel = true; \
        if constexpr (MODE == MODE_MOBA) { const int n_ = kbase >> 8; \
            if (n_ < D.own) { const float ktm_ = D.ktn[kbase >> 6]; const float bnd_ = fmaf(qn * D.c2, ktm_, -D.slc * (float)(qi - kbase - 63)) + 1.0f; \
                lane_sel = ((selmask >> n_) & 1u) && (bnd_ - m_reg >= -151.0f); act = __any(lane_sel); need_mask = false; } \
            else { act = kbase <= qlo + 31; need_mask = kbase + 63 > qlo; } } \
        else { act = (kbase <= qlo + 31) && (kbase + 63 >= qlo - D.W + 1); need_mask = (kbase + 63 > qlo) || (kbase < qlo + 31 - D.W + 1); } \
        (void)buf; (void)need_mask; (void)lane_sel
#define FA_H1(t) do { FA_TILE_FLAGS(t); tact = act; if (act) { \
        p0 = f32x16{}; p1 = f32x16{}; \
        { const unsigned kbuf_ = kb_lds + (unsigned)(buf * SHM_K); bf16x8 kf[KPF][2];     \
          _Pragma("unroll") for (int j = 0; j < KPF; ++j) if (j < NKS) FA_KRD2(kf[j], kbuf_, j); \
          _Pragma("unroll") for (int d0 = 0; d0 < NKS; ++d0) { \
              const int rem_ = (NKS - 1 - d0) < (KPF - 1) ? (NKS - 1 - d0) : (KPF - 1); \
              if (rem_ >= 2) FA_LW(4); else if (rem_ == 1) FA_LW(2); else FA_LW(0); \
              p0 = __builtin_amdgcn_mfma_f32_32x32x16_bf16(kf[d0 % KPF][0], qr[d0], p0, 0, 0, 0); \
              p1 = __builtin_amdgcn_mfma_f32_32x32x16_bf16(kf[d0 % KPF][1], qr[d0], p1, 0, 0, 0); \
              if (d0 + KPF < NKS) FA_KRD2(kf[d0 % KPF], kbuf_, d0 + KPF); } } \
        const int dq = qi - kbase - 4 * hi;     \
        if constexpr (BIAS) { const float b0_ = -(float)dq * D.slc; \
            _Pragma("unroll") for (int r = 0; r < 16; ++r) { const float c = (float)((r & 3) + 8 * (r >> 2)); p0[r] = fmaf(p0[r], D.c2, fmaf(c, D.slc, b0_)); p1[r] = fmaf(p1[r], D.c2, fmaf(c + 32.f, D.slc, b0_)); } } \
          \
        if (need_mask) { _Pragma("unroll") for (int r = 0; r < 16; ++r) { const int c = (r & 3) + 8 * (r >> 2); \
            if ((unsigned)(dq - c) >= (unsigned)D.W) p0[r] = NEG; if ((unsigned)(dq - c - 32) >= (unsigned)D.W) p1[r] = NEG; } } \
        if constexpr (MODE == MODE_MOBA) { if (!lane_sel) { _Pragma("unroll") for (int r = 0; r < 16; ++r) { p0[r] = NEG; p1[r] = NEG; } } } \
        float pmax = p0[0]; \
        _Pragma("unroll") for (int r = 1; r < 16; ++r) pmax = fmaxf(pmax, p0[r]); \
        _Pragma("unroll") for (int r = 0; r < 16; ++r) pmax = fmaxf(pmax, p1[r]); \
        { auto rr = __builtin_amdgcn_permlane32_swap(__float_as_uint(pmax), __float_as_uint(pmax), false, false); pmax = fmaxf(__uint_as_float(rr[0]), __uint_as_float(rr[1])); } \
        if constexpr (!BIAS) pmax *= D.c2; \
        if (!__all(pmax - m_reg <= THR2)) {     \
            const float mn = fmaxf(m_reg, pmax), alpha = __builtin_amdgcn_exp2f(m_reg - mn); m_reg = mn; l_reg *= alpha; \
            _Pragma("unroll") for (int d0 = 0; d0 < ND0; ++d0) _Pragma("unroll") for (int r = 0; r < 16; ++r) o[d0][r] *= alpha; } \
          \
        _Pragma("unroll") for (int r = 0; r < 16; ++r) p0[r] = BIAS ? __builtin_amdgcn_exp2f(p0[r] - m_reg) : __builtin_amdgcn_exp2f(fmaf(p0[r], D.c2, -m_reg)); } } while (0)
#define FA_PK4(P, B_, OUT) do { const unsigned a0 = cvtpk(P[B_ + 0], P[B_ + 1]), a1 = cvtpk(P[B_ + 2], P[B_ + 3]), b0 = cvtpk(P[B_ + 4], P[B_ + 5]), b1 = cvtpk(P[B_ + 6], P[B_ + 7]); \
        auto r0 = __builtin_amdgcn_permlane32_swap(a0, b0, false, false); auto r1 = __builtin_amdgcn_permlane32_swap(a1, b1, false, false); \
        u32x4 w = {r0[0], r1[0], r0[1], r1[1]}; OUT = __builtin_bit_cast(bf16x8, w); } while (0)
#define FA_TR(dst, off) asm volatile("ds_read_b64_tr_b16 %0, %1 offset:%2" : "=&v"(dst) : "v"(vb), "i"(off) : "memory")
#define FA_TR8(S, d0) do { constexpr int b_ = (d0) * 512; FA_TR(S##l0, b_); FA_TR(S##h0, b_ + NCG * 512); FA_TR(S##l1, b_ + NCG * 1024); FA_TR(S##h1, b_ + NCG * 1536); \
        FA_TR(S##l2, b_ + NCG * 2048); FA_TR(S##h2, b_ + NCG * 2560); FA_TR(S##l3, b_ + NCG * 3072); FA_TR(S##h3, b_ + NCG * 3584); } while (0)
#define FA_MM4(S, d0) do { \
        o[d0] = __builtin_amdgcn_mfma_f32_32x32x16_bf16((bf16x8){S##l0[0], S##l0[1], S##l0[2], S##l0[3], S##h0[0], S##h0[1], S##h0[2], S##h0[3]}, pa0, o[d0], 0, 0, 0); \
        o[d0] = __builtin_amdgcn_mfma_f32_32x32x16_bf16((bf16x8){S##l1[0], S##l1[1], S##l1[2], S##l1[3], S##h1[0], S##h1[1], S##h1[2], S##h1[3]}, pa1, o[d0], 0, 0, 0); \
        o[d0] = __builtin_amdgcn_mfma_f32_32x32x16_bf16((bf16x8){S##l2[0], S##l2[1], S##l2[2], S##l2[3], S##h2[0], S##h2[1], S##h2[2], S##h2[3]}, pa2, o[d0], 0, 0, 0); \
        o[d0] = __builtin_amdgcn_mfma_f32_32x32x16_bf16((bf16x8){S##l3[0], S##l3[1], S##l3[2], S##l3[3], S##h3[0], S##h3[1], S##h3[2], S##h3[3]}, pa3, o[d0], 0, 0, 0); } while (0)
#define FA_LW(n) do { asm volatile("s_waitcnt lgkmcnt(%0)" :: "i"(n) : "memory"); __builtin_amdgcn_sched_barrier(0); } while (0)
#define FA_TRP(L0, H0, L1, H1, d0, j0) do { constexpr int b_ = (d0) * 512 + NCG * 512 * (2 * (j0)); FA_TR(L0, b_); FA_TR(H0, b_ + NCG * 512); FA_TR(L1, b_ + NCG * 1024); FA_TR(H1, b_ + NCG * 1536); } while (0)
#define FA_MM2(L0, H0, L1, H1, d0, PA, PB) do { \
        o[d0] = __builtin_amdgcn_mfma_f32_32x32x16_bf16((bf16x8){L0[0], L0[1], L0[2], L0[3], H0[0], H0[1], H0[2], H0[3]}, PA, o[d0], 0, 0, 0); \
        o[d0] = __builtin_amdgcn_mfma_f32_32x32x16_bf16((bf16x8){L1[0], L1[1], L1[2], L1[3], H1[0], H1[1], H1[2], H1[3]}, PB, o[d0], 0, 0, 0); } while (0)
#define FA_E4(B_) do { _Pragma("unroll") for (int r = (B_); r < (B_) + 4; ++r) { p1[r] = BIAS ? __builtin_amdgcn_exp2f(p1[r] - m_reg) : __builtin_amdgcn_exp2f(fmaf(p1[r], D.c2, -m_reg)); ps += p0[r] + p1[r]; } } while (0)
#define FA_H2(t) do { const int buf = (t) & 1; if (tact) { \
        const int vb = vb0 + buf * SHM_V; constexpr int W_ = ND0 > 2 ? 12 : 4; \
        s16x4 Al0, Al1, Al2, Al3, Ah0, Ah1, Ah2, Ah3, Bl0, Bl1, Bl2, Bl3, Bh0, Bh1, Bh2, Bh3; \
        FA_TRP(Al0, Ah0, Al1, Ah1, 0, 0); FA_TRP(Al2, Ah2, Al3, Ah3, 1, 0); \
        if constexpr (ND0 > 2) { FA_TRP(Bl0, Bh0, Bl1, Bh1, 2, 0); FA_TRP(Bl2, Bh2, Bl3, Bh3, 3, 0); } \
        float ps = 0.f; bf16x8 pa0, pa1, pa2, pa3; FA_PK4(p0, 0, pa0); FA_PK4(p0, 8, pa1); \
        FA_LW(W_); FA_MM2(Al0, Ah0, Al1, Ah1, 0, pa0, pa1); FA_TRP(Al0, Ah0, Al1, Ah1, 0, 2); FA_E4(0); \
        FA_LW(W_); FA_MM2(Al2, Ah2, Al3, Ah3, 1, pa0, pa1); FA_TRP(Al2, Ah2, Al3, Ah3, 1, 2); FA_E4(4); \
        if constexpr (ND0 > 2) { FA_LW(12); FA_MM2(Bl0, Bh0, Bl1, Bh1, 2, pa0, pa1); FA_TRP(Bl0, Bh0, Bl1, Bh1, 2, 2); FA_E4(8); \
                                 FA_LW(12); FA_MM2(Bl2, Bh2, Bl3, Bh3, 3, pa0, pa1); FA_TRP(Bl2, Bh2, Bl3, Bh3, 3, 2); FA_E4(12); } \
        else { FA_E4(8); FA_E4(12); } \
        l_reg += ps;     \
        FA_PK4(p1, 0, pa2); FA_PK4(p1, 8, pa3); \
        FA_LW(W_); FA_MM2(Al0, Ah0, Al1, Ah1, 0, pa2, pa3); \
        if constexpr (ND0 > 2) { FA_LW(8); FA_MM2(Al2, Ah2, Al3, Ah3, 1, pa2, pa3); FA_LW(4); FA_MM2(Bl0, Bh0, Bl1, Bh1, 2, pa2, pa3); FA_LW(0); FA_MM2(Bl2, Bh2, Bl3, Bh3, 3, pa2, pa3); } \
        else { FA_LW(0); FA_MM2(Al2, Ah2, Al3, Ah3, 1, pa2, pa3); } } } while (0)
#define FA_ENDK(issued) do { if (issued) asm volatile("s_waitcnt vmcnt(%0)" :: "i"(NKC) : "memory"); else asm volatile("s_waitcnt vmcnt(0)" ::: "memory"); __builtin_amdgcn_s_barrier(); asm volatile("" ::: "memory"); } while (0)
#define FA_ENDV(issued) do { if (issued) asm volatile("s_waitcnt vmcnt(%0)" :: "i"(NVC) : "memory"); else asm volatile("s_waitcnt vmcnt(0)" ::: "memory"); __builtin_amdgcn_s_barrier(); asm volatile("" ::: "memory"); } while (0)
    VM_WAIT();
    __syncthreads();
    if (grp == 0) {
        for (int t = 0; t < NT; ++t) { f32x16 p0, p1; bool tact;
            { const bool is_ = t + 1 < NT; if (is_) FA_LOADK(t + 1); FA_H1(t); FA_ENDK(is_); }
            { const bool is_ = t + 1 < NT; if (is_) FA_LOADV(t + 1); FA_H2(t); FA_ENDV(is_); } }
        FA_ENDK(false);
    } else {
        { const bool is_ = 1 < NT; if (is_) FA_LOADK(1); FA_ENDK(is_); }
        for (int t = 0; t < NT; ++t) { f32x16 p0, p1; bool tact;
            { const bool is_ = t + 1 < NT; if (is_) FA_LOADV(t + 1); FA_H1(t); FA_ENDV(is_); }
            { const bool is_ = t + 2 < NT; if (is_) FA_LOADK(t + 2); FA_H2(t); FA_ENDK(is_); } }
    }
#undef FA_TILE_FLAGS
#undef FA_TI
#undef FA_KADDR
#undef FA_KHALF
#undef FA_KRD2
#undef FA_H1
#undef FA_H2
#undef FA_PK4
#undef FA_TR
#undef FA_TR8
#undef FA_MM4
#undef FA_TRP
#undef FA_MM2
#undef FA_E4
#undef FA_LW
#undef FA_ENDK
#undef FA_ENDV
#undef FA_LOADK
#undef FA_LOADV
    { auto rr = __builtin_amdgcn_permlane32_swap(__float_as_uint(l_reg), __float_as_uint(l_reg), false, false); l_reg = __uint_as_float(rr[0]) + __uint_as_float(rr[1]); }
    if constexpr (MODE == MODE_BAND_SINK) l_reg += __builtin_amdgcn_exp2f(D.sink2 - m_reg);
    const float inv = 1.0f / l_reg;
    int qi_e = qi; asm volatile("" : "+v"(qi_e));
    bf16* op = D.o + (long)qi_e * D.o_rs + 4 * hi;
#pragma unroll
    for (int d0 = 0; d0 < ND0; ++d0)
#pragma unroll
        for (int g4 = 0; g4 < 4; ++g4) { v2u w; w.x = cvtpk(o[d0][4 * g4 + 0] * inv, o[d0][4 * g4 + 1] * inv); w.y = cvtpk(o[d0][4 * g4 + 2] * inv, o[d0][4 * g4 + 3] * inv);
            *(GAS v2u*)(op + d0 * 32 + 8 * g4) = w; }
    if constexpr (MODE == MODE_BAND_LSE) { if (hi == 0) D.lse[(long)qi_e * D.lse_rs] = (m_reg + __builtin_amdgcn_logf(l_reg)) * 0.6931471805599453f; }
}
}

constexpr float LOG2E = 1.4426950408889634f;
__device__ __forceinline__ void fast_mla_attn(KArgs a, LAS unsigned char* lds, int tid, int vcu) {
    unsigned char* ws = a->ws;
    const bf16* QM = (const bf16*)(ws + WS_QMLA); const bf16* KB = (const bf16*)(ws + WS_KB); const bf16* VB = (const bf16*)(ws + WS_VB); bf16* CAT = (bf16*)(ws + WS_CAT);
    for (int it = vcu; it < 256; it += gridDim.x) {
        const int xq = it & 7, rq = it >> 3, bh = xq * 4 + (rq >> 3), p = rq & 7, b = bh >> 3, h = bh & 7; const long r0 = (long)b * SEQ;
#pragma unroll 1
        for (int half = 0; half < 2; ++half) { const int x = half == 0 ? 15 - p : p;
            fa::Desc D{};
            D.q0 = 256 * x; D.t_lo = 0; D.t_hi = 4 * x + 4; D.W = 1 << 30; D.own = x; D.sink2 = 0.f;
            D.q = QM + r0 * NQMLA + h * 192; D.q_rs = NQMLA; D.k = KB + r0 * NQMLA + h * 192; D.k_rs = NQMLA; D.v = VB + r0 * 1024 + h * 128; D.v_rs = 1024;
            D.o = CAT + r0 * NCAT_E + h * 128; D.o_rs = NCAT_E; D.c2 = 0.07216878364870322f * LOG2E; D.slc = 0.f; D.rope = (const float*)(ws + WS_ROPE);
            fa::attn_unit<192, 128, fa::MODE_CAUSAL>(D, lds, tid);
        }
    }
}
__device__ __forceinline__ void fast_moba_attn(KArgs a, int ev, LAS unsigned char* lds, int tid, int vcu) {
    unsigned char* ws = a->ws; (void)vcu;
    const bf16* Z = (const bf16*)(ws + WS_Z); const bf16* KM = (const bf16*)(ws + WS_KM); bf16* CAT = (bf16*)(ws + WS_CAT);
    unsigned* ctr = (unsigned*)(ws + WS_CTL) + CW_QUEUE + 64 * ev;
    volatile LAS unsigned* slot = (volatile LAS unsigned*)(lds + LDSCTL_OFF + 128);
    for (;;) {
        if (tid == 0) slot[0] = __hip_atomic_fetch_add(ctr, 1u, __ATOMIC_RELAXED, __HIP_MEMORY_SCOPE_AGENT);
        __syncthreads();
        const int idx = __builtin_amdgcn_readfirstlane((int)slot[0]);
        __syncthreads();
        if (idx >= 512) break;
        const int x = 15 - (idx >> 5), rem = idx & 31, h = 7 - (rem >> 2), b = rem & 3; const long r0 = (long)b * SEQ;
        fa::Desc D{};
        D.q0 = 256 * x; D.t_lo = 0; D.t_hi = 4 * x + 4; D.W = 1 << 30; D.own = x; D.sink2 = 0.f;
        D.q = Z + r0 * NZE + ZE_QB + h * 128; D.q_rs = NZE; D.k = Z + r0 * NZE + ZE_KB + h * 128; D.k_rs = NZE; D.v = Z + r0 * NZE + ZE_VB + h * 128; D.v_rs = NZE;
        D.o = CAT + r0 * NCAT_E + 1024 + h * 128; D.o_rs = NCAT_E; D.km = KM + (size_t)((b * 8 + h) * 16) * 128; D.ktn = (const float*)(ws + WS_KTN) + (size_t)(b * 8 + h) * 64;
        D.c2 = 0.08838834764831845f * LOG2E; D.slc = exp2f(-(float)(h + 1)) * LOG2E;
        fa::attn_unit<128, 128, fa::MODE_MOBA>(D, lds, tid);
    }
}
__device__ __forceinline__ void fast_dil_attn(KArgs a, LAS unsigned char* lds, int tid, int vcu) {
    unsigned char* ws = a->ws;
    const bf16* Z = (const bf16*)(ws + WS_Z); bf16* OD = (bf16*)(ws + WS_OD); float* LSE = (float*)(ws + WS_LSE);
    for (int u = vcu; u < 768; u += gridDim.x) {
        fa::Desc D{};
        const int b = u / 192, rem = u - b * 192, head = rem >> 4, sub = rem & 15, g = head >> 2, hh = head & 3, dil = (g == 0) ? 1 : (g == 1 ? 4 : 16), nb = 16 / dil, r = sub / nb, blk = sub - r * nb, i0 = 256 * blk;
        const long row0 = (long)b * SEQ + r;
        D.q = Z + row0 * NZO + ZO_QC + head * 128; D.q_rs = (long)dil * NZO; D.k = Z + row0 * NZO + ZO_KC + head * 128; D.k_rs = (long)dil * NZO; D.v = Z + row0 * NZO + ZO_VC + head * 128; D.v_rs = (long)dil * NZO;
        D.o = OD + ((size_t)g * MTOK + row0) * 512 + hh * 128; D.o_rs = (long)dil * 512; D.lse = LSE + ((size_t)g * MTOK + row0) * 4 + hh; D.lse_rs = (long)dil * 4;
        D.q0 = i0; D.t_lo = (i0 >= 128) ? (i0 / 64 - 2) : 0; D.t_hi = i0 / 64 + 4; D.W = 129; D.c2 = 0.08838834764831845f * LOG2E; D.slc = exp2f(-8.0f * (float)(head + 1) / 12.0f) * (float)dil * LOG2E;
        fa::attn_unit<128, 128, fa::MODE_BAND_LSE>(D, lds, tid);
    }
}
__device__ __forceinline__ void fast_swa_attn(KArgs a, int od, LAS unsigned char* lds, int tid, int vcu) {
    unsigned char* ws = a->ws;
    const bf16* Z = (const bf16*)(ws + WS_Z); bf16* CAT = (bf16*)(ws + WS_CAT);
    const float* sinks = a->in[I_OD_SINKS] + od * 16;
    for (int v = vcu; v < 1024; v += gridDim.x) {
        fa::Desc D{};
        const int b = v >> 8, rem = v & 255, hq = rem >> 4, blk = rem & 15, kvh = hq >> 3, i0 = 256 * blk; const long row0 = (long)b * SEQ;
        D.q = Z + row0 * NZO + ZO_QD + hq * 64; D.q_rs = NZO; D.k = Z + row0 * NZO + ZO_KD + kvh * 64; D.k_rs = NZO; D.v = Z + row0 * NZO + ZO_VD + kvh * 64; D.v_rs = NZO;
        D.o = CAT + row0 * NCAT_O + 512 + hq * 64; D.o_rs = NCAT_O;
        D.q0 = i0; D.t_lo = (i0 >= 128) ? (i0 / 64 - 2) : 0; D.t_hi = i0 / 64 + 4; D.W = 128; D.c2 = 0.125f * LOG2E; D.slc = exp2f(-0.5f * (float)(hq + 1)) * LOG2E; D.sink2 = sinks[hq] * LOG2E;
        fa::attn_unit<64, 64, fa::MODE_BAND_SINK>(D, lds, tid);
    }
}

#define XLPTR ((bf16*)nullptr)
#define RSTAB ((LAS float*)(lds + QBUF_OFF))
#define GEMM_CONS(ACT_, PART_, Bptr, O_, ldc_, N_) do { pg8::StaticOrder S0_; S0_.init(MTOK, (N_), (int)gridDim.x, VCU()); pg8::Unit u0_; u0_.pm = 0; u0_.pn = 0; (void)S0_.next(0, u0_); \
        prep_rstab((PART_), u0_.pm, RSTAB, tid_now_()); pg8::EpiBf16<ACT_> E_{(O_), (ldc_), (const LAS float*)RSTAB, u0_.pm, (PART_), nullptr, 0, nullptr, nullptr}; \
        GEMM_CALL(pg8::EpiBf16<ACT_>, (bf16*)(ws + WS_H), DM, (Bptr), DM, (N_), DM, E_); } while (0)
#define GEMM_CONS_I8(ACT_, PART_, Bptr, CSP_, O_, ldc_, N_) do { pg8::StaticOrder S0_; S0_.init(MTOK, (N_), (int)gridDim.x, VCU()); pg8::Unit u0_; u0_.pm = 0; u0_.pn = 0; (void)S0_.next(0, u0_); \
        const float* qrow_ = (const float*)(ws + WS_XQS); \
        prep_rstab_q((PART_), qrow_, u0_.pm, RSTAB, tid_now_()); pg8::EpiBf16<ACT_, true> E_{(O_), (ldc_), (const LAS float*)RSTAB, u0_.pm, (PART_), nullptr, 0, qrow_, (CSP_)}; \
        typedef pg8::EpiBf16<ACT_, true> EpiQ_; GEMM_CALL(EpiQ_, (ws + WS_XQ), DM, (Bptr), DM, (N_), DM, E_); } while (0)
#define GEMM_CONS_U8(PART_, Bptr, CSP_, O8_, BS_, N_) do { pg8::StaticOrder S0_; S0_.init(MTOK, (N_), (int)gridDim.x, VCU()); pg8::Unit u0_; u0_.pm = 0; u0_.pn = 0; (void)S0_.next(0, u0_); \
        const float* qrow_ = (const float*)(ws + WS_XQS); \
        prep_rstab_q((PART_), qrow_, u0_.pm, RSTAB, tid_now_()); pg8::EpiU8 E_{(O8_), (BS_), (const LAS float*)RSTAB, u0_.pm, (PART_), qrow_, (CSP_)}; \
        GEMM_CALL(pg8::EpiU8, (ws + WS_XQ), DM, (Bptr), DM, (N_), DM, E_); } while (0)
#define GEMM_CALL(EPI, Aptr, lda_, Bptr, ldb_, N_, K_, E_) GEMM_CALLW(EPI, Aptr, lda_, Bptr, ldb_, N_, K_, E_, 8)
#define GEMM_CALLW(EPI, Aptr, lda_, Bptr, ldb_, N_, K_, E_, WGM_) do { pg8::Gemm g_{(const pg8::bf16_t*)(Aptr), (const pg8::bf16_t*)(Bptr), MTOK, (N_), (K_), (lda_), (ldb_)}; \
        pg8::StaticOrder S_; S_.init(MTOK, (N_), (int)gridDim.x, VCU()); S_.wgm = (WGM_); pg8::gemm_phase<EPI, pg8::StaticOrder, true, true>(lds + RING_OFF, g_, S_, E_); } while (0)
#define PH_ENV() KArgs kp = kargs(); unsigned char* ws = kp->ws; const Env e = make_env(); (void)ws; (void)e
#define VCU() ((int)__builtin_amdgcn_readfirstlane((int)((volatile LAS unsigned*)(lds + LDSCTL_OFF + 64))[3]))

__global__ void __launch_bounds__(NTHR, 2) mega_fwd(Args args_unused) {
    extern __shared__ __attribute__((aligned(16))) unsigned char lds_raw[];
    LAS unsigned char* lds = (LAS unsigned char*)lds_raw;
    (void)args_unused;
    for (int u = threadIdx.x; u < (LDS_BYTES - LDSCTL_OFF) / 4; u += NTHR) ((LAS unsigned*)(lds + LDSCTL_OFF))[u] = 0u;
    __syncthreads();
    { KArgs kp = kargs(); (void)xcd_barrier_post((unsigned*)(kp->ws + WS_CTL) + CW_BAR, (volatile LAS unsigned*)(lds + LDSCTL_OFF + 64)); }
#define SEAM() do { KArgs kb_ = kargs(); XcdBarrier bar_; bar_.bar = (unsigned*)(kb_->ws + WS_CTL) + CW_BAR; bar_.x = xb_xcc_id(); bar_.st = (volatile LAS unsigned*)(lds + LDSCTL_OFF + 64); xcd_barrier(bar_); } while (0)

    { KArgs kp = kargs(); slab_phase(kp, lds, tid_now_()); }
    { PH_ENV(); prologue_phase(kp, lds, e.gw, e.NGW, e.wave, e.lane); }
    { PH_ENV(); init_phase(kp->in[I_X], (bf16*)(ws + WS_H), XLPTR, (float*)(ws + WS_PB), e.gw, e.NGW, e.lane); }
    SEAM();
    { KArgs kp = kargs(); unsigned* bw = (unsigned*)(kp->ws + WS_CTL) + CW_BAR; volatile LAS unsigned* st = (volatile LAS unsigned*)(lds + LDSCTL_OFF + 64);
      if (threadIdx.x == 0) { const unsigned G = gridDim.x; bool ok = (G % 8u) == 0u;
          for (unsigned j = 0; j < 16; ++j) { const unsigned c = xb_ld(&bw[XB_XCNT(j)]); ok = ok && (c == (j < 8u ? G / 8u : 0u)); }
          const unsigned x = xb_xcc_id(); st[3] = (ok && x < 8u && st[2] < G / 8u) ? x + 8u * st[2] : blockIdx.x; }
      __syncthreads(); }
    if (IN_I8_MASK & 1) { { PH_ENV(); quant_rows<4>((const bf16*)(ws + WS_H), DM, (signed char*)(ws + WS_XQ), (float*)(ws + WS_XQS), MTOK, e.gw, e.NGW, e.lane); } SEAM(); }
#pragma unroll 1
    for (int layer = 0; layer < DEPTH; ++layer) {
        const int i2 = layer >> 1;
        if (layer > 0 && ((IN_I8_MASK >> layer) & 1)) { { PH_ENV(); quant_rows<4>((const bf16*)(ws + WS_H), DM, (signed char*)(ws + WS_XQ), (float*)(ws + WS_XQS), MTOK, e.gw, e.NGW, e.lane); } SEAM(); }
        if ((layer & 1) == 0) {
            if ((IN_I8_MASK >> layer) & 1) { PH_ENV(); GEMM_CONS_I8(0, (const float*)(ws + WS_PB), (ws + WS_WQINE) + (size_t)i2 * 4096 * DM, (const float*)(ws + WS_CSTEP) + CS_INE + i2 * 4096, (bf16*)(ws + WS_Z), NZE, 4096); }
            else { PH_ENV(); GEMM_CONS(0, (const float*)(ws + WS_PB), (bf16*)(ws + WS_WINE) + (size_t)i2 * NZE * DM, (bf16*)(ws + WS_Z), NZE, 4096); }
            SEAM();
            { PH_ENV(); latent_phase(kp, i2, lds, e.gw, e.NGW, e.wave, e.lane); }
            { PH_ENV(); const bf16* Zq = (const bf16*)(ws + WS_Z) + ZE_QLAT; const bf16* Zk = (const bf16*)(ws + WS_Z) + ZE_KVLAT;
              pg8::StaticOrder S0; S0.init(MTOK, NQMLA, (int)gridDim.x, VCU()); pg8::Unit u0; u0.pm = 0; u0.pn = 0; (void)S0.next(0, u0);
              const int tq = tid_now_(); prep_rstab_z(Zq, NZE, u0.pm, RSTAB, tq); prep_rstab_z(Zk, NZE, u0.pm, RSTAB + 256, tq);
              { pg8::EpiBf16<0> E{(bf16*)(ws + WS_QMLA), NQMLA, (const LAS float*)RSTAB, u0.pm, nullptr, Zq, NZE, nullptr, nullptr}; GEMM_CALL(pg8::EpiBf16<0>, Zq, NZE, (bf16*)(ws + WS_WUQ) + (size_t)i2 * NQMLA * 512, 512, NQMLA, 512, E); }
              { pg8::EpiKV E{(bf16*)(ws + WS_KB), (bf16*)(ws + WS_VB), (const LAS float*)(RSTAB + 256), u0.pm, Zk, NZE}; GEMM_CALL(pg8::EpiKV, Zk, NZE, (bf16*)(ws + WS_WUKV) + (size_t)i2 * NKVU * 512, 512, NKVU, 512, E); } }
            SEAM();
            #if FAST_EVEN
            { KArgs kp = kargs(); int tid_o = threadIdx.x; asm volatile("" : "+v"(tid_o)); fast_mla_attn(kp, lds, tid_o, VCU()); }
            { KArgs kp = kargs(); int tid_o = threadIdx.x; asm volatile("" : "+v"(tid_o)); fast_moba_attn(kp, i2, lds, tid_o, VCU()); }
#else
            { PH_ENV(); naive_even_attn(kp, lds, e.gw, e.NGW, e.wave, e.lane); }
#endif
            SEAM();
            { PH_ENV(); quant_rows<4>((const bf16*)(ws + WS_CAT), NCAT_E, (signed char*)(ws + WS_CATQ), (float*)(ws + WS_CATQS), MTOK, e.gw, e.NGW, e.lane); }
            SEAM();
            { PH_ENV(); pg8::EpiResSplitT<true> E{(bf16*)(ws + WS_H), XLPTR, (float*)(ws + WS_PA), (const float*)(ws + WS_CATQS), (const float*)(ws + WS_CSTEP) + CS_OUTE + i2 * DM, nullptr};
              GEMM_CALLW(pg8::EpiResSplitT<true>, (ws + WS_CATQ), NCAT_E, (ws + WS_WQOUTE) + (size_t)i2 * DM * NCAT_E, NCAT_E, DM, NCAT_E, E, 4); }
            SEAM();
        } else {
            if ((IN_I8_MASK >> layer) & 1) { PH_ENV(); GEMM_CONS_I8(0, (const float*)(ws + WS_PB), (ws + WS_WQINO) + (size_t)i2 * NZO * DM, (const float*)(ws + WS_CSTEP) + CS_INO + i2 * NZO, (bf16*)(ws + WS_Z), NZO, NZO); }
            else { PH_ENV(); GEMM_CONS(0, (const float*)(ws + WS_PB), (bf16*)(ws + WS_WINO) + (size_t)i2 * NZO * DM, (bf16*)(ws + WS_Z), NZO, NZO); }
            SEAM();
            #if FAST_ODD
            { KArgs kp = kargs(); int tid_o = threadIdx.x; asm volatile("" : "+v"(tid_o)); fast_dil_attn(kp, lds, tid_o, VCU()); }
            { KArgs kp = kargs(); int tid_o = threadIdx.x; asm volatile("" : "+v"(tid_o)); fast_swa_attn(kp, i2, lds, tid_o, VCU()); }
#else
            { PH_ENV(); naive_odd_attn(kp, i2, lds, e.gw, e.NGW, e.wave, e.lane); }
#endif
            SEAM();
            { PH_ENV(); merge_quant_phase(kp, e.gw, e.NGW, e.lane); }
            SEAM();
            { PH_ENV(); pg8::EpiResSplitT<true> E{(bf16*)(ws + WS_H), XLPTR, (float*)(ws + WS_PA), (const float*)(ws + WS_CATQS), (const float*)(ws + WS_CSTEP) + CS_OUTO + i2 * DM, nullptr}; GEMM_CALLW(pg8::EpiResSplitT<true>, (ws + WS_CATQ), NCAT_O, (ws + WS_WQOUTO) + (size_t)i2 * DM * NCAT_O, NCAT_O, DM, NCAT_O, E, 4); }
            SEAM();
        }
        if ((UP_I8_MASK >> layer) & 1) {
            { PH_ENV(); quant_rows<4>((const bf16*)(ws + WS_H), DM, (signed char*)(ws + WS_XQ), (float*)(ws + WS_XQS), MTOK, e.gw, e.NGW, e.lane); }
            SEAM();
            if ((DN_I8_MASK >> layer) & 1) { PH_ENV(); GEMM_CONS_U8((const float*)(ws + WS_PA), (ws + WS_WUP + (size_t)layer * FF * DM * 2), (const float*)(ws + WS_WUP + (size_t)layer * FF * DM * 2 + (size_t)FF * DM), (unsigned char*)(ws + WS_U), (float*)(ws + WS_U + (size_t)128 * MiB), FF); }
            else { PH_ENV(); GEMM_CONS_I8(1, (const float*)(ws + WS_PA), (ws + WS_WUP + (size_t)layer * FF * DM * 2), (const float*)(ws + WS_WUP + (size_t)layer * FF * DM * 2 + (size_t)FF * DM), (bf16*)(ws + WS_U), FF, FF); }
        } else
        { PH_ENV(); GEMM_CONS(1, (const float*)(ws + WS_PA), (bf16*)(ws + WS_WUP) + (size_t)layer * FF * DM, (bf16*)(ws + WS_U), FF, FF); }
        SEAM();

        if ((DN_I8_MASK >> layer) & 1) {
            { PH_ENV(); requant_hidden((unsigned char*)(ws + WS_U), (const float*)(ws + WS_U + (size_t)128 * MiB), (float*)(ws + WS_XQS), e.gw, e.NGW, e.lane);
              quant_weight_dn((const bf16*)(ws + WS_WDN) + (size_t)layer * DM * FF, (signed char*)(ws + WS_OD), (float*)(ws + WS_OD + (size_t)DM * FF), (float*)(ws + WS_OD + (size_t)DM * FF + 8192), e.gw, e.NGW, e.lane); }
            SEAM();
            { PH_ENV(); pg8::EpiResSplitT<true, true> E{(bf16*)(ws + WS_H), XLPTR, (float*)(ws + WS_PB), (const float*)(ws + WS_XQS), (const float*)(ws + WS_OD + (size_t)DM * FF), (const float*)(ws + WS_OD + (size_t)DM * FF + 8192)};
              typedef pg8::EpiResSplitT<true, true> EpiDn_; GEMM_CALLW(EpiDn_, (ws + WS_U), FF, (ws + WS_OD), FF, DM, FF, E, 4); }
        } else
        { PH_ENV(); pg8::EpiResSplit E{(bf16*)(ws + WS_H), XLPTR, (float*)(ws + WS_PB), nullptr, nullptr, nullptr}; GEMM_CALLW(pg8::EpiResSplit, (bf16*)(ws + WS_U), FF, (bf16*)(ws + WS_WDN) + (size_t)layer * DM * FF, FF, DM, FF, E, 4); }
        SEAM();
    }
    { PH_ENV(); final_norm_phase((const bf16*)(ws + WS_H), (const bf16*)XLPTR, kp->out, kp->in[I_FINAL_NORM], e.gw, e.NGW, e.lane); }
#undef SEAM
}

static_assert((DN_I8_MASK & ~UP_I8_MASK) == 0, "the int8 down-projection takes its input from an int8 up-projection's block-scaled int8 image");
extern "C" void kernel_launch(void* const* d_in, const int* in_sizes, int n_in, void* d_out, int out_size, void* d_ws, size_t ws_size, hipStream_t stream) {
    static int grid = 0;
    if (grid == 0) {
        if (n_in != 15 || in_sizes[0] != MTOK * DM || out_size != MTOK * DM || ws_size < WS_END2) { fprintf(stderr, "kernel_launch: unexpected shapes (n_in %d, in0 %d, out %d, ws %zu)\n", n_in, n_in > 0 ? in_sizes[0] : -1, out_size, ws_size); grid = -1; return; }
        int dev = 0, cus = 0, per_cu = 0;
        if (hipGetDevice(&dev) != hipSuccess || hipDeviceGetAttribute(&cus, hipDeviceAttributeMultiprocessorCount, dev) != hipSuccess) { grid = -1; return; }
        if (hipFuncSetAttribute((const void*)mega_fwd, hipFuncAttributeMaxDynamicSharedMemorySize, LDS_BYTES) != hipSuccess) { fprintf(stderr, "kernel_launch: hipFuncSetAttribute failed\n"); grid = -1; return; }
        if (hipOccupancyMaxActiveBlocksPerMultiprocessor(&per_cu, (const void*)mega_fwd, NTHR, LDS_BYTES) != hipSuccess || per_cu < 1) fprintf(stderr, "kernel_launch: occupancy query reports %d\n", per_cu);
        (void)hipGetLastError();
        grid = cus;
    }
    if (grid < 0) return;
    if (hipMemsetAsync((char*)d_ws + WS_CTL, 0, CTL_ZERO_BYTES, stream) != hipSuccess) { fprintf(stderr, "kernel_launch: memset failed\n"); return; }
    Args a{};
    for (int i = 0; i < 15; ++i) a.in[i] = (const float*)d_in[i];
    a.out = (float*)d_out; a.ws = (unsigned char*)d_ws; a.ph_lo = 0; a.ph_hi = 1 << 20;
    hipLaunchKernelGGL(mega_fwd, dim3(grid), dim3(NTHR), LDS_BYTES, stream, a);
}
```

```cpp
#include <hip/hip_runtime.h>
#include <cstdio>
#include <cstdint>
namespace pg8 {
#define PG8_LAS __attribute__((address_space(3)))
typedef unsigned short bf16_t;
typedef short bf16x8 __attribute__((ext_vector_type(8)));
typedef float f32x4 __attribute__((ext_vector_type(4)));
typedef unsigned u32x4 __attribute__((ext_vector_type(4)));
constexpr int BM = 256, BK = 64, HALF = 128, HTB = HALF * BK * 2  , STAGE_BYTES = 8 * HTB, NXCD = 8, WGM = 8;

__host__ __device__ __forceinline__ int lds_byte(int r, int c) { const int st = (r >> 4) * 2 + (c >> 5), rr = r & 15, cc = c & 31, ob = rr * 64 + cc * 2; return st * 1024 + (ob ^ (((ob >> 9) & 1) << 5)); }
__host__ __device__ __forceinline__ void stage_rc(int b, int& R, int& C) { const int st = b / 1024, sb = b % 1024, swz = sb ^ (((sb >> 9) & 1) << 5); R = (st >> 1) * 16 + swz / 64; C = (st & 1) * 32 + (swz % 64) / 2; }
__host__ __device__ __forceinline__ int perm32(int rho) { const int n = rho >> 4, i = rho & 15; return 8 * (i >> 2) + 4 * n + (i & 3); }

struct Unit { int pm, pn; };
struct Gemm { const bf16_t* A; const bf16_t* Bt; int M, N, K, lda, ldb; };

struct StaticOrder {
    int nM, nN, nwg, G, c, wgm;
    __host__ __device__ __forceinline__ void init(int M, int N, int G_, int c_) { nM = M / BM; nN = N / BM; nwg = nM * nN; G = G_; c = c_; wgm = WGM; }
    __host__ __device__ __forceinline__ bool next(int i, Unit& u) const {
        const long L = (long)i * G + c; if (L >= nwg) return false;
        int wgid = (int)L; { const int q = nwg / NXCD, r = nwg % NXCD, xcd = wgid % NXCD, off = wgid / NXCD; wgid = (xcd < r ? xcd * (q + 1) : r * (q + 1) + (xcd - r) * q) + off; }
        const int nig = wgm * nN, gid = wgid / nig, fm = gid * wgm, gsz = (nM - fm) < wgm ? (nM - fm) : wgm;
        u.pm = fm + ((wgid % nig) % gsz); u.pn = (wgid % nig) / gsz; return true;
    }
    __device__ __forceinline__ void a_ready(const Unit&) const {}
    __device__ __forceinline__ void done(const Unit&) const {}
};
typedef int i32x4 __attribute__((ext_vector_type(4)));
template <bool I8> struct AccT { typedef f32x4 type; };
template <> struct AccT<true> { typedef i32x4 type; };
__device__ __forceinline__ f32x4 mma16(bf16x8 a, bf16x8 b, f32x4 c) { return __builtin_amdgcn_mfma_f32_16x16x32_bf16(a, b, c, 0, 0, 0); }
__device__ __forceinline__ i32x4 mma16(bf16x8 a, bf16x8 b, i32x4 c) { return __builtin_amdgcn_mfma_i32_16x16x64_i8(__builtin_bit_cast(i32x4, a), __builtin_bit_cast(i32x4, b), c, 0, 0, 0); }
template <class Epi, class Sched, bool ALIGN_EPI = false, bool SP2 = false>
__device__ __forceinline__ void gemm_phase(PG8_LAS unsigned char* lds, const Gemm g, const Sched& S, const Epi& E) {
    int tid_o = threadIdx.x; asm volatile("" : "+v"(tid_o));
    const int tid = tid_o, wid = __builtin_amdgcn_readfirstlane(tid >> 6), lane = tid & 63, wr = wid >> 2, wc = wid & 3, fr = lane & 15, fq = lane >> 4;
    constexpr int ESZ = Epi::I8 ? 1 : 2;
    const int K = g.K, nt = K * ESZ / (BK * 2);
    unsigned voffA[2], voffB[2];
#pragma unroll
    for (int i = 0; i < 2; ++i) { int R, C; stage_rc(tid * 16 + i * 8192, R, C); const int Rb = Epi::PERM ? (64 * (R >> 5) + perm32(R & 31)) : R;
        voffA[i] = (unsigned)(R * g.lda * ESZ + C * 2); voffB[i] = (unsigned)(Rb * g.ldb * ESZ + C * 2); }
    const size_t kstep = (size_t)(BK * 2);
    const size_t hstepA = (size_t)HALF * g.lda * ESZ, hstepB = (size_t)(Epi::PERM ? 32 : HALF) * g.ldb * ESZ;
    const size_t tstepA = 2 * hstepA, tstepB = (size_t)BM * g.ldb * ESZ;
    const unsigned ldsw = (unsigned)wid * 1024u;
    const int aoff = lds_byte(wr * 64 + fr, fq * 8), boff = lds_byte(wc * 32 + fr, fq * 8);
#define PG8_SA(b, h) (((b) * 2 + (h)) * HTB)
#define PG8_SB(b, h) ((4 + (b) * 2 + (h)) * HTB)
#define PG8_STAGE(bufoff, gbase, voff) do { _Pragma("unroll") for (int _i = 0; _i < 2; ++_i) \
        __builtin_amdgcn_global_load_lds((const unsigned*)((const char*)(gbase) + (voff)[_i]), (PG8_LAS unsigned*)(lds + (bufoff) + ldsw + _i * 8192), 16, 0, 0); } while (0)
#define PG8_LDA(dst, b, h) do { _Pragma("unroll") for (int m = 0; m < 4; ++m) _Pragma("unroll") for (int k = 0; k < 2; ++k) dst[m][k] = *(const PG8_LAS bf16x8*)(lds + PG8_SA(b, h) + aoff + m * 2048 + k * 1024); } while (0)
#define PG8_LDB(dst, b, h) do { _Pragma("unroll") for (int n = 0; n < 2; ++n) _Pragma("unroll") for (int k = 0; k < 2; ++k) dst[n][k] = *(const PG8_LAS bf16x8*)(lds + PG8_SB(b, h) + boff + n * 2048 + k * 1024); } while (0)
#define PG8_MMA(ai, bj, At, Bt) do { __builtin_amdgcn_s_setprio(1); _Pragma("unroll") for (int m = 0; m < 4; ++m) _Pragma("unroll") for (int n = 0; n < 2; ++n) _Pragma("unroll") for (int k = 0; k < 2; ++k) \
        acc[ai][bj][m][n] = mma16(Bt[n][k], At[m][k], acc[ai][bj][m][n]); __builtin_amdgcn_s_setprio(0); } while (0)
#define PG8_WAIT_V(n) asm volatile("s_waitcnt vmcnt(" #n ")" ::: "memory")
#define PG8_WAIT_L(n) asm volatile("s_waitcnt lgkmcnt(" #n ")" ::: "memory")
#define PG8_BAR __builtin_amdgcn_s_barrier()
#define PG8_SCHED __builtin_amdgcn_sched_barrier(0)
    Unit cur, nxt; int ui = 0;
    if (!S.next(0, cur)) return;
    typedef typename AccT<Epi::I8>::type acc_t;
    acc_t acc[2][2][4][2];
#pragma unroll
    for (int a = 0; a < 2; ++a)
#pragma unroll
        for (int b = 0; b < 2; ++b)
#pragma unroll
            for (int m = 0; m < 4; ++m)
#pragma unroll
                for (int n = 0; n < 2; ++n) acc[a][b][m][n] = (acc_t){0, 0, 0, 0};
    bf16x8 At[4][2], B0[2][2], B1[2][2];
    const char* cA = (const char*)g.A + (size_t)cur.pm * tstepA; const char* cB = (const char*)g.Bt + (size_t)cur.pn * tstepB;
    S.a_ready(cur);
    if constexpr (SP2) {
        PG8_STAGE(PG8_SB(0, 0), cB, voffB); PG8_STAGE(PG8_SB(0, 1), cB + hstepB, voffB); PG8_STAGE(PG8_SA(0, 0), cA, voffA); PG8_STAGE(PG8_SA(0, 1), cA + hstepA, voffA);
        if (wr == 1) PG8_BAR;
        PG8_WAIT_V(2); PG8_BAR;
        PG8_STAGE(PG8_SB(1, 0), cB + kstep, voffB); PG8_STAGE(PG8_SA(1, 0), cA + kstep, voffA); PG8_STAGE(PG8_SB(1, 1), cB + hstepB + kstep, voffB);
        PG8_WAIT_V(6); PG8_BAR;
    } else {
        PG8_STAGE(PG8_SB(0, 0), cB, voffB); PG8_STAGE(PG8_SA(0, 0), cA, voffA); PG8_STAGE(PG8_SB(0, 1), cB + hstepB, voffB); PG8_STAGE(PG8_SA(0, 1), cA + hstepA, voffA);
        if (wr == 1) PG8_BAR;
        PG8_WAIT_V(4); PG8_BAR;
        PG8_STAGE(PG8_SB(1, 0), cB + kstep, voffB); PG8_STAGE(PG8_SA(1, 0), cA + kstep, voffA); PG8_STAGE(PG8_SB(1, 1), cB + hstepB + kstep, voffB);
        PG8_WAIT_V(6); PG8_BAR;
    }
    for (;;) {
        const bool has_next = S.next(ui + 1, nxt);
        const char* nA = has_next ? (const char*)g.A + (size_t)nxt.pm * tstepA : cA; const char* nB = has_next ? (const char*)g.Bt + (size_t)nxt.pn * tstepB : cB;
        for (int t = 0; t < nt; t += 2) {
            const bool last = (t == nt - 2);
            const char* a1 = cA + (size_t)(t + 1) * kstep;
            const char* a2 = last ? nA : cA + (size_t)(t + 2) * kstep; const char* b2 = last ? nB : cB + (size_t)(t + 2) * kstep;
            const char* a3 = a2 + kstep; const char* b3 = b2 + kstep;
            if (last && has_next) S.a_ready(nxt);
            if constexpr (SP2) {
            PG8_LDB(B0, 0, 0); PG8_LDB(B1, 0, 1); PG8_SCHED; PG8_LDA(At, 0, 0); PG8_STAGE(PG8_SA(1, 1), a1 + hstepA, voffA);
            PG8_WAIT_V(8); PG8_WAIT_L(0); PG8_BAR; PG8_MMA(0, 0, At, B0); PG8_MMA(0, 1, At, B1); PG8_BAR; PG8_SCHED;
            PG8_LDA(At, 0, 1); PG8_STAGE(PG8_SB(0, 0), b2, voffB); PG8_STAGE(PG8_SB(0, 1), b2 + hstepB, voffB); PG8_STAGE(PG8_SA(0, 0), a2, voffA);
            PG8_WAIT_V(8); PG8_WAIT_L(0); PG8_BAR; PG8_MMA(1, 0, At, B0); PG8_MMA(1, 1, At, B1); PG8_BAR; PG8_SCHED;
            PG8_LDB(B0, 1, 0); PG8_LDB(B1, 1, 1); PG8_SCHED; PG8_LDA(At, 1, 0); PG8_STAGE(PG8_SA(0, 1), a2 + hstepA, voffA);
            PG8_WAIT_V(8); PG8_WAIT_L(0); PG8_BAR; PG8_MMA(0, 0, At, B0); PG8_MMA(0, 1, At, B1); PG8_BAR; PG8_SCHED;
            PG8_LDA(At, 1, 1); PG8_STAGE(PG8_SB(1, 0), b3, voffB); PG8_STAGE(PG8_SB(1, 1), b3 + hstepB, voffB); PG8_STAGE(PG8_SA(1, 0), a3, voffA);
            PG8_WAIT_V(8); PG8_WAIT_L(0); PG8_BAR; PG8_MMA(1, 0, At, B0); PG8_MMA(1, 1, At, B1); PG8_BAR; PG8_SCHED;
            } else {
            PG8_LDB(B0, 0, 0); PG8_SCHED; PG8_LDA(At, 0, 0); PG8_STAGE(PG8_SA(1, 1), a1 + hstepA, voffA);
            PG8_WAIT_L(8); PG8_BAR; PG8_WAIT_L(0); PG8_MMA(0, 0, At, B0); PG8_BAR; PG8_SCHED;
            PG8_LDB(B1, 0, 1); PG8_STAGE(PG8_SB(0, 0), b2, voffB);
            PG8_BAR; PG8_WAIT_L(0); PG8_MMA(0, 1, At, B1); PG8_BAR;
            PG8_LDA(At, 0, 1); PG8_STAGE(PG8_SA(0, 0), a2, voffA);
            PG8_BAR; PG8_WAIT_L(0); PG8_MMA(1, 0, At, B0); PG8_BAR; PG8_SCHED;
            PG8_STAGE(PG8_SB(0, 1), b2 + hstepB, voffB);
            PG8_WAIT_V(6); PG8_BAR; PG8_MMA(1, 1, At, B1); PG8_BAR;
            PG8_LDB(B0, 1, 0); PG8_SCHED; PG8_LDA(At, 1, 0); PG8_STAGE(PG8_SA(0, 1), a2 + hstepA, voffA);
            PG8_WAIT_L(8); PG8_BAR; PG8_WAIT_L(0); PG8_MMA(0, 0, At, B0); PG8_BAR; PG8_SCHED;
            PG8_LDB(B1, 1, 1); PG8_STAGE(PG8_SB(1, 0), b3, voffB);
            PG8_BAR; PG8_WAIT_L(0); PG8_MMA(0, 1, At, B1); PG8_BAR;
            PG8_LDA(At, 1, 1); PG8_STAGE(PG8_SA(1, 0), a3, voffA);
            PG8_BAR; PG8_WAIT_L(0); PG8_MMA(1, 0, At, B0); PG8_BAR; PG8_SCHED;
            PG8_STAGE(PG8_SB(1, 1), b3 + hstepB, voffB);
            PG8_WAIT_V(6); PG8_BAR; PG8_MMA(1, 1, At, B1); PG8_BAR;
            }
        }
        if constexpr (ALIGN_EPI) { if (wr == 0) PG8_BAR; }
        if constexpr (!Epi::AFTER_DRAIN) { if constexpr (Epi::I8) { f32x4 accf[2][2][4][2];
            const f32x4* cp_ = (const f32x4*)(E.qcol + cur.pn * BM + wc * 64 + 8 * fq); const f32x4 cs_[2][2] = {{cp_[0], cp_[1]}, {cp_[8], cp_[9]}};
            f32x4 of_[2][2] = {};
            if constexpr (Epi::OFFS) { const f32x4* op_ = (const f32x4*)(E.qoff + cur.pn * BM + wc * 64 + 8 * fq); of_[0][0] = op_[0]; of_[0][1] = op_[1]; of_[1][0] = op_[8]; of_[1][1] = op_[9]; }
#pragma unroll
            for (int a = 0; a < 2; ++a)
#pragma unroll
                for (int b = 0; b < 2; ++b)
#pragma unroll
                    for (int m = 0; m < 4; ++m)
#pragma unroll
                        for (int n = 0; n < 2; ++n) accf[a][b][m][n] = Epi::OFFS ? (__builtin_convertvector(acc[a][b][m][n], f32x4) + of_[b][n]) * cs_[b][n] : __builtin_convertvector(acc[a][b][m][n], f32x4) * cs_[b][n];
            E(accf, cur, wr, wc, fr, fq); } else { E(acc, cur, wr, wc, fr, fq); } S.done(cur); }
        if (!has_next) break;
#pragma unroll
        for (int a = 0; a < 2; ++a)
#pragma unroll
            for (int b = 0; b < 2; ++b)
#pragma unroll
                for (int m = 0; m < 4; ++m)
#pragma unroll
                    for (int n = 0; n < 2; ++n) acc[a][b][m][n] = (acc_t){0, 0, 0, 0};
        cur = nxt; cA = nA; cB = nB; ++ui;
        if constexpr (ALIGN_EPI) { if (wr == 1) PG8_BAR; }
    }
    PG8_WAIT_V(0);
    if constexpr (!ALIGN_EPI) { if (wr == 0) PG8_BAR; }
    PG8_BAR;
    if constexpr (Epi::AFTER_DRAIN && !Epi::I8) { E.fused(acc, cur, wr, wc, fr, fq, lds, wid, lane); S.done(cur); }
#undef PG8_SA
#undef PG8_SB
#undef PG8_STAGE
#undef PG8_LDA
#undef PG8_LDB
#undef PG8_MMA
#undef PG8_WAIT_V
#undef PG8_WAIT_L
#undef PG8_BAR
#undef PG8_SCHED
}
}

namespace pg8 {
__device__ __forceinline__ unsigned cvt_pk_bf16(float lo, float hi) { unsigned r; asm volatile("v_cvt_pk_bf16_f32 %0, %1, %2" : "=v"(r) : "v"(lo), "v"(hi)); return r; }
__device__ __forceinline__ float zrow_rstd(const bf16_t* z) { float s = 0.f;
#pragma unroll 1
    for (int c = 0; c < 64; ++c) { const u32x4 w = *(const u32x4*)(z + c * 8);
        const float a0 = __uint_as_float(w.x << 16), a1 = __uint_as_float(w.x & 0xffff0000u), a2 = __uint_as_float(w.y << 16), a3 = __uint_as_float(w.y & 0xffff0000u), a4 = __uint_as_float(w.z << 16), a5 = __uint_as_float(w.z & 0xffff0000u), a6 = __uint_as_float(w.w << 16), a7 = __uint_as_float(w.w & 0xffff0000u);
        s += ((a0 * a0 + a1 * a1) + (a2 * a2 + a3 * a3)) + ((a4 * a4 + a5 * a5) + (a6 * a6 + a7 * a7)); }
    return 1.0f / sqrtf(s * (1.0f / 512.0f) + 1e-6f); }
typedef unsigned u32x2 __attribute__((ext_vector_type(2)));
template <int ACT, bool I8_ = false> struct EpiBf16 {
    static constexpr bool PERM = true, AFTER_DRAIN = false, I8 = I8_, OFFS = false;
    bf16_t* O; int ldc; const PG8_LAS float* rstab; int tab_pm; const float* part; const bf16_t* zsrc; int zld; const float* qrow; const float* qcol;
    __device__ __forceinline__ void operator()(const f32x4 (&acc)[2][2][4][2], const Unit& u, int wr, int wc, int fr, int fq) const {
        const int row0 = u.pm * BM + wr * 64 + fr; const int col0 = u.pn * BM + wc * 64 + 8 * fq;
        float rs[2][4];
#pragma unroll
        for (int ai = 0; ai < 2; ++ai)
#pragma unroll
            for (int m = 0; m < 4; ++m) { rs[ai][m] = 1.0f;
                if (rstab) { if (u.pm == tab_pm) rs[ai][m] = rstab[ai * HALF + wr * 64 + m * 16 + fr];
                    else if (part) { const f32x4* pp = (const f32x4*)(part + (size_t)(row0 + ai * HALF + m * 16) * 32); float s = 0.f;
#pragma unroll 1
                        for (int j = 0; j < 8; ++j) { const f32x4 t = pp[j]; s += (t[0] + t[1]) + (t[2] + t[3]); }
                        rs[ai][m] = 1.0f / sqrtf(s * (1.0f / 2048.0f) + 1e-6f); if (I8_) rs[ai][m] *= qrow[row0 + ai * HALF + m * 16]; }
                    else rs[ai][m] = zrow_rstd(zsrc + (size_t)(row0 + ai * HALF + m * 16) * zld); } }
#pragma unroll
        for (int ai = 0; ai < 2; ++ai)
#pragma unroll
            for (int m = 0; m < 4; ++m) { bf16_t* rowp = O + (size_t)(row0 + ai * HALF + m * 16) * ldc + col0;
#pragma unroll
                for (int bj = 0; bj < 2; ++bj) { f32x4 v0 = acc[ai][bj][m][0] * rs[ai][m], v1 = acc[ai][bj][m][1] * rs[ai][m];
                    if (ACT == 1) {
#pragma unroll
                        for (int j = 0; j < 4; ++j) { const float a = fmaxf(v0[j], 0.f), b = fmaxf(v1[j], 0.f); v0[j] = a * a; v1[j] = b * b; } }
                    u32x4 w; w.x = cvt_pk_bf16(v0[0], v0[1]); w.y = cvt_pk_bf16(v0[2], v0[3]); w.z = cvt_pk_bf16(v1[0], v1[1]); w.w = cvt_pk_bf16(v1[2], v1[3]);
                    *(u32x4*)(rowp + bj * 32) = w; } }
    }
};
__device__ __forceinline__ unsigned q4u_(float a, float b, float c, float d) { return ((unsigned)((int)__builtin_rintf(a) - 128) & 255u) | (((unsigned)((int)__builtin_rintf(b) - 128) & 255u) << 8) | (((unsigned)((int)__builtin_rintf(c) - 128) & 255u) << 16) | ((unsigned)((int)__builtin_rintf(d) - 128) << 24); }
struct EpiU8 {
    static constexpr bool PERM = true, AFTER_DRAIN = false, I8 = true, OFFS = false;
    unsigned char* O8; float* bs; const PG8_LAS float* rstab; int tab_pm; const float* part; const float* qrow; const float* qcol;
    __device__ __forceinline__ void operator()(const f32x4 (&acc)[2][2][4][2], const Unit& u, int wr, int wc, int fr, int fq) const {
        const int row0 = u.pm * BM + wr * 64 + fr; const int col0 = u.pn * BM + wc * 64 + 8 * fq;
#pragma unroll
        for (int ai = 0; ai < 2; ++ai)
#pragma unroll
            for (int m = 0; m < 4; ++m) { const int row = row0 + ai * HALF + m * 16; float rs;
                if (u.pm == tab_pm) rs = rstab[ai * HALF + wr * 64 + m * 16 + fr];
                else { const f32x4* pp = (const f32x4*)(part + (size_t)row * 32); float s = 0.f;
#pragma unroll 1
                    for (int j = 0; j < 8; ++j) { const f32x4 t = pp[j]; s += (t[0] + t[1]) + (t[2] + t[3]); }
                    rs = (1.0f / sqrtf(s * (1.0f / 2048.0f) + 1e-6f)) * qrow[row]; }
                float h[2][8]; float mx = 0.f;
#pragma unroll
                for (int bj = 0; bj < 2; ++bj)
#pragma unroll
                    for (int j = 0; j < 8; ++j) { const float a = fmaxf(acc[ai][bj][m][j >> 2][j & 3] * rs, 0.f); h[bj][j] = a * a; mx = fmaxf(mx, h[bj][j]); }
                { auto r = __builtin_amdgcn_permlane16_swap(__float_as_uint(mx), __float_as_uint(mx), false, false); mx = fmaxf(__uint_as_float(r[0]), __uint_as_float(r[1])); }
                { auto r = __builtin_amdgcn_permlane32_swap(__float_as_uint(mx), __float_as_uint(mx), false, false); mx = fmaxf(__uint_as_float(r[0]), __uint_as_float(r[1])); }
                const float inv = mx > 0.f ? 255.0f / mx : 0.f;
                unsigned char* rowp = O8 + (size_t)row * 8192 + col0;
#pragma unroll
                for (int bj = 0; bj < 2; ++bj) { u32x2 w; w.x = q4u_(h[bj][0] * inv, h[bj][1] * inv, h[bj][2] * inv, h[bj][3] * inv); w.y = q4u_(h[bj][4] * inv, h[bj][5] * inv, h[bj][6] * inv, h[bj][7] * inv);
                    *(u32x2*)(rowp + bj * 32) = w; }
                if (fq == 0) bs[(size_t)row * 128 + u.pn * 4 + wc] = mx * (1.0f / 255.0f); }
    }
};
struct EpiKV {
    static constexpr bool PERM = true, AFTER_DRAIN = false, I8 = false, OFFS = false;
    bf16_t* KBp; bf16_t* VBp; const PG8_LAS float* rstab; int tab_pm; const bf16_t* zsrc; int zld;
    __device__ __forceinline__ void operator()(const f32x4 (&acc)[2][2][4][2], const Unit& u, int wr, int wc, int fr, int fq) const {
        const int row0 = u.pm * BM + wr * 64 + fr; const int c0 = (wc & 1) * 64 + 8 * fq;
#pragma unroll
        for (int ai = 0; ai < 2; ++ai)
#pragma unroll
            for (int m = 0; m < 4; ++m) { const size_t row = (size_t)(row0 + ai * HALF + m * 16);
                const float rs = (u.pm == tab_pm) ? rstab[ai * HALF + wr * 64 + m * 16 + fr] : zrow_rstd(zsrc + row * zld);
#pragma unroll
                for (int bj = 0; bj < 2; ++bj) { const f32x4 v0 = acc[ai][bj][m][0] * rs, v1 = acc[ai][bj][m][1] * rs;
                    u32x4 w; w.x = cvt_pk_bf16(v0[0], v0[1]); w.y = cvt_pk_bf16(v0[2], v0[3]); w.z = cvt_pk_bf16(v1[0], v1[1]); w.w = cvt_pk_bf16(v1[2], v1[3]);
                    bf16_t* dst = (wc < 2 ? KBp + row * 1536 + u.pn * 192 : VBp + row * 1024 + u.pn * 128) + c0 + bj * 32;
                    *(u32x4*)dst = w; } }
    }
};
__device__ __forceinline__ float bfl(unsigned w) { return __uint_as_float(w << 16); }
__device__ __forceinline__ float bfh(unsigned w) { return __uint_as_float(w & 0xffff0000u); }
template <bool I8_ = false, bool OFFS_ = false> struct EpiResSplitT {
    static constexpr bool PERM = true, AFTER_DRAIN = false, I8 = I8_, OFFS = OFFS_;
    bf16_t* XH; bf16_t* XL; float* part; const float* qrow; const float* qcol; const float* qoff;
    __device__ __forceinline__ void operator()(const f32x4 (&acc)[2][2][4][2], const Unit& u, int wr, int wc, int fr, int fq) const {
        const int row0 = u.pm * BM + wr * 64 + fr, col0 = u.pn * BM + wc * 64 + 8 * fq;
#pragma unroll
        for (int ai = 0; ai < 2; ++ai) { u32x4 hx[4][2];
#pragma unroll
            for (int m = 0; m < 4; ++m)
#pragma unroll
                for (int bj = 0; bj < 2; ++bj) hx[m][bj] = *(const u32x4*)(XH + (size_t)(row0 + ai * HALF + m * 16) * 2048 + col0 + bj * 32);
            float qs[4] = {1.f, 1.f, 1.f, 1.f};
            if (I8_) {
#pragma unroll
                for (int m = 0; m < 4; ++m) qs[m] = qrow[row0 + ai * HALF + m * 16]; }
            asm volatile("" ::: "memory");
#pragma unroll
            for (int m = 0; m < 4; ++m) { const int row = row0 + ai * HALF + m * 16; const size_t off = (size_t)row * 2048 + col0; float ss = 0.f; const float qf = qs[m];
#pragma unroll
                for (int bj = 0; bj < 2; ++bj) { const u32x4 h = hx[m][bj]; u32x4 l = {0u, 0u, 0u, 0u}; if (XL) l = *(const u32x4*)(XL + off + bj * 32);
                    const f32x4 a0 = I8_ ? acc[ai][bj][m][0] * qf : acc[ai][bj][m][0], a1 = I8_ ? acc[ai][bj][m][1] * qf : acc[ai][bj][m][1]; float x[8];
                    x[0] = (bfl(h.x) + bfl(l.x)) + a0[0]; x[1] = (bfh(h.x) + bfh(l.x)) + a0[1]; x[2] = (bfl(h.y) + bfl(l.y)) + a0[2]; x[3] = (bfh(h.y) + bfh(l.y)) + a0[3];
                    x[4] = (bfl(h.z) + bfl(l.z)) + a1[0]; x[5] = (bfh(h.z) + bfh(l.z)) + a1[1]; x[6] = (bfl(h.w) + bfl(l.w)) + a1[2]; x[7] = (bfh(h.w) + bfh(l.w)) + a1[3];
                    ss += ((x[0] * x[0] + x[1] * x[1]) + (x[2] * x[2] + x[3] * x[3])) + ((x[4] * x[4] + x[5] * x[5]) + (x[6] * x[6] + x[7] * x[7]));
                    u32x4 nh; nh.x = cvt_pk_bf16(x[0], x[1]); nh.y = cvt_pk_bf16(x[2], x[3]); nh.z = cvt_pk_bf16(x[4], x[5]); nh.w = cvt_pk_bf16(x[6], x[7]);
                    *(u32x4*)(XH + off + bj * 32) = nh;
                    if (XL) { u32x4 nl; nl.x = cvt_pk_bf16(x[0] - bfl(nh.x), x[1] - bfh(nh.x)); nl.y = cvt_pk_bf16(x[2] - bfl(nh.y), x[3] - bfh(nh.y)); nl.z = cvt_pk_bf16(x[4] - bfl(nh.z), x[5] - bfh(nh.z)); nl.w = cvt_pk_bf16(x[6] - bfl(nh.w), x[7] - bfh(nh.w));
                        *(u32x4*)(XL + off + bj * 32) = nl; } }
                { auto r = __builtin_amdgcn_permlane16_swap(__float_as_uint(ss), __float_as_uint(ss), false, false); ss = __uint_as_float(r[0]) + __uint_as_float(r[1]); }
                { auto r = __builtin_amdgcn_permlane32_swap(__float_as_uint(ss), __float_as_uint(ss), false, false); ss = __uint_as_float(r[0]) + __uint_as_float(r[1]); }
                if (fq == 0) part[(size_t)row * 32 + u.pn * 4 + wc] = ss; }
            asm volatile("" ::: "memory"); }
    }
};
typedef EpiResSplitT<false, false> EpiResSplit;
}

constexpr int NWAVES = 8, NTHR = NWAVES * 64;
constexpr int DM = 2048, BATCH = 4, SEQ = 4096, MTOK = BATCH * SEQ, DEPTH = 4, FF = 8192;
constexpr float NORM_EPS = 1e-6f;
constexpr int NZE = 4352, NZO = 5888;
constexpr int ZE_QLAT = 0, ZE_KVLAT = 512, ZE_QB = 1024, ZE_KB = 2048, ZE_VB = 3072, ZE_KPE = 4096;
constexpr int ZO_QC = 0, ZO_KC = 1536, ZO_VC = 3072, ZO_QD = 4608, ZO_KD = 5632, ZO_VD = 5760;
constexpr int NQMLA = 1536, NKVU = 2048, NCAT_E = 2048, NCAT_O = 1536;

constexpr size_t MiB = 1u << 20;
constexpr size_t WS_CTL = 0, CTL_ZERO_BYTES = 1 * MiB;
constexpr size_t WS_ROPE = 1 * MiB;
constexpr size_t WS_KTN = 2 * MiB + 128 * 1024;
constexpr size_t WS_KM = 2 * MiB;
constexpr size_t WS_LSE = 3 * MiB;
constexpr size_t WS_WUP = 4 * MiB, WS_WDN = 132 * MiB, WS_WINE = 260 * MiB, WS_WUQ = 294 * MiB, WS_WUKV = 297 * MiB, WS_WOUTE = 301 * MiB, WS_WINO = 317 * MiB, WS_WOUTO = 363 * MiB;
constexpr size_t WS_H = 376 * MiB, WS_Z = 440 * MiB, WS_QKVN = 624 * MiB, WS_QMLA = 656 * MiB, WS_KB = 704 * MiB, WS_VB = 752 * MiB, WS_CAT = 784 * MiB, WS_OD = 848 * MiB, WS_XL = 896 * MiB, WS_PA = 960 * MiB, WS_PB = 962 * MiB, WS_END = 964 * MiB;
constexpr size_t WS_XQ = 896 * MiB, WS_CATQ = 928 * MiB;
constexpr size_t WS_XQS = 3 * MiB + 768 * 1024, WS_CATQS = WS_XQS + 65536;
constexpr size_t WS_WQINE = 964 * MiB, WS_WQINO = 980 * MiB, WS_WQOUTE = 1003 * MiB, WS_WQOUTO = 1011 * MiB, WS_END2 = 1018 * MiB;
constexpr size_t WS_CSTEP = 1017 * MiB;
constexpr int CS_INE = 0, CS_INO = 8192, CS_OUTE = 8192 + 11776, CS_OUTO = CS_OUTE + 4096;
constexpr int CW_WMAX = 12288;
constexpr size_t WS_U = 440 * MiB;
static_assert(WS_U + (size_t)MTOK * FF * 2 <= WS_KB && WS_H + (size_t)MTOK * DM * 2 <= WS_Z && WS_Z + (size_t)MTOK * NZO * 2 <= WS_QKVN, "ws map");
constexpr int CW_QUEUE = 8192;
constexpr int CW_BAR = 4096;

constexpr int RING_OFF = 0, RING_BYTES = 131072, QBUF_OFF = 131072, LDSCTL_OFF = 139264, LDS_BYTES = 147456;

#define GAS __attribute__((address_space(1)))
#define LAS __attribute__((address_space(3)))
typedef unsigned short bf16;
typedef unsigned v4u __attribute__((ext_vector_type(4)));
typedef unsigned v2u __attribute__((ext_vector_type(2)));
typedef float f32x4 __attribute__((ext_vector_type(4)));
#define LDS_WAIT() asm volatile("s_waitcnt lgkmcnt(0)" ::: "memory")
#define VM_WAIT() asm volatile("s_waitcnt vmcnt(0)" ::: "memory")
__device__ __forceinline__ unsigned f2bf(float f) { unsigned u = __builtin_bit_cast(unsigned, f); return (u + 0x7fffu + ((u >> 16) & 1u)) >> 16; }
__device__ __forceinline__ unsigned pk2(float lo, float hi) { return f2bf(lo) | (f2bf(hi) << 16); }
__device__ __forceinline__ float bf_lo(unsigned w) { return __uint_as_float(w << 16); }
__device__ __forceinline__ float bf_hi(unsigned w) { return __uint_as_float(w & 0xffff0000u); }
__device__ __forceinline__ float bf1(bf16 b) { return __uint_as_float(((unsigned)b) << 16); }
#define DPP_ADD(v, ctrl) ((v) + __int_as_float(__builtin_amdgcn_update_dpp(0, __float_as_int(v), (ctrl), 0xf, 0xf, false)))
__device__ __forceinline__ float wave_sum_v(float v) {
    v = DPP_ADD(v, 0xB1); v = DPP_ADD(v, 0x4E); v = DPP_ADD(v, 0x141); v = DPP_ADD(v, 0x140);
    { auto r = __builtin_amdgcn_permlane16_swap(__float_as_uint(v), __float_as_uint(v), false, false); v = __uint_as_float(r[0]) + __uint_as_float(r[1]); }
    { auto r = __builtin_amdgcn_permlane32_swap(__float_as_uint(v), __float_as_uint(v), false, false); v = __uint_as_float(r[0]) + __uint_as_float(r[1]); }
    return v;
}
#define DPP_MAX(v, ctrl) fmaxf((v), __int_as_float(__builtin_amdgcn_update_dpp(0, __float_as_int(v), (ctrl), 0xf, 0xf, false)))
__device__ __forceinline__ float wave_max_v(float v) {
    v = DPP_MAX(v, 0xB1); v = DPP_MAX(v, 0x4E); v = DPP_MAX(v, 0x141); v = DPP_MAX(v, 0x140);
    { auto r = __builtin_amdgcn_permlane16_swap(__float_as_uint(v), __float_as_uint(v), false, false); v = fmaxf(__uint_as_float(r[0]), __uint_as_float(r[1])); }
    { auto r = __builtin_amdgcn_permlane32_swap(__float_as_uint(v), __float_as_uint(v), false, false); v = fmaxf(__uint_as_float(r[0]), __uint_as_float(r[1])); }
    return v;
}
__device__ __forceinline__ float shfl_xor_l(float v, int o, int lane) { return __int_as_float(__builtin_amdgcn_ds_bpermute((lane ^ o) << 2, __float_as_int(v))); }
__device__ __forceinline__ float wave_sum_l(float v, int lane) {
#pragma unroll
    for (int o = 1; o < 64; o <<= 1) v += shfl_xor_l(v, o, lane);
    return v;
}
__device__ __forceinline__ float wave_max_l(float v, int lane) {
#pragma unroll
    for (int o = 1; o < 64; o <<= 1) v = fmaxf(v, shfl_xor_l(v, o, lane));
    return v;
}

#define XB_TMO      128
#define XB_XCNT(j)  (256  + 64 * (j))
#define XB_XSUB(j)  (1280 + 64 * (j))
#define XB_XGEN(j)  (2304 + 64 * (j))
#define XB_TOP      3328
#define XB_TOPGEN   3392
#define XCD_BAR_WORDS 3456
#define XB_SPIN_CAP (1u << 22)
__device__ __forceinline__ unsigned xb_ld(unsigned* p)              { return __hip_atomic_load(p, __ATOMIC_RELAXED, __HIP_MEMORY_SCOPE_AGENT); }
__device__ __forceinline__ unsigned xb_add(unsigned* p, unsigned v) { return __hip_atomic_fetch_add(p, v, __ATOMIC_RELAXED, __HIP_MEMORY_SCOPE_AGENT); }
__device__ __forceinline__ unsigned xb_xcc_id() { return (unsigned)__builtin_amdgcn_s_getreg((3 << 11) | 20) & 0xFu; }
#define XB_SPIN(cond, bar) do { unsigned _sp = 0; while (cond) { __builtin_amdgcn_s_sleep(1); \
    if ((++_sp & 255u) == 0u) { if (xb_ld(&(bar)[XB_TMO])) break; if (_sp > XB_SPIN_CAP) { atomicAdd(&(bar)[XB_TMO], 1u); break; } } } } while (0)
struct XcdBarrier { unsigned* bar; unsigned x; volatile LAS unsigned* st; };
__device__ __forceinline__ XcdBarrier xcd_barrier_post(unsigned* bar, volatile LAS unsigned* st) {
    XcdBarrier b; b.bar = bar; b.x = xb_xcc_id(); b.st = st;
    if (threadIdx.x == 0) st[2] = xb_add(&bar[XB_XCNT(b.x)], 1u);
    return b;
}
__device__ __forceinline__ void xcd_barrier_complete(unsigned* bar, unsigned x, unsigned& nloc, unsigned& nx) {
    const unsigned G = gridDim.x * gridDim.y * gridDim.z;
    unsigned sum, cnt, mine, sp = 0u;
    for (;;) {
        sum = 0u; cnt = 0u; mine = 0u;
#pragma unroll
        for (unsigned j = 0; j < 16; ++j) { const unsigned c = xb_ld(&bar[XB_XCNT(j)]); sum += c; cnt += (c > 0u) ? 1u : 0u; mine = (j == x) ? c : mine; }
        if (sum == G) break;
        __builtin_amdgcn_s_sleep(1);
        if ((++sp & 255u) == 0u) { if (xb_ld(&bar[XB_TMO])) break; if (sp > XB_SPIN_CAP) { atomicAdd(&bar[XB_TMO], 1u); break; } }
    }
    nloc = mine > 0u ? mine : 1u; nx = cnt > 0u ? cnt : 1u;
}
__device__ __forceinline__ void xcd_barrier(const XcdBarrier& b) {
    asm volatile("s_waitcnt vmcnt(0)" ::: "memory");
    __syncthreads();
    if (threadIdx.x == 0) {
        unsigned* bar = b.bar;
        __builtin_amdgcn_s_waitcnt(0);
        unsigned nloc = b.st[0], nx = b.st[1];
        if (nloc == 0u) { xcd_barrier_complete(bar, b.x, nloc, nx); b.st[0] = nloc; b.st[1] = nx; }
        const unsigned old = xb_add(&bar[XB_XSUB(b.x)], 1u);
        const unsigned gen = old / nloc;
        if (old + 1u == (gen + 1u) * nloc) {
            __builtin_amdgcn_fence(__ATOMIC_RELEASE, "agent");
            asm volatile("s_waitcnt vmcnt(0)" ::: "memory");
            const unsigned og = xb_add(&bar[XB_TOP], 1u);
            const unsigned tg = og / nx;
            if (og + 1u == (tg + 1u) * nx) xb_add(&bar[XB_TOPGEN], 1u);
            else XB_SPIN(xb_ld(&bar[XB_TOPGEN]) == tg, bar);
            __builtin_amdgcn_fence(__ATOMIC_ACQUIRE, "agent");
            xb_add(&bar[XB_XGEN(b.x)], 1u);
            asm volatile("s_waitcnt vmcnt(0)" ::: "memory");
        } else {
            XB_SPIN(xb_ld(&bar[XB_XGEN(b.x)]) == gen, bar);
            __builtin_amdgcn_fence(__ATOMIC_ACQUIRE, "agent");
            asm volatile("s_waitcnt vmcnt(0)" ::: "memory");
        }
    }
    __syncthreads();
}

struct Args { const float* in[15]; float* out; unsigned char* ws; int ph_lo, ph_hi; };
typedef __attribute__((address_space(4))) const Args* KArgs;
__device__ __forceinline__ KArgs kargs() { KArgs p = (KArgs)__builtin_amdgcn_kernarg_segment_ptr(); asm volatile("" : "+s"(p)); return p; }
__device__ __forceinline__ int tid_now_() { int t = threadIdx.x; asm volatile("" : "+v"(t)); return t; }
struct Env { int lane, wave, gw, NGW, G; };
__device__ __forceinline__ Env make_env() { int tid = threadIdx.x; asm volatile("" : "+v"(tid)); Env e; e.lane = tid & 63; e.wave = __builtin_amdgcn_readfirstlane(tid >> 6); e.G = gridDim.x; e.gw = blockIdx.x * NWAVES + e.wave; e.NGW = e.G * NWAVES; return e; }
enum { I_X = 0, I_ATTN_NORM, I_MLP_NORM, I_WUP, I_WDN, I_EV_WIN, I_EV_QNORM, I_EV_WUQ, I_EV_KVNORM, I_EV_WUKV, I_EV_WOUT, I_OD_WIN, I_OD_SINKS, I_OD_WOUT, I_FINAL_NORM };

#ifndef IN_I8_MASK
#define IN_I8_MASK 14
#endif
#ifndef DN_I8_MASK
#define DN_I8_MASK 14
#endif
#ifndef UP_I8_MASK
#define UP_I8_MASK 14
#endif
struct Job { const float* W; bf16* WT; const float* gain; int K, ldw, scol0, drow0, ncols, qid; };
constexpr int NJOBS = 24;
__device__ __forceinline__ Job make_job(KArgs a, int j) {
    Job J; unsigned char* ws = a->ws; J.gain = nullptr; J.qid = -1;
    if (j < 4) { J.W = a->in[I_WUP] + (size_t)j * DM * FF; J.WT = (bf16*)(ws + WS_WUP) + (size_t)j * FF * DM; J.K = DM; J.ldw = FF; J.scol0 = 0; J.drow0 = 0; J.ncols = ((UP_I8_MASK >> j) & 1) ? 0 : FF; J.gain = a->in[I_MLP_NORM] + j * DM; return J; }
    if (j < 8) { const int l = j - 4; J.W = a->in[I_WDN] + (size_t)l * FF * DM; J.WT = (bf16*)(ws + WS_WDN) + (size_t)l * DM * FF; J.K = FF; J.ldw = DM; J.scol0 = 0; J.drow0 = 0; J.ncols = DM; return J; }
    const int i = (j - 8) >> 3, sub = (j - 8) & 7;
    if (sub < 3) { J.W = a->in[I_EV_WIN] + (size_t)i * DM * 4160; J.WT = (bf16*)(ws + WS_WINE) + (size_t)i * NZE * DM; J.K = DM; J.ldw = 4160; J.gain = a->in[I_ATTN_NORM] + (2 * i) * DM;
        if (sub == 0) { J.scol0 = 0; J.drow0 = 0; J.ncols = 1024; J.qid = i; } else if (sub == 1) { J.scol0 = 1088; J.drow0 = 1024; J.ncols = 3072; J.qid = i; } else { J.scol0 = 1024; J.drow0 = 4096; J.ncols = 64; }
        if (sub < 2 && ((IN_I8_MASK >> (2 * i)) & 1)) J.ncols = 0;
        return J; }
    J.scol0 = 0; J.drow0 = 0;
    if (sub == 3) { J.W = a->in[I_EV_WUQ] + (size_t)i * 512 * NQMLA; J.WT = (bf16*)(ws + WS_WUQ) + (size_t)i * NQMLA * 512; J.K = 512; J.ldw = NQMLA; J.ncols = NQMLA; J.gain = a->in[I_EV_QNORM] + i * 512; return J; }
    if (sub == 4) { J.W = a->in[I_EV_WUKV] + (size_t)i * 512 * NKVU; J.WT = (bf16*)(ws + WS_WUKV) + (size_t)i * NKVU * 512; J.K = 512; J.ldw = NKVU; J.ncols = NKVU; J.gain = a->in[I_EV_KVNORM] + i * 512; return J; }
    if (sub == 5) { J.W = a->in[I_EV_WOUT] + (size_t)i * NCAT_E * DM; J.WT = (bf16*)(ws + WS_WOUTE) + (size_t)i * DM * NCAT_E; J.K = NCAT_E; J.ldw = DM; J.ncols = 0; J.qid = 4 + i; return J; }
    if (sub == 6) { J.W = a->in[I_OD_WIN] + (size_t)i * DM * NZO; J.WT = (bf16*)(ws + WS_WINO) + (size_t)i * NZO * DM; J.K = DM; J.ldw = NZO; J.ncols = NZO; J.gain = a->in[I_ATTN_NORM] + (2 * i + 1) * DM; J.qid = 2 + i; if ((IN_I8_MASK >> (2 * i + 1)) & 1) J.ncols = 0; return J; }
    J.W = a->in[I_OD_WOUT] + (size_t)i * NCAT_O * DM; J.WT = (bf16*)(ws + WS_WOUTO) + (size_t)i * DM * NCAT_O; J.K = NCAT_O; J.ldw = DM; J.ncols = 0; J.qid = 6 + i; return J;
}
__device__ __forceinline__ void tile_load(const Job& J, int item, int lane, f32x4 (&v)[8], unsigned* ctl) {
    const int nblk = J.ncols / 32, kb = item / nblk, nb = item % nblk, k0 = 64 * kb, n0 = 32 * nb;
    const GAS float* W = (const GAS float*)J.W + (size_t)(k0 + (lane >> 3)) * J.ldw + J.scol0 + n0 + 4 * (lane & 7);
#pragma unroll
    for (int i = 0; i < 8; ++i) v[i] = __builtin_nontemporal_load((const GAS f32x4*)(W + (size_t)(8 * i) * J.ldw));
    if (J.gain) {
#pragma unroll
        for (int i = 0; i < 8; ++i) v[i] = v[i] * ((const GAS float*)J.gain)[k0 + 8 * i + (lane >> 3)]; }
}
__device__ __forceinline__ void tile_store(const Job& J, LAS float* scr, int item, int lane, const f32x4 (&v)[8]) {
    const int nblk = J.ncols / 32, kb = item / nblk, nb = item % nblk, k0 = 64 * kb, n0 = 32 * nb;
#pragma unroll
    for (int i = 0; i < 8; ++i) { LAS float* d = scr + (8 * i + (lane >> 3)) * 33 + 4 * (lane & 7); d[0] = v[i][0]; d[1] = v[i][1]; d[2] = v[i][2]; d[3] = v[i][3]; }
    LDS_WAIT(); asm volatile("" ::: "memory");
    const int c = lane & 7;
#pragma unroll
    for (int j = 0; j < 4; ++j) { const int n = (lane >> 3) + 8 * j; const LAS float* s = scr + (8 * c) * 33 + n;
        v4u o; o.x = pk2(s[0 * 33], s[1 * 33]); o.y = pk2(s[2 * 33], s[3 * 33]); o.z = pk2(s[4 * 33], s[5 * 33]); o.w = pk2(s[6 * 33], s[7 * 33]);
        *(GAS v4u*)(J.WT + (size_t)(J.drow0 + n0 + n) * J.K + k0 + 8 * c) = o; }
    LDS_WAIT(); asm volatile("" ::: "memory");
}
__device__ __forceinline__ void prologue_phase(KArgs a, LAS unsigned char* lds, int gw, int NGW, int wave, int lane) {
    LAS float* scr = (LAS float*)(lds + RING_OFF + wave * 16384); unsigned* ctl_ = (unsigned*)(a->ws + WS_CTL);
    int total = 0;
    for (int j = 0; j < NJOBS; ++j) { const Job J = make_job(a, j); total += (J.K / 64) * (J.ncols / 32); }
    int jc = 0, basec = 0; Job Jc = make_job(a, 0); int nitc = (Jc.K / 64) * (Jc.ncols / 32);
#define PRO_LOCATE(gi) do { while ((gi) - basec >= nitc) { basec += nitc; ++jc; Jc = make_job(a, jc); nitc = (Jc.K / 64) * (Jc.ncols / 32); } } while (0)
    f32x4 v[8]; int gi = gw;
    if (gi < total) { PRO_LOCATE(gi); tile_load(Jc, gi - basec, lane, v, ctl_); }
    while (gi < total) {
        const Job Jt = Jc; const int itt = gi - basec; const int gn = gi + NGW;
        f32x4 vn[8];
        if (gn < total) { PRO_LOCATE(gn); tile_load(Jc, gn - basec, lane, vn, ctl_); }
        tile_store(Jt, scr, itt, lane, v);
        if (gn < total) {
#pragma unroll
            for (int i = 0; i < 8; ++i) v[i] = vn[i]; }
        gi = gn;
    }
#undef PRO_LOCATE
    for (int i = 0; i < 2; ++i) { GAS v4u* p = (GAS v4u*)((bf16*)(a->ws + WS_WINE) + (size_t)i * NZE * DM + (size_t)4160 * DM); const int n16 = 192 * DM / 8;
        for (int e = gw * 64 + lane; e < n16; e += NGW * 64) p[e] = (v4u){0u, 0u, 0u, 0u}; }
    { GAS float* ct = (GAS float*)(a->ws + WS_ROPE); GAS float* st = ct + SEQ * 32;
        for (int e = gw * 64 + lane; e < SEQ * 32; e += NGW * 64) { const int pos = e >> 5, i = e & 31; const double inv = exp2(-(double)i * (13.287712379549449 / 32.0)); const double ang = (double)pos * inv;
            ct[e] = (float)cos(ang); st[e] = (float)sin(ang); } }
}

__device__ __forceinline__ void init_phase(const float* X, bf16* XH, bf16* XL, float* PB, int gw, int NGW, int lane) {
    f32x4 v[8];
    if (gw < MTOK) { const GAS f32x4* xr = (const GAS f32x4*)(X + (size_t)gw * DM) + lane;
#pragma unroll
        for (int j = 0; j < 8; ++j) v[j] = xr[64 * j]; }
    for (int m = gw; m < MTOK; m += NGW) {
        f32x4 vn[8]; const int mn = m + NGW < MTOK ? m + NGW : m;
        { const GAS f32x4* xr = (const GAS f32x4*)(X + (size_t)mn * DM) + lane;
#pragma unroll
          for (int j = 0; j < 8; ++j) vn[j] = xr[64 * j]; }
        float s = 0.f;
#pragma unroll
        for (int j = 0; j < 8; ++j) s += (v[j].x * v[j].x + v[j].y * v[j].y) + (v[j].z * v[j].z + v[j].w * v[j].w);
        s = wave_sum_v(s);
        GAS v2u* oh = (GAS v2u*)(XH + (size_t)m * DM) + lane; GAS v2u* ol = (GAS v2u*)(XL + (size_t)m * DM) + lane;
#pragma unroll
        for (int j = 0; j < 8; ++j) { v2u h; h.x = pk2(v[j].x, v[j].y); h.y = pk2(v[j].z, v[j].w);
            v2u l; l.x = pk2(v[j].x - bf_lo(h.x), v[j].y - bf_hi(h.x)); l.y = pk2(v[j].z - bf_lo(h.y), v[j].w - bf_hi(h.y)); oh[64 * j] = h; if (XL) ol[64 * j] = l; }
        if (lane < 32) ((GAS float*)PB)[(size_t)m * 32 + lane] = lane == 0 ? s : 0.f;
#pragma unroll
        for (int j = 0; j < 8; ++j) v[j] = vn[j];
    }
}
__device__ __forceinline__ void final_norm_phase(const bf16* XH, const bf16* XL, float* out, const float* g, int gw, int NGW, int lane) {
    f32x4 gv[8];
#pragma unroll
    for (int j = 0; j < 8; ++j) gv[j] = ((const GAS f32x4*)g)[64 * j + lane];
    v2u hc[8];
    if (gw < MTOK) { const GAS v2u* ph = (const GAS v2u*)(XH + (size_t)gw * DM) + lane;
#pragma unroll
        for (int j = 0; j < 8; ++j) hc[j] = ph[64 * j]; }
    for (int m = gw; m < MTOK; m += NGW) {
        v2u hn[8]; const int mn = m + NGW < MTOK ? m + NGW : m;
        { const GAS v2u* ph = (const GAS v2u*)(XH + (size_t)mn * DM) + lane;
#pragma unroll
          for (int j = 0; j < 8; ++j) hn[j] = ph[64 * j]; }
        const GAS v2u* pl = (const GAS v2u*)(XL + (size_t)m * DM) + lane;
        f32x4 v[8]; float s = 0.f;
#pragma unroll
        for (int j = 0; j < 8; ++j) { const v2u h = hc[j]; v2u l = {0u, 0u}; if (XL) l = pl[64 * j]; v[j].x = bf_lo(h.x) + bf_lo(l.x); v[j].y = bf_hi(h.x) + bf_hi(l.x); v[j].z = bf_lo(h.y) + bf_lo(l.y); v[j].w = bf_hi(h.y) + bf_hi(l.y);
            s += (v[j].x * v[j].x + v[j].y * v[j].y) + (v[j].z * v[j].z + v[j].w * v[j].w); }
        const float rstd = 1.0f / sqrtf(wave_sum_v(s) * (1.f / DM) + NORM_EPS);
        GAS f32x4* xo = (GAS f32x4*)(out + (size_t)m * DM) + lane;
#pragma unroll
        for (int j = 0; j < 8; ++j) xo[64 * j] = v[j] * rstd * gv[j];
#pragma unroll
        for (int j = 0; j < 8; ++j) hc[j] = hn[j];
    }
}
__device__ __forceinline__ unsigned q4(float a, float b, float c, float d) { return ((unsigned)(int)__builtin_rintf(a) & 255u) | (((unsigned)(int)__builtin_rintf(b) & 255u) << 8) | (((unsigned)(int)__builtin_rintf(c) & 255u) << 16) | ((unsigned)(int)__builtin_rintf(d) << 24); }
template <int NCH>
__device__ __forceinline__ void quant_rows(const bf16* src, int ld, signed char* dst, float* step, int nrows, int gw, int NGW, int lane) {
    v4u c[NCH];
    if (gw < nrows) { const GAS v4u* ps = (const GAS v4u*)(src + (size_t)gw * ld) + lane;
#pragma unroll
        for (int j = 0; j < NCH; ++j) c[j] = ps[64 * j]; }
    for (int m = gw; m < nrows; m += NGW) {
        v4u n[NCH]; const int mn = m + NGW < nrows ? m + NGW : m;
        { const GAS v4u* ps = (const GAS v4u*)(src + (size_t)mn * ld) + lane;
#pragma unroll
          for (int j = 0; j < NCH; ++j) n[j] = ps[64 * j]; }
        float mx = 0.f;
#pragma unroll
        for (int j = 0; j < NCH; ++j) mx = fmaxf(mx, fmaxf(fmaxf(fmaxf(fabsf(bf_lo(c[j].x)), fabsf(bf_hi(c[j].x))), fmaxf(fabsf(bf_lo(c[j].y)), fabsf(bf_hi(c[j].y)))), fmaxf(fmaxf(fabsf(bf_lo(c[j].z)), fabsf(bf_hi(c[j].z))), fmaxf(fabsf(bf_lo(c[j].w)), fabsf(bf_hi(c[j].w))))));
        mx = wave_max_v(mx);
        const float inv = mx > 0.f ? 127.0f / mx : 0.f;
        GAS v2u* pd = (GAS v2u*)(dst + (size_t)m * (NCH * 512)) + lane;
#pragma unroll
        for (int j = 0; j < NCH; ++j) { v2u o; o.x = q4(bf_lo(c[j].x) * inv, bf_hi(c[j].x) * inv, bf_lo(c[j].y) * inv, bf_hi(c[j].y) * inv); o.y = q4(bf_lo(c[j].z) * inv, bf_hi(c[j].z) * inv, bf_lo(c[j].w) * inv, bf_hi(c[j].w) * inv); pd[64 * j] = o; }
        if (lane == 0) ((GAS float*)step)[m] = mx * (1.0f / 127.0f);
#pragma unroll
        for (int j = 0; j < NCH; ++j) c[j] = n[j];
    }
}
template <int NCH>
__device__ __forceinline__ void quant_weight(const bf16* src, int ld, signed char* dst, float* cstep, int nrows, int gw, int NGW, int lane) {
    for (int m = gw; m < nrows; m += NGW) { const GAS v4u* ps = (const GAS v4u*)(src + (size_t)m * ld) + lane; GAS v2u* pd = (GAS v2u*)(dst + (size_t)m * (NCH * 512)) + lane; v4u c[NCH];
#pragma unroll
        for (int j = 0; j < NCH; ++j) c[j] = ps[64 * j];
        float mx = 0.f;
#pragma unroll
        for (int j = 0; j < NCH; ++j) mx = fmaxf(mx, fmaxf(fmaxf(fmaxf(fabsf(bf_lo(c[j].x)), fabsf(bf_hi(c[j].x))), fmaxf(fabsf(bf_lo(c[j].y)), fabsf(bf_hi(c[j].y)))), fmaxf(fmaxf(fabsf(bf_lo(c[j].z)), fabsf(bf_hi(c[j].z))), fmaxf(fabsf(bf_lo(c[j].w)), fabsf(bf_hi(c[j].w))))));
        mx = wave_max_v(mx);
        const float inv = mx > 0.f ? 127.0f / mx : 0.f;
#pragma unroll
        for (int j = 0; j < NCH; ++j) { v2u o; o.x = q4(bf_lo(c[j].x) * inv, bf_hi(c[j].x) * inv, bf_lo(c[j].y) * inv, bf_hi(c[j].y) * inv); o.y = q4(bf_lo(c[j].z) * inv, bf_hi(c[j].z) * inv, bf_lo(c[j].w) * inv, bf_hi(c[j].w) * inv); pd[64 * j] = o; }
        if (lane == 0) ((GAS float*)cstep)[m] = mx * (1.0f / 127.0f); }
}
struct SJob { const float* W; const float* gain; signed char* dst; float* cstep; int K, ldw, scol0, drow0, ncols, hasg; };
constexpr int NSJOBS = 14;
__device__ __forceinline__ SJob make_sjob(KArgs a, int j) {
    SJob J; unsigned char* ws = a->ws; J.W = nullptr; J.gain = a->in[I_ATTN_NORM]; J.hasg = 0; J.dst = nullptr; J.cstep = nullptr; J.K = DM; J.ldw = DM; J.scol0 = 0; J.drow0 = 0; J.ncols = 0;
    float* cst = (float*)(ws + WS_CSTEP);
    if (j < 4) { if ((UP_I8_MASK >> j) & 1) { J.W = a->in[I_WUP] + (size_t)j * DM * FF; J.gain = a->in[I_MLP_NORM] + j * DM; J.hasg = 1; J.dst = (signed char*)(ws + WS_WUP) + (size_t)j * FF * DM * 2; J.cstep = (float*)(J.dst + (size_t)FF * DM); J.ldw = FF; J.ncols = FF; } return J; }
    const int i = (j - 4) / 5, sub = (j - 4) % 5;
    if (sub < 2) { if ((IN_I8_MASK >> (2 * i)) & 1) { J.W = a->in[I_EV_WIN] + (size_t)i * DM * 4160; J.gain = a->in[I_ATTN_NORM] + (2 * i) * DM; J.hasg = 1; J.dst = (signed char*)(ws + WS_WQINE) + (size_t)i * 4096 * DM; J.cstep = cst + CS_INE + i * 4096; J.ldw = 4160;
                       if (sub == 0) { J.scol0 = 0; J.drow0 = 0; J.ncols = 1024; } else { J.scol0 = 1088; J.drow0 = 1024; J.ncols = 3072; } } return J; }
    if (sub == 2) { if ((IN_I8_MASK >> (2 * i + 1)) & 1) { J.W = a->in[I_OD_WIN] + (size_t)i * DM * NZO; J.gain = a->in[I_ATTN_NORM] + (2 * i + 1) * DM; J.hasg = 1; J.dst = (signed char*)(ws + WS_WQINO) + (size_t)i * NZO * DM; J.cstep = cst + CS_INO + i * NZO; J.ldw = NZO; J.ncols = NZO; } return J; }
    if (sub == 3) { J.W = a->in[I_EV_WOUT] + (size_t)i * NCAT_E * DM; J.dst = (signed char*)(ws + WS_WQOUTE) + (size_t)i * DM * NCAT_E; J.cstep = cst + CS_OUTE + i * DM; J.K = NCAT_E; J.ncols = DM; return J; }
    J.W = a->in[I_OD_WOUT] + (size_t)i * NCAT_O * DM; J.dst = (signed char*)(ws + WS_WQOUTO) + (size_t)i * DM * NCAT_O; J.cstep = cst + CS_OUTO + i * DM; J.K = NCAT_O; J.ncols = DM; return J;
}
__device__ __forceinline__ void slab_load(const SJob& J, int slab, int bt, int tid, f32x4 (&v)[4][2], float (&g)[4][2]) {
    const int c4 = tid & 7, rp = tid >> 3;
#pragma unroll
    for (int it = 0; it < 4; ++it) { const int k = bt * 512 + it * 128 + 2 * rp; g[it][0] = ((const GAS float*)J.gain)[k]; g[it][1] = ((const GAS float*)J.gain)[k + 1]; }
    const GAS float* W = (const GAS float*)J.W + (size_t)(bt * 512 + 2 * rp) * J.ldw + J.scol0 + 32 * slab + 4 * c4;
#pragma unroll
    for (int it = 0; it < 4; ++it) { const GAS float* p = W + (size_t)(it * 128) * J.ldw; v[it][0] = __builtin_nontemporal_load((const GAS f32x4*)p); v[it][1] = __builtin_nontemporal_load((const GAS f32x4*)(p + J.ldw)); }
}
__device__ __forceinline__ void slab_phase(KArgs a, LAS unsigned char* lds, int tid) {
    constexpr int PD = 1026;
    LAS unsigned* T = (LAS unsigned*)(lds + RING_OFF); LAS float* wmax = (LAS float*)(T + 32 * PD);
    const int c4 = tid & 7, rp = tid >> 3, wave = __builtin_amdgcn_readfirstlane(tid >> 6), lane = tid & 63;
    int total = 0;
    for (int j = 0; j < NSJOBS; ++j) total += make_sjob(a, j).ncols / 32;
    int s = blockIdx.x; if (s >= total) return;
    int jc = 0, basec = 0; SJob J = make_sjob(a, 0);
#define SLAB_LOCATE(si) do { while ((si) - basec >= J_.ncols / 32) { basec += J_.ncols / 32; ++jc; J_ = make_sjob(a, jc); } } while (0)
    { SJob J_ = J; SLAB_LOCATE(s); J = J_; }
    int sl = s - basec;
    f32x4 v[4][2]; float g[4][2];
    slab_load(J, sl, 0, tid, v, g);
#pragma unroll 1
    for (;;) {
        const int sn = s + (int)gridDim.x; const bool has_next = sn < total;
        SJob Jn = J; int sln = 0;
        if (has_next) { SJob J_ = J; SLAB_LOCATE(sn); Jn = J_; sln = sn - basec; }
        float mx0 = 0.f, mx1 = 0.f, mx2 = 0.f, mx3 = 0.f; const int nb = J.K / 512;
#pragma unroll 1
        for (int bt = 0; bt < nb; ++bt) {
            f32x4 vn[4][2]; float gn[4][2];
            { const bool more = bt + 1 < nb; SJob Jl = more || !has_next ? J : Jn; slab_load(Jl, more || !has_next ? sl : sln, more ? bt + 1 : (has_next ? 0 : bt), tid, vn, gn); }
#pragma unroll
            for (int it = 0; it < 4; ++it) { const int kd = bt * 256 + it * 64 + rp; const float g0 = J.hasg ? g[it][0] : 1.f, g1 = J.hasg ? g[it][1] : 1.f;
                const unsigned d0 = pk2(v[it][0][0] * g0, v[it][1][0] * g1), d1 = pk2(v[it][0][1] * g0, v[it][1][1] * g1), d2 = pk2(v[it][0][2] * g0, v[it][1][2] * g1), d3 = pk2(v[it][0][3] * g0, v[it][1][3] * g1);
                T[(4 * c4 + 0) * PD + kd] = d0; T[(4 * c4 + 1) * PD + kd] = d1; T[(4 * c4 + 2) * PD + kd] = d2; T[(4 * c4 + 3) * PD + kd] = d3;
                mx0 = fmaxf(mx0, fmaxf(fabsf(bf_lo(d0)), fabsf(bf_hi(d0)))); mx1 = fmaxf(mx1, fmaxf(fabsf(bf_lo(d1)), fabsf(bf_hi(d1)))); mx2 = fmaxf(mx2, fmaxf(fabsf(bf_lo(d2)), fabsf(bf_hi(d2)))); mx3 = fmaxf(mx3, fmaxf(fabsf(bf_lo(d3)), fabsf(bf_hi(d3)))); }
            __builtin_amdgcn_sched_barrier(0);
#pragma unroll
            for (int it = 0; it < 4; ++it) { v[it][0] = vn[it][0]; v[it][1] = vn[it][1]; g[it][0] = gn[it][0]; g[it][1] = gn[it][1]; }
        }
#pragma unroll
        for (int o = 8; o < 64; o <<= 1) { mx0 = fmaxf(mx0, __shfl_xor(mx0, o)); mx1 = fmaxf(mx1, __shfl_xor(mx1, o)); mx2 = fmaxf(mx2, __shfl_xor(mx2, o)); mx3 = fmaxf(mx3, __shfl_xor(mx3, o)); }
        if (lane < 8) { wmax[wave * 32 + 4 * lane + 0] = mx0; wmax[wave * 32 + 4 * lane + 1] = mx1; wmax[wave * 32 + 4 * lane + 2] = mx2; wmax[wave * 32 + 4 * lane + 3] = mx3; }
        __syncthreads();
#pragma unroll 1
        for (int cc = 0; cc < 4; ++cc) { const int col = 4 * wave + cc; float mx = 0.f;
#pragma unroll
            for (int w2 = 0; w2 < 8; ++w2) mx = fmaxf(mx, wmax[w2 * 32 + col]);
            const float inv = mx > 0.f ? 127.0f / mx : 0.f; const int n = J.drow0 + 32 * sl + col; GAS v2u* pd = (GAS v2u*)(J.dst + (size_t)n * J.K) + lane;
#pragma unroll 1
            for (int ch = 0; ch < nb; ++ch) { const LAS v2u* sp = (const LAS v2u*)(T + col * PD + ch * 256 + lane * 4); const v2u x = sp[0], y = sp[1];
                v2u o; o.x = q4(bf_lo(x.x) * inv, bf_hi(x.x) * inv, bf_lo(x.y) * inv, bf_hi(x.y) * inv); o.y = q4(bf_lo(y.x) * inv, bf_hi(y.x) * inv, bf_lo(y.y) * inv, bf_hi(y.y) * inv); pd[64 * ch] = o; }
            if (lane == 0) ((GAS float*)J.cstep)[n] = mx * (1.0f / 127.0f); }
        __syncthreads();
        if (!has_next) break;
        J = Jn; sl = sln; s = sn;
    }
#undef SLAB_LOCATE
}
__device__ __forceinline__ unsigned q4u(float a, float b, float c, float d) { return ((unsigned)((int)__builtin_rintf(a) - 128) & 255u) | (((unsigned)((int)__builtin_rintf(b) - 128) & 255u) << 8) | (((unsigned)((int)__builtin_rintf(c) - 128) & 255u) << 16) | ((unsigned)((int)__builtin_rintf(d) - 128) << 24); }
__device__ __forceinline__ void quant_hidden(bf16* U, float* step, int gw, int NGW, int lane) {
    for (int m = gw; m < MTOK; m += NGW) { const GAS v4u* ps = (const GAS v4u*)(U + (size_t)m * FF) + lane; v4u c[16];
#pragma unroll
        for (int j = 0; j < 16; ++j) c[j] = ps[64 * j];
        float mx = 0.f;
#pragma unroll
        for (int j = 0; j < 16; ++j) mx = fmaxf(mx, fmaxf(fmaxf(fmaxf(bf_lo(c[j].x), bf_hi(c[j].x)), fmaxf(bf_lo(c[j].y), bf_hi(c[j].y))), fmaxf(fmaxf(bf_lo(c[j].z), bf_hi(c[j].z)), fmaxf(bf_lo(c[j].w), bf_hi(c[j].w)))));
        mx = wave_max_v(mx);
        const float inv = mx > 0.f ? 255.0f / mx : 0.f;
        asm volatile("s_waitcnt vmcnt(0)" ::: "memory");
        GAS v2u* pd = (GAS v2u*)((signed char*)(U + (size_t)m * FF)) + lane;
#pragma unroll
        for (int j = 0; j < 16; ++j) { v2u o; o.x = q4u(bf_lo(c[j].x) * inv, bf_hi(c[j].x) * inv, bf_lo(c[j].y) * inv, bf_hi(c[j].y) * inv); o.y = q4u(bf_lo(c[j].z) * inv, bf_hi(c[j].z) * inv, bf_lo(c[j].w) * inv, bf_hi(c[j].w) * inv); pd[64 * j] = o; }
        if (lane == 0) ((GAS float*)step)[m] = mx * (1.0f / 255.0f); }
}
__device__ __forceinline__ unsigned rq4(unsigned w, float ratio) {
    const float a = (float)((int)(signed char)(w & 255u) + 128) * ratio, b = (float)((int)(signed char)((w >> 8) & 255u) + 128) * ratio, c = (float)((int)(signed char)((w >> 16) & 255u) + 128) * ratio, d = (float)((int)(signed char)(w >> 24) + 128) * ratio;
    return q4u(a, b, c, d); }
__device__ __forceinline__ void requant_hidden(unsigned char* U8, const float* bs, float* step, int gw, int NGW, int lane) {
    for (int m = gw; m < MTOK; m += NGW) { GAS v4u* ps = (GAS v4u*)(U8 + (size_t)m * 8192) + lane; const GAS float* bp = (const GAS float*)bs + (size_t)m * 128; v4u c[8]; float bsv[8];
#pragma unroll
        for (int j = 0; j < 8; ++j) { c[j] = ps[64 * j]; bsv[j] = bp[j * 16 + (lane >> 2)]; }
        float mx = fmaxf(bp[lane], bp[64 + lane]);
        mx = wave_max_v(mx);
        const float inv = mx > 0.f ? 1.0f / mx : 0.f;
#pragma unroll
        for (int j = 0; j < 8; ++j) { const float ratio = bsv[j] * inv; v4u o; o.x = rq4(c[j].x, ratio); o.y = rq4(c[j].y, ratio); o.z = rq4(c[j].z, ratio); o.w = rq4(c[j].w, ratio); ps[64 * j] = o; }
        if (lane == 0) ((GAS float*)step)[m] = mx; }
}
__device__ __forceinline__ int q1i(float a) { return (int)__builtin_rintf(a); }
__device__ __forceinline__ void quant_weight_dn(const bf16* src, signed char* dst, float* cstep, float* coff, int gw, int NGW, int lane) {
    for (int m = gw; m < DM; m += NGW) { const GAS v4u* ps = (const GAS v4u*)(src + (size_t)m * FF) + lane; GAS v2u* pd = (GAS v2u*)(dst + (size_t)m * FF) + lane; v4u c[16];
#pragma unroll
        for (int j = 0; j < 16; ++j) c[j] = ps[64 * j];
        float mx = 0.f;
#pragma unroll
        for (int j = 0; j < 16; ++j) mx = fmaxf(mx, fmaxf(fmaxf(fmaxf(fabsf(bf_lo(c[j].x)), fabsf(bf_hi(c[j].x))), fmaxf(fabsf(bf_lo(c[j].y)), fabsf(bf_hi(c[j].y)))), fmaxf(fmaxf(fabsf(bf_lo(c[j].z)), fabsf(bf_hi(c[j].z))), fmaxf(fabsf(bf_lo(c[j].w)), fabsf(bf_hi(c[j].w))))));
        mx = wave_max_v(mx);
        const float inv = mx > 0.f ? 127.0f / mx : 0.f; float sum = 0.f;
#pragma unroll
        for (int j = 0; j < 16; ++j) { const int q0 = q1i(bf_lo(c[j].x) * inv), q1 = q1i(bf_hi(c[j].x) * inv), q2 = q1i(bf_lo(c[j].y) * inv), q3 = q1i(bf_hi(c[j].y) * inv), q4_ = q1i(bf_lo(c[j].z) * inv), q5 = q1i(bf_hi(c[j].z) * inv), q6 = q1i(bf_lo(c[j].w) * inv), q7 = q1i(bf_hi(c[j].w) * inv);
            sum += (float)(((q0 + q1) + (q2 + q3)) + ((q4_ + q5) + (q6 + q7)));
            v2u o; o.x = ((unsigned)q0 & 255u) | (((unsigned)q1 & 255u) << 8) | (((unsigned)q2 & 255u) << 16) | ((unsigned)q3 << 24); o.y = ((unsigned)q4_ & 255u) | (((unsigned)q5 & 255u) << 8) | (((unsigned)q6 & 255u) << 16) | ((unsigned)q7 << 24); pd[64 * j] = o; }
        sum = wave_sum_v(sum);
        if (lane == 0) { ((GAS float*)cstep)[m] = mx * (1.0f / 127.0f); ((GAS float*)coff)[m] = 128.0f * sum; } }
}
__device__ __forceinline__ void prep_rstab_z(const bf16* Zc, int zld, int pm, LAS float* rstab, int tid) {
    const int wave = __builtin_amdgcn_readfirstlane(tid >> 6), lane = tid & 63;
#pragma unroll 1
    for (int hf = 0; hf < 2; ++hf) { v4u w[16];
#pragma unroll
        for (int i = 0; i < 16; ++i) w[i] = *(const GAS v4u*)(Zc + (size_t)(pm * 256 + wave * 32 + hf * 16 + i) * zld + lane * 8);
#pragma unroll
        for (int i = 0; i < 16; ++i) { const v4u x = w[i];
            float s = ((bf_lo(x.x) * bf_lo(x.x) + bf_hi(x.x) * bf_hi(x.x)) + (bf_lo(x.y) * bf_lo(x.y) + bf_hi(x.y) * bf_hi(x.y))) + ((bf_lo(x.z) * bf_lo(x.z) + bf_hi(x.z) * bf_hi(x.z)) + (bf_lo(x.w) * bf_lo(x.w) + bf_hi(x.w) * bf_hi(x.w)));
            s = wave_sum_v(s);
            if (lane == 0) rstab[wave * 32 + hf * 16 + i] = 1.0f / sqrtf(s * (1.f / 512) + NORM_EPS); } }
    __syncthreads();
}
__device__ __forceinline__ void prep_rstab(const float* part, int pm, LAS float* rstab, int tid) {
    const int row = tid >> 1, half = tid & 1; const GAS f32x4* pp = (const GAS f32x4*)(part + (size_t)(pm * 256 + row) * 32 + half * 16);
    const f32x4 a = pp[0], b = pp[1], c = pp[2], d = pp[3];
    float s = (((a[0] + a[1]) + (a[2] + a[3])) + ((b[0] + b[1]) + (b[2] + b[3]))) + (((c[0] + c[1]) + (c[2] + c[3])) + ((d[0] + d[1]) + (d[2] + d[3])));
    s = DPP_ADD(s, 0xB1);
    if (half == 0) rstab[row] = 1.0f / sqrtf(s * (1.f / DM) + NORM_EPS);
    __syncthreads();
}
__device__ __forceinline__ void prep_rstab_q(const float* part, const float* qrow, int pm, LAS float* rstab, int tid) {
    const int row = tid >> 1, half = tid & 1; const GAS f32x4* pp = (const GAS f32x4*)(part + (size_t)(pm * 256 + row) * 32 + half * 16);
    const f32x4 a = pp[0], b = pp[1], c = pp[2], d = pp[3];
    float s = (((a[0] + a[1]) + (a[2] + a[3])) + ((b[0] + b[1]) + (b[2] + b[3]))) + (((c[0] + c[1]) + (c[2] + c[3])) + ((d[0] + d[1]) + (d[2] + d[3])));
    s = DPP_ADD(s, 0xB1);
    if (half == 0) rstab[row] = (1.0f / sqrtf(s * (1.f / DM) + NORM_EPS)) * ((const GAS float*)qrow)[pm * 256 + row];
    __syncthreads();
}
__device__ __forceinline__ void latent_phase(KArgs a, int ev, LAS unsigned char* lds, int gw, int NGW, int wave, int lane) {
    const bf16* Z = (const bf16*)(a->ws + WS_Z); bf16* KBp = (bf16*)(a->ws + WS_KB); bf16* KM = (bf16*)(a->ws + WS_KM);
    const GAS float* ct = (const GAS float*)(a->ws + WS_ROPE); const GAS float* st = ct + SEQ * 32;
    { typedef short bf16x8_t __attribute__((ext_vector_type(8))); typedef float f32x16_t __attribute__((ext_vector_type(16)));
      const bf16* Hb = (const bf16*)(a->ws + WS_H); const float* PBp = (const float*)(a->ws + WS_PB);     const bf16* Wpe = (const bf16*)(a->ws + WS_WINE) + (size_t)ev * NZE * DM + (size_t)4096 * DM;
      LAS float* red = (LAS float*)(lds + RING_OFF);
      const int r32 = lane & 31, hi = lane >> 5;
      for (int chunk = blockIdx.x; chunk < MTOK / 32; chunk += gridDim.x) { const int row0 = chunk * 32;
          f32x16_t c0 = {}, c1 = {};
          const bf16* ap = Hb + (size_t)(row0 + r32) * DM + wave * 256 + hi * 8; const bf16* bp0 = Wpe + (size_t)r32 * DM + wave * 256 + hi * 8; const bf16* bp1 = bp0 + (size_t)32 * DM;
#pragma unroll
          for (int ks = 0; ks < 16; ++ks) { const bf16x8_t av = *(const GAS bf16x8_t*)(ap + ks * 16), b0 = *(const GAS bf16x8_t*)(bp0 + ks * 16), b1 = *(const GAS bf16x8_t*)(bp1 + ks * 16);
              c0 = __builtin_amdgcn_mfma_f32_32x32x16_bf16(av, b0, c0, 0, 0, 0); c1 = __builtin_amdgcn_mfma_f32_32x32x16_bf16(av, b1, c1, 0, 0, 0); }
#pragma unroll
          for (int r = 0; r < 16; ++r) { red[(wave * 32 + r) * 64 + lane] = c0[r]; red[(wave * 32 + 16 + r) * 64 + lane] = c1[r]; }
          __syncthreads();
#pragma unroll
          for (int rr = 0; rr < 2; ++rr) { const int r = 2 * wave + rr; float x1 = 0.f, x2 = 0.f;
#pragma unroll
              for (int w = 0; w < 8; ++w) { x1 += red[(w * 32 + r) * 64 + lane]; x2 += red[(w * 32 + 16 + r) * 64 + lane]; }
              const int tok = row0 + (r & 3) + 8 * (r >> 2) + 4 * hi, pos = tok & (SEQ - 1); const float c = ct[pos * 32 + r32], s = st[pos * 32 + r32];
              { float ssq = ((const GAS float*)PBp)[(size_t)tok * 32 + r32];
                ssq = DPP_ADD(ssq, 0xB1); ssq = DPP_ADD(ssq, 0x4E); ssq = DPP_ADD(ssq, 0x141); ssq = DPP_ADD(ssq, 0x140);
                { auto rr2 = __builtin_amdgcn_permlane16_swap(__float_as_uint(ssq), __float_as_uint(ssq), false, false); ssq = __uint_as_float(rr2[0]) + __uint_as_float(rr2[1]); }
                const float rstd = 1.0f / sqrtf(ssq * (1.f / DM) + NORM_EPS); x1 *= rstd; x2 *= rstd; }
              const bf16 o1 = (bf16)f2bf(x1 * c - x2 * s), o2 = (bf16)f2bf(x2 * c + x1 * s);
#pragma unroll
              for (int h = 0; h < 8; ++h) { ((GAS bf16*)KBp)[(size_t)tok * 1536 + h * 192 + 128 + r32] = o1; ((GAS bf16*)KBp)[(size_t)tok * 1536 + h * 192 + 160 + r32] = o2; } }
          __syncthreads(); } }
    { float* KTN = (float*)(a->ws + WS_KTN);
      for (int t = gw; t < BATCH * 8 * 64; t += NGW) { const int tile = t & 63, h = (t >> 6) & 7, b = t >> 9;
          const bf16* kp = Z + (size_t)(b * SEQ + tile * 64 + lane) * NZE + ZE_KB + h * 128; float s = 0.f;
#pragma unroll
          for (int c = 0; c < 16; ++c) { const v4u w = *(const GAS v4u*)(kp + c * 8);
              s += bf_lo(w.x) * bf_lo(w.x) + bf_hi(w.x) * bf_hi(w.x) + bf_lo(w.y) * bf_lo(w.y) + bf_hi(w.y) * bf_hi(w.y) + bf_lo(w.z) * bf_lo(w.z) + bf_hi(w.z) * bf_hi(w.z) + bf_lo(w.w) * bf_lo(w.w) + bf_hi(w.w) * bf_hi(w.w); }
          s = wave_max_v(s);
          if (lane == 0) KTN[(size_t)(b * 8 + h) * 64 + tile] = sqrtf(s) * 1.0001f; } }
    { LAS float* red = (LAS float*)(lds + RING_OFF);
      const int rr = lane >> 4, cc = lane & 15;
      for (int st = gw; st < BATCH * 16 * 8 * 4; st += NGW) { const int t = st >> 2, sub = st & 3, h = t & 7, n = (t >> 3) & 15, b = t >> 7;
          const bf16* kp = Z + (size_t)(b * SEQ + n * 256 + sub * 64 + rr) * NZE + ZE_KB + h * 128 + cc * 8; v4u w[16];
#pragma unroll
          for (int i = 0; i < 16; ++i) w[i] = *(const GAS v4u*)(kp + (size_t)(4 * i) * NZE);
          float s[8] = {0.f, 0.f, 0.f, 0.f, 0.f, 0.f, 0.f, 0.f};
#pragma unroll
          for (int i = 0; i < 16; ++i) { s[0] += bf_lo(w[i].x); s[1] += bf_hi(w[i].x); s[2] += bf_lo(w[i].y); s[3] += bf_hi(w[i].y); s[4] += bf_lo(w[i].z); s[5] += bf_hi(w[i].z); s[6] += bf_lo(w[i].w); s[7] += bf_hi(w[i].w); }
#pragma unroll
          for (int j = 0; j < 8; ++j) {
              { auto r = __builtin_amdgcn_permlane16_swap(__float_as_uint(s[j]), __float_as_uint(s[j]), false, false); s[j] = __uint_as_float(r[0]) + __uint_as_float(r[1]); }
              { auto r = __builtin_amdgcn_permlane32_swap(__float_as_uint(s[j]), __float_as_uint(s[j]), false, false); s[j] = __uint_as_float(r[0]) + __uint_as_float(r[1]); } }
          if (rr == 0) {
#pragma unroll
              for (int j = 0; j < 8; ++j) red[wave * 128 + cc * 8 + j] = s[j]; }
          __syncthreads();
          if (sub == 0) { const float m0 = (red[wave * 128 + lane * 2] + red[(wave + 1) * 128 + lane * 2]) + (red[(wave + 2) * 128 + lane * 2] + red[(wave + 3) * 128 + lane * 2]);
              const float m1 = (red[wave * 128 + lane * 2 + 1] + red[(wave + 1) * 128 + lane * 2 + 1]) + (red[(wave + 2) * 128 + lane * 2 + 1] + red[(wave + 3) * 128 + lane * 2 + 1]);
              *(GAS unsigned*)(KM + ((size_t)((b * 8 + h) * 16 + n)) * 128 + lane * 2) = pk2(m0 * (1.f / 256), m1 * (1.f / 256)); }
          __syncthreads(); } }
}
__device__ __forceinline__ void qrope_phase(KArgs a, int gw, int NGW, int lane) {
    GAS bf16* Q = (GAS bf16*)(a->ws + WS_QMLA); const GAS float* ct = (const GAS float*)(a->ws + WS_ROPE); const GAS float* st = ct + SEQ * 32;
    for (int m = gw; m < MTOK; m += NGW) { const int pos = m & (SEQ - 1);
#pragma unroll
        for (int e = 0; e < 4; ++e) { const int p = e * 64 + lane, h = p >> 5, i = p & 31; GAS bf16* qp = Q + (size_t)m * NQMLA + h * 192 + 128 + i;
            const float x1 = bf1(qp[0]), x2 = bf1(qp[32]), c = ct[pos * 32 + i], s = st[pos * 32 + i];
            qp[0] = (bf16)f2bf(x1 * c - x2 * s); qp[32] = (bf16)f2bf(x2 * c + x1 * s); } }
}

__device__ __forceinline__ float dot8(const LAS float* q, v4u w) {
    return q[0] * bf_lo(w.x) + q[1] * bf_hi(w.x) + q[2] * bf_lo(w.y) + q[3] * bf_hi(w.y) + q[4] * bf_lo(w.z) + q[5] * bf_hi(w.z) + q[6] * bf_lo(w.w) + q[7] * bf_hi(w.w);
}
__device__ __forceinline__ float dot_row(const LAS float* q, const bf16* k, int n) { float s = 0.f; for (int c = 0; c < n; c += 8) s += dot8(q + c, *(const GAS v4u*)(k + c)); return s; }
__device__ __forceinline__ void load_q(LAS float* qs, const bf16* q, int n, int lane) { for (int c = lane; c < n; c += 64) qs[c] = bf1(((const GAS bf16*)q)[c]); LDS_WAIT(); asm volatile("" ::: "memory"); }
__device__ __forceinline__ float softmax_lds(LAS float* sc, int n, int lane, bool has_sink, float sink, float& lse) {
    float mx = has_sink ? sink : -__builtin_inff();
    for (int j = lane; j < n; j += 64) mx = fmaxf(mx, sc[j]);
    mx = wave_max_l(mx, lane); float sum = 0.f;
    for (int j = lane; j < n; j += 64) { const float p = __expf(sc[j] - mx); sc[j] = p; sum += p; }
    sum = wave_sum_l(sum, lane); if (has_sink) sum += __expf(sink - mx);
    LDS_WAIT(); asm volatile("" ::: "memory");
    lse = mx + __logf(sum);
    return 1.0f / sum;
}
__device__ __forceinline__ void naive_even_attn(KArgs a, LAS unsigned char* lds, int gw, int NGW, int wave, int lane) {
    LAS float* sc = (LAS float*)(lds + RING_OFF + wave * 16384); LAS float* qs = (LAS float*)(lds + QBUF_OFF + wave * 1024);
    const bf16* Z = (const bf16*)(a->ws + WS_Z); const bf16* QM = (const bf16*)(a->ws + WS_QMLA); const bf16* KBp = (const bf16*)(a->ws + WS_KB); const bf16* VBp = (const bf16*)(a->ws + WS_VB); const bf16* KM = (const bf16*)(a->ws + WS_KM);
    bf16* CAT = (bf16*)(a->ws + WS_CAT);
    for (int task = gw; task < MTOK * 16; task += NGW) {
        const int hh = task & 15, row = task >> 4, b = row >> 12, t = row & (SEQ - 1); float lse;
        if (hh < 8) {
            const int h = hh; load_q(qs, QM + (size_t)row * NQMLA + h * 192, 192, lane);
            const float scale = 0.07216878364870322f;
            for (int j = lane; j <= t; j += 64) { const size_t kr = (size_t)(b * SEQ + j);
                sc[j] = dot_row(qs, KBp + kr * 1536 + h * 192, 192) * scale; }
            LDS_WAIT(); asm volatile("" ::: "memory");
            const float inv = softmax_lds(sc, t + 1, lane, false, 0.f, lse);
            float o0 = 0.f, o1 = 0.f; const bf16* vp = VBp + (size_t)(b * SEQ) * 1024 + h * 128 + lane * 2;
            for (int j = 0; j <= t; ++j) { const unsigned w = *(const GAS unsigned*)(vp + (size_t)j * 1024); const float p = sc[j]; o0 += p * bf_lo(w); o1 += p * bf_hi(w); }
            *(GAS unsigned*)(CAT + (size_t)row * NCAT_E + h * 128 + lane * 2) = pk2(o0 * inv, o1 * inv);
        } else {
            const int h = hh - 8, own = t >> 8; load_q(qs, Z + (size_t)row * NZE + ZE_QB + h * 128, 128, lane);
            float g = -__builtin_inff();
            if (lane < own) g = dot_row(qs, KM + ((size_t)((b * 8 + h) * 16 + lane)) * 128, 128);
            int sel[4]; int nsel = 0;
#pragma unroll
            for (int r = 0; r < 3; ++r) { const float mx = wave_max_l(g, lane); const unsigned long long bal = __ballot(g == mx && mx > -__builtin_inff());
                if (bal) { const int idx = __builtin_ctzll(bal); sel[r] = idx; if (lane == idx) g = -__builtin_inff(); nsel = r + 1; } else sel[r] = -1; }
            sel[3] = own;
            const float scale = 0.08838834764831845f, slope = exp2f(-(float)(h + 1));
#pragma unroll
            for (int r = 0; r < 4; ++r) { const int n = sel[r];
                for (int jj = lane; jj < 256; jj += 64) { float s = -__builtin_inff();
                    if (n >= 0) { const int kpos = n * 256 + jj; if (kpos <= t) s = dot_row(qs, Z + (size_t)(b * SEQ + kpos) * NZE + ZE_KB + h * 128, 128) * scale - slope * (float)(t - kpos); }
                    sc[r * 256 + jj] = s; } }
            LDS_WAIT(); asm volatile("" ::: "memory");
            const float inv = softmax_lds(sc, 1024, lane, false, 0.f, lse);
            float o0 = 0.f, o1 = 0.f;
#pragma unroll
            for (int r = 0; r < 4; ++r) { const int n = sel[r]; if (n < 0) continue;
                const bf16* vp = Z + (size_t)(b * SEQ + n * 256) * NZE + ZE_VB + h * 128 + lane * 2; const int lim = (n == own) ? (t - n * 256 + 1) : 256;
                for (int jj = 0; jj < lim; ++jj) { const unsigned w = *(const GAS unsigned*)(vp + (size_t)jj * NZE); const float p = sc[r * 256 + jj]; o0 += p * bf_lo(w); o1 += p * bf_hi(w); } }
            *(GAS unsigned*)(CAT + (size_t)row * NCAT_E + 1024 + h * 128 + lane * 2) = pk2(o0 * inv, o1 * inv);
            (void)nsel;
        }
    }
}
__device__ __forceinline__ void naive_odd_attn(KArgs a, int od, LAS unsigned char* lds, int gw, int NGW, int wave, int lane) {
    LAS float* sc = (LAS float*)(lds + RING_OFF + wave * 16384); LAS float* qs = (LAS float*)(lds + QBUF_OFF + wave * 1024);
    const bf16* Z = (const bf16*)(a->ws + WS_Z); bf16* CAT = (bf16*)(a->ws + WS_CAT); bf16* OD = (bf16*)(a->ws + WS_OD); float* LSE = (float*)(a->ws + WS_LSE);
    const float* sinks = a->in[I_OD_SINKS] + od * 16;
    for (int task = gw; task < MTOK * 28; task += NGW) {
        const int row = task / 28, hh = task - row * 28, b = row >> 12, t = row & (SEQ - 1); float lse;
        if (hh < 12) {
            const int g = hh >> 2, j4 = hh & 3, dil = (g == 0) ? 1 : (g == 1 ? 4 : 16);
            load_q(qs, Z + (size_t)row * NZO + ZO_QC + hh * 128, 128, lane);
            const float scale = 0.08838834764831845f, slope = exp2f(-8.0f * (float)(hh + 1) / 12.0f);
            for (int k = lane; k < 129; k += 64) { const int kpos = t - dil * k; float s = -__builtin_inff();
                if (kpos >= 0) s = dot_row(qs, Z + (size_t)(b * SEQ + kpos) * NZO + ZO_KC + hh * 128, 128) * scale - slope * (float)(dil * k);
                sc[k] = s; }
            LDS_WAIT(); asm volatile("" ::: "memory");
            const float inv = softmax_lds(sc, 129, lane, false, 0.f, lse);
            float o0 = 0.f, o1 = 0.f;
            for (int k = 0; k < 129; ++k) { const int kpos = t - dil * k; if (kpos < 0) break;
                const unsigned w = *(const GAS unsigned*)(Z + (size_t)(b * SEQ + kpos) * NZO + ZO_VC + hh * 128 + lane * 2); const float p = sc[k]; o0 += p * bf_lo(w); o1 += p * bf_hi(w); }
            *(GAS unsigned*)(OD + ((size_t)g * MTOK + row) * 512 + j4 * 128 + lane * 2) = pk2(o0 * inv, o1 * inv);
            if (lane == 0) LSE[((size_t)g * MTOK + row) * 4 + j4] = lse;
        } else {
            const int hq = hh - 12, kvh = hq >> 3; load_q(qs, Z + (size_t)row * NZO + ZO_QD + hq * 64, 64, lane);
            const float scale = 0.125f, slope = exp2f(-0.5f * (float)(hq + 1)), sink = sinks[hq];
            for (int k = lane; k < 128; k += 64) { const int kpos = t - k; float s = -__builtin_inff();
                if (kpos >= 0) s = dot_row(qs, Z + (size_t)(b * SEQ + kpos) * NZO + ZO_KD + kvh * 64, 64) * scale - slope * (float)k;
                sc[k] = s; }
            LDS_WAIT(); asm volatile("" ::: "memory");
            const float inv = softmax_lds(sc, 128, lane, true, sink, lse);
            float o0 = 0.f;
            for (int k = 0; k < 128; ++k) { const int kpos = t - k; if (kpos < 0) break;
                o0 += sc[k] * bf1(((const GAS bf16*)Z)[(size_t)(b * SEQ + kpos) * NZO + ZO_VD + kvh * 64 + lane]); }
            ((GAS bf16*)CAT)[(size_t)row * NCAT_O + 512 + hq * 64 + lane] = (bf16)f2bf(o0 * inv);
        }
    }
}
__device__ __forceinline__ void merge_quant_phase(KArgs a, int gw, int NGW, int lane) {
    const bf16* OD = (const bf16*)(a->ws + WS_OD); const float* LSE = (const float*)(a->ws + WS_LSE); const bf16* CAT = (const bf16*)(a->ws + WS_CAT);
    signed char* CQ = (signed char*)(a->ws + WS_CATQ); float* CS = (float*)(a->ws + WS_CATQS);
    const int j4 = lane >> 4;
    for (int rb = gw; rb < MTOK; rb += 4 * NGW) {
        float ls[4][3]; v4u av[4][3], sw[4][2];
#pragma unroll
        for (int k = 0; k < 4; ++k) { const int row = rb + k * NGW < MTOK ? rb + k * NGW : rb;
#pragma unroll
            for (int g = 0; g < 3; ++g) { ls[k][g] = ((const GAS float*)LSE)[((size_t)g * MTOK + row) * 4 + j4]; av[k][g] = *(const GAS v4u*)(OD + ((size_t)g * MTOK + row) * 512 + lane * 8); }
            sw[k][0] = *(const GAS v4u*)(CAT + (size_t)row * NCAT_O + 512 + lane * 8); sw[k][1] = *(const GAS v4u*)(CAT + (size_t)row * NCAT_O + 1024 + lane * 8); }
#pragma unroll
        for (int k = 0; k < 4; ++k) { const int row = rb + k * NGW; if (row >= MTOK) break;
            const float l0 = ls[k][0], l1 = ls[k][1], l2 = ls[k][2]; const v4u a0 = av[k][0], a1 = av[k][1], a2 = av[k][2];
            const float mxl = fmaxf(l0, fmaxf(l1, l2)); float w0 = __expf(l0 - mxl), w1 = __expf(l1 - mxl), w2 = __expf(l2 - mxl); const float invw = 1.0f / (w0 + w1 + w2); w0 *= invw; w1 *= invw; w2 *= invw;
            float x[24];
            x[0] = w0 * bf_lo(a0.x) + w1 * bf_lo(a1.x) + w2 * bf_lo(a2.x); x[1] = w0 * bf_hi(a0.x) + w1 * bf_hi(a1.x) + w2 * bf_hi(a2.x);
            x[2] = w0 * bf_lo(a0.y) + w1 * bf_lo(a1.y) + w2 * bf_lo(a2.y); x[3] = w0 * bf_hi(a0.y) + w1 * bf_hi(a1.y) + w2 * bf_hi(a2.y);
            x[4] = w0 * bf_lo(a0.z) + w1 * bf_lo(a1.z) + w2 * bf_lo(a2.z); x[5] = w0 * bf_hi(a0.z) + w1 * bf_hi(a1.z) + w2 * bf_hi(a2.z);
            x[6] = w0 * bf_lo(a0.w) + w1 * bf_lo(a1.w) + w2 * bf_lo(a2.w); x[7] = w0 * bf_hi(a0.w) + w1 * bf_hi(a1.w) + w2 * bf_hi(a2.w);
#pragma unroll
            for (int c = 0; c < 2; ++c) { const v4u s = sw[k][c]; x[8 + 8 * c + 0] = bf_lo(s.x); x[8 + 8 * c + 1] = bf_hi(s.x); x[8 + 8 * c + 2] = bf_lo(s.y); x[8 + 8 * c + 3] = bf_hi(s.y);
                x[8 + 8 * c + 4] = bf_lo(s.z); x[8 + 8 * c + 5] = bf_hi(s.z); x[8 + 8 * c + 6] = bf_lo(s.w); x[8 + 8 * c + 7] = bf_hi(s.w); }
            float mx = 0.f;
#pragma unroll
            for (int i = 0; i < 24; ++i) mx = fmaxf(mx, fabsf(x[i]));
            mx = wave_max_v(mx);
            const float inv = mx > 0.f ? 127.0f / mx : 0.f;
            GAS v2u* pd = (GAS v2u*)(CQ + (size_t)row * NCAT_O) + lane;
#pragma unroll
            for (int c = 0; c < 3; ++c) { v2u o; o.x = q4(x[8 * c] * inv, x[8 * c + 1] * inv, x[8 * c + 2] * inv, x[8 * c + 3] * inv); o.y = q4(x[8 * c + 4] * inv, x[8 * c + 5] * inv, x[8 * c + 6] * inv, x[8 * c + 7] * inv); pd[64 * c] = o; }
            if (lane == 0) ((GAS float*)CS)[row] = mx * (1.0f / 127.0f); } }
}

#ifndef PROBE_DUP_DN
#define PROBE_DUP_DN 0
#endif
#ifndef PROBE_DUP_UP
#define PROBE_DUP_UP 0
#endif
#ifndef PROBE_DUP_EVATT
#define PROBE_DUP_EVATT 0
#endif
#ifndef PROBE_DUP_PRO
#define PROBE_DUP_PRO 0
#endif
#ifndef FAST_EVEN
#define FAST_EVEN 1
#endif
#ifndef FAST_ODD
#define FAST_ODD 1
#endif


namespace fa {
typedef short bf16x8 __attribute__((ext_vector_type(8)));
typedef short s16x4 __attribute__((ext_vector_type(4)));
typedef float f32x16 __attribute__((ext_vector_type(16)));
typedef unsigned u32x4 __attribute__((ext_vector_type(4)));
enum { MODE_CAUSAL = 0, MODE_MOBA = 1, MODE_BAND_LSE = 2, MODE_BAND_SINK = 3 };
struct Desc {
    const bf16* q; long q_rs;
    const bf16* k; long k_rs;
    const bf16* v; long v_rs;
    bf16* o; long o_rs;
    float* lse; long lse_rs;
    const bf16* km;
    const float* rope;
    const float* ktn;
    int q0, t_lo, t_hi, W, own;
    float c2, slc, sink2;
};
typedef float f32x2_t __attribute__((ext_vector_type(2))); typedef __bf16 bf16x2_t __attribute__((ext_vector_type(2)));
__device__ __forceinline__ unsigned cvtpk(float lo, float hi) { const f32x2_t v = {lo, hi}; const bf16x2_t b = __builtin_convertvector(v, bf16x2_t); return __builtin_bit_cast(unsigned, b); }
__device__ __forceinline__ int v_rd_base(int lane) { return ((lane & 3) << 3) | (((lane >> 2) & 3) << 6) | (((lane >> 4) & 1) << 5) | (((lane >> 5) & 1) << 8); }
template <int NCG> __device__ __forceinline__ int v_st(int k, int c) { const int kk = (k & ~0xC) | ((k & 4) << 1) | ((k & 8) >> 1); return ((kk >> 3) * NCG + (c >> 5)) * 512 + ((kk & 7) * 32 + (c & 31)) * 2; }

template <int DQK, int DV, int MODE>
__device__ __forceinline__ void attn_unit(const Desc& D, LAS unsigned char* lds, int tid) {
    constexpr int KPITCH = DQK * 2, SHM_K = 64 * KPITCH, SHM_V = 64 * DV * 2, NCG = DV / 32, NKS = DQK / 16, ND0 = DV / 32;
    constexpr int KCH = DQK / 8, NKC = 64 * KCH / 512, VCH = DV / 8, NVC = 64 * VCH / 512;
    constexpr int NOPE = (DQK >= 128) ? 128 : 0, ROPE = DQK - NOPE, NOPE_SLOTS = 64 * (NOPE / 8), NOPE_BYTES = 64 * NOPE * 2, NKS_N = NOPE / 16;
    static_assert(ROPE == 0 || ROPE == 64, "K tile images");
    constexpr int OFF_V = 0, OFF_K = 2 * SHM_V, OFF_G = 2 * SHM_V + 2 * SHM_K;
    constexpr bool BIAS = (MODE != MODE_CAUSAL);
    constexpr float THR2 = 11.0f;
    const int wid = __builtin_amdgcn_readfirstlane(tid >> 6), lane = tid & 63, r32 = lane & 31, hi = lane >> 5;
    const int grp = wid >> 2;
    const float NEG = -__builtin_inff();
    unsigned kgo[NKC], vgo[NVC];
#pragma unroll
    for (int i = 0; i < NKC; ++i) { const int s = (i * 8 + wid) * 64 + lane; int row, ch;
        if (s < NOPE_SLOTS) { row = s >> 4; ch = (s & 15) ^ (row & 15); }
        else { const int s2 = s - NOPE_SLOTS; row = s2 >> 3; ch = NOPE / 8 + ((s2 & 7) ^ ((row >> 1) & 7)); }
        kgo[i] = (unsigned)(row * (int)D.k_rs + ch * 8) * 2u; }
#pragma unroll
    for (int i = 0; i < NVC; ++i) { const int s = (i * 8 + wid) * 64 + lane, sub = s >> 5, kk = (sub / NCG) * 8 + ((s & 31) >> 2), c = (sub % NCG) * 32 + (s & 3) * 8, k = (kk & ~0xC) | ((kk & 4) << 1) | ((kk & 8) >> 1);
        vgo[i] = (unsigned)(k * (int)D.v_rs + c) * 2u; }
#define FA_TI(s) ((MODE == MODE_MOBA) ? (D.t_hi - 1 - (s)) : (D.t_lo + (s)))
#define FA_LOADK(s) do { const char* kt_ = (const char*)D.k + (size_t)FA_TI(s) * 64 * D.k_rs * 2; \
        _Pragma("unroll") for (int i = 0; i < NKC; ++i) __builtin_amdgcn_global_load_lds((const unsigned*)(kt_ + kgo[i]), (LAS unsigned*)(lds + OFF_K + ((s) & 1) * SHM_K + (i * 8 + wid) * 1024), 16, 0, 0); } while (0)
#define FA_LOADV(s) do { const char* vt_ = (const char*)D.v + (size_t)FA_TI(s) * 64 * D.v_rs * 2; \
        _Pragma("unroll") for (int i = 0; i < NVC; ++i) __builtin_amdgcn_global_load_lds((const unsigned*)(vt_ + vgo[i]), (LAS unsigned*)(lds + OFF_V + ((s) & 1) * SHM_V + (i * 8 + wid) * 1024), 16, 0, 0); } while (0)
    FA_LOADK(0); FA_LOADV(0);
    const int qi = D.q0 + wid * 32 + r32;
    bf16x8 qr[NKS];
    { const bf16* qp = D.q + (long)qi * D.q_rs + hi * 8;
#pragma unroll
      for (int d0 = 0; d0 < NKS; ++d0) qr[d0] = *(const GAS bf16x8*)(qp + d0 * 16); }
    if constexpr (MODE == MODE_CAUSAL && DQK == 192) {
#pragma unroll
        for (int dd = 0; dd < 2; ++dd) { const float* cp = D.rope + (size_t)qi * 32 + dd * 16 + hi * 8; const float* sp = cp + SEQ * 32;
            const f32x4 c0 = *(const GAS f32x4*)cp, c1 = *(const GAS f32x4*)(cp + 4), s0 = *(const GAS f32x4*)sp, s1 = *(const GAS f32x4*)(sp + 4);
            const float cc[8] = {c0[0], c0[1], c0[2], c0[3], c1[0], c1[1], c1[2], c1[3]}, ss[8] = {s0[0], s0[1], s0[2], s0[3], s1[0], s1[1], s1[2], s1[3]};
            const u32x4 a = __builtin_bit_cast(u32x4, qr[8 + dd]), b = __builtin_bit_cast(u32x4, qr[10 + dd]); u32x4 oa, ob;
#pragma unroll
            for (int w = 0; w < 4; ++w) { const float x1l = bf_lo(a[w]), x1h = bf_hi(a[w]), x2l = bf_lo(b[w]), x2h = bf_hi(b[w]);
                oa[w] = pk2(x1l * cc[2 * w] - x2l * ss[2 * w], x1h * cc[2 * w + 1] - x2h * ss[2 * w + 1]);
                ob[w] = pk2(x2l * cc[2 * w] + x1l * ss[2 * w], x2h * cc[2 * w + 1] + x1h * ss[2 * w + 1]); }
            qr[8 + dd] = __builtin_bit_cast(bf16x8, oa); qr[10 + dd] = __builtin_bit_cast(bf16x8, ob); }
    }
    const int qlo = D.q0 + wid * 32;
    float qn = 0.f;
    if constexpr (MODE == MODE_MOBA) {
#pragma unroll
        for (int d0 = 0; d0 < NKS; ++d0) { const u32x4 w = __builtin_bit_cast(u32x4, qr[d0]);
#pragma unroll
            for (int e = 0; e < 4; ++e) { const float lo = bf_lo(w[e]), hh = bf_hi(w[e]); qn = fmaf(lo, lo, fmaf(hh, hh, qn)); } }
        { auto rr = __builtin_amdgcn_permlane32_swap(__float_as_uint(qn), __float_as_uint(qn), false, false); qn = __uint_as_float(rr[0]) + __uint_as_float(rr[1]); }
        qn = sqrtf(qn) * 1.0001f;
    }
    const int kbN = r32 * 256, mmN = hi ^ (r32 & 15), kbR = NOPE_BYTES + r32 * 128, mmR = hi ^ ((r32 >> 1) & 7);
#define FA_KADDR(d0) (((d0) < NKS_N) ? (kbN + (((2 * (d0)) ^ mmN) << 4)) : (kbR + (((2 * ((d0) - NKS_N)) ^ mmR) << 4)))
#define FA_KHALF(d0) (((d0) < NKS_N) ? 32 * 256 : 32 * 128)
    constexpr int KPF = 3;
    const unsigned kb_lds = (unsigned)(uintptr_t)(lds + OFF_K);
#define FA_KRD2(R, base, d) do { const unsigned a_ = (base) + (unsigned)FA_KADDR(d); asm volatile("ds_read_b128 %0, %1" : "=v"(R[0]) : "v"(a_) : "memory"); \
        if ((d) < NKS_N) asm volatile("ds_read_b128 %0, %1 offset:8192" : "=v"(R[1]) : "v"(a_) : "memory"); else asm volatile("ds_read_b128 %0, %1 offset:4096" : "=v"(R[1]) : "v"(a_) : "memory"); } while (0)
    const int vb0 = (int)(unsigned)(uintptr_t)(lds + OFF_V) + v_rd_base(lane);

    unsigned selmask = 0u;
    if constexpr (MODE == MODE_MOBA) {
        if (D.own > 0) {
            if (tid < 256) { const int row = tid >> 4, ch = tid & 15; *(LAS bf16x8*)(lds + OFF_G + row * 256 + ((ch ^ (row & 15)) << 4)) = *(const GAS bf16x8*)(D.km + row * 128 + ch * 8); }
            __syncthreads();
            f32x16 gp = {};
#pragma unroll
            for (int d0 = 0; d0 < 8; ++d0) { const bf16x8 kf = *(const LAS bf16x8*)(lds + OFF_G + r32 * 256 + (((2 * d0) ^ hi ^ (r32 & 15)) << 4)); gp = __builtin_amdgcn_mfma_f32_32x32x16_bf16(kf, qr[d0], gp, 0, 0, 0); }
            float g[16];
#pragma unroll
            for (int r = 0; r < 8; ++r) { const unsigned x = __float_as_uint(gp[r]); auto sw = __builtin_amdgcn_permlane32_swap(x, x, false, false);
                g[(r & 3) + 8 * (r >> 2)] = __uint_as_float(sw[0]); g[(r & 3) + 8 * (r >> 2) + 4] = __uint_as_float(sw[1]); }
#pragma unroll
            for (int n = 0; n < 16; ++n) if (n >= D.own) g[n] = NEG;
#pragma unroll
            for (int pass = 0; pass < 3; ++pass) { float best = NEG; int bi = -1;
#pragma unroll
                for (int n = 0; n < 16; ++n) if (g[n] > best) { best = g[n]; bi = n; }
                if (bi >= 0) selmask |= 1u << bi;
#pragma unroll
                for (int n = 0; n < 16; ++n) if (n == bi) g[n] = NEG; }
        }
    }

    float m_reg = -1e30f, l_reg = 0.f; f32x16 o[ND0];
#pragma unroll
    for (int d0 = 0; d0 < ND0; ++d0) o[d0] = f32x16{};
    const int NT = D.t_hi - D.t_lo;
#define FA_TILE_FLAGS(t) const int buf = (t) & 1, kbase = FA_TI(t) * 64; bool act, need_mask; bool lane_sel = true; \
        if constexpr (MODE == MODE_MOBA) { const int n_ = kbase >> 8; \
            if (n_ < D.own) { const float ktm_ = D.ktn[kbase >> 6]; const float bnd_ = fmaf(qn * D.c2, ktm_, -D.slc * (float)(qi - kbase - 63)) + 1.0f; \
                lane_sel = ((selmask >> n_) & 1u) && (bnd_ - m_reg >= -151.0f); act = __any(lane_sel); need_mask = false; } \
            else { act = kbase <= qlo + 31; need_mask = kbase + 63 > qlo; } } \
        else { act = (kbase <= qlo + 31) && (kbase + 63 >= qlo - D.W + 1); need_mask = (kbase + 63 > qlo) || (kbase < qlo + 31 - D.W + 1); } \
        (void)buf; (void)need_mask; (void)lane_sel
#define FA_H1(t) do { FA_TILE_FLAGS(t); tact = act; if (act) { \
        p0 = f32x16{}; p1 = f32x16{}; \
        { const unsigned kbuf_ = kb_lds + (unsigned)(buf * SHM_K); bf16x8 kf[KPF][2];     \
          _Pragma("unroll") for (int j = 0; j < KPF; ++j) if (j < NKS) FA_KRD2(kf[j], kbuf_, j); \
          _Pragma("unroll") for (int d0 = 0; d0 < NKS; ++d0) { \
              const int rem_ = (NKS - 1 - d0) < (KPF - 1) ? (NKS - 1 - d0) : (KPF - 1); \
              if (rem_ >= 2) FA_LW(4); else if (rem_ == 1) FA_LW(2); else FA_LW(0); \
              p0 = __builtin_amdgcn_mfma_f32_32x32x16_bf16(kf[d0 % KPF][0], qr[d0], p0, 0, 0, 0); \
              p1 = __builtin_amdgcn_mfma_f32_32x32x16_bf16(kf[d0 % KPF][1], qr[d0], p1, 0, 0, 0); \
              if (d0 + KPF < NKS) FA_KRD2(kf[d0 % KPF], kbuf_, d0 + KPF); } } \
        const int dq = qi - kbase - 4 * hi;     \
        if constexpr (BIAS) { const float b0_ = -(float)dq * D.slc; \
            _Pragma("unroll") for (int r = 0; r < 16; ++r) { const float c = (float)((r & 3) + 8 * (r >> 2)); p0[r] = fmaf(p0[r], D.c2, fmaf(c, D.slc, b0_)); p1[r] = fmaf(p1[r], D.c2, fmaf(c + 32.f, D.slc, b0_)); } } \
          \
        if (need_mask) { _Pragma("unroll") for (int r = 0; r < 16; ++r) { const int c = (r & 3) + 8 * (r >> 2); \
            if ((unsigned)(dq - c) >= (unsigned)D.W) p0[r] = NEG; if ((unsigned)(dq - c - 32) >= (unsigned)D.W) p1[r] = NEG; } } \
        if constexpr (MODE == MODE_MOBA) { if (!lane_sel) { _Pragma("unroll") for (int r = 0; r < 16; ++r) { p0[r] = NEG; p1[r] = NEG; } } } \
        float pmax = p0[0]; \
        _Pragma("unroll") for (int r = 1; r < 16; ++r) pmax = fmaxf(pmax, p0[r]); \
        _Pragma("unroll") for (int r = 0; r < 16; ++r) pmax = fmaxf(pmax, p1[r]); \
        { auto rr = __builtin_amdgcn_permlane32_swap(__float_as_uint(pmax), __float_as_uint(pmax), false, false); pmax = fmaxf(__uint_as_float(rr[0]), __uint_as_float(rr[1])); } \
        if constexpr (!BIAS) pmax *= D.c2; \
        if (!__all(pmax - m_reg <= THR2)) {     \
            const float mn = fmaxf(m_reg, pmax), alpha = __builtin_amdgcn_exp2f(m_reg - mn); m_reg = mn; l_reg *= alpha; \
            _Pragma("unroll") for (int d0 = 0; d0 < ND0; ++d0) _Pragma("unroll") for (int r = 0; r < 16; ++r) o[d0][r] *= alpha; } \
          \
        _Pragma("unroll") for (int r = 0; r < 16; ++r) p0[r] = BIAS ? __builtin_amdgcn_exp2f(p0[r] - m_reg) : __builtin_amdgcn_exp2f(fmaf(p0[r], D.c2, -m_reg)); } } while (0)
#define FA_PK4(P, B_, OUT) do { const unsigned a0 = cvtpk(P[B_ + 0], P[B_ + 1]), a1 = cvtpk(P[B_ + 2], P[B_ + 3]), b0 = cvtpk(P[B_ + 4], P[B_ + 5]), b1 = cvtpk(P[B_ + 6], P[B_ + 7]); \
        auto r0 = __builtin_amdgcn_permlane32_swap(a0, b0, false, false); auto r1 = __builtin_amdgcn_permlane32_swap(a1, b1, false, false); \
        u32x4 w = {r0[0], r1[0], r0[1], r1[1]}; OUT = __builtin_bit_cast(bf16x8, w); } while (0)
#define FA_TR(dst, off) asm volatile("ds_read_b64_tr_b16 %0, %1 offset:%2" : "=&v"(dst) : "v"(vb), "i"(off) : "memory")
#define FA_TR8(S, d0) do { constexpr int b_ = (d0) * 512; FA_TR(S##l0, b_); FA_TR(S##h0, b_ + NCG * 512); FA_TR(S##l1, b_ + NCG * 1024); FA_TR(S##h1, b_ + NCG * 1536); \
        FA_TR(S##l2, b_ + NCG * 2048); FA_TR(S##h2, b_ + NCG * 2560); FA_TR(S##l3, b_ + NCG * 3072); FA_TR(S##h3, b_ + NCG * 3584); } while (0)
#define FA_MM4(S, d0) do { \
        o[d0] = __builtin_amdgcn_mfma_f32_32x32x16_bf16((bf16x8){S##l0[0], S##l0[1], S##l0[2], S##l0[3], S##h0[0], S##h0[1], S##h0[2], S##h0[3]}, pa0, o[d0], 0, 0, 0); \
        o[d0] = __builtin_amdgcn_mfma_f32_32x32x16_bf16((bf16x8){S##l1[0], S##l1[1], S##l1[2], S##l1[3], S##h1[0], S##h1[1], S##h1[2], S##h1[3]}, pa1, o[d0], 0, 0, 0); \
        o[d0] = __builtin_amdgcn_mfma_f32_32x32x16_bf16((bf16x8){S##l2[0], S##l2[1], S##l2[2], S##l2[3], S##h2[0], S##h2[1], S##h2[2], S##h2[3]}, pa2, o[d0], 0, 0, 0); \
        o[d0] = __builtin_amdgcn_mfma_f32_32x32x16_bf16((bf16x8){S##l3[0], S##l3[1], S##l3[2], S##l3[3], S##h3[0], S##h3[1], S##h3[2], S##h3[3]}, pa3, o[d0], 0, 0, 0); } while (0)
#define FA_LW(n) do { asm volatile("s_waitcnt lgkmcnt(%0)" :: "i"(n) : "memory"); __builtin_amdgcn_sched_barrier(0); } while (0)
#define FA_TRP(L0, H0, L1, H1, d0, j0) do { constexpr int b_ = (d0) * 512 + NCG * 512 * (2 * (j0)); FA_TR(L0, b_); FA_TR(H0, b_ + NCG * 512); FA_TR(L1, b_ + NCG * 1024); FA_TR(H1, b_ + NCG * 1536); } while (0)
#define FA_MM2(L0, H0, L1, H1, d0, PA, PB) do { \
        o[d0] = __builtin_amdgcn_mfma_f32_32x32x16_bf16((bf16x8){L0[0], L0[1], L0[2], L0[3], H0[0], H0[1], H0[2], H0[3]}, PA, o[d0], 0, 0, 0); \
        o[d0] = __builtin_amdgcn_mfma_f32_32x32x16_bf16((bf16x8){L1[0], L1[1], L1[2], L1[3], H1[0], H1[1], H1[2], H1[3]}, PB, o[d0], 0, 0, 0); } while (0)
#define FA_E4(B_) do { _Pragma("unroll") for (int r = (B_); r < (B_) + 4; ++r) { p1[r] = BIAS ? __builtin_amdgcn_exp2f(p1[r] - m_reg) : __builtin_amdgcn_exp2f(fmaf(p1[r], D.c2, -m_reg)); ps += p0[r] + p1[r]; } } while (0)
#define FA_H2(t) do { const int buf = (t) & 1; if (tact) { \
        const int vb = vb0 + buf * SHM_V; constexpr int W_ = ND0 > 2 ? 12 : 4; \
        s16x4 Al0, Al1, Al2, Al3, Ah0, Ah1, Ah2, Ah3, Bl0, Bl1, Bl2, Bl3, Bh0, Bh1, Bh2, Bh3; \
        FA_TRP(Al0, Ah0, Al1, Ah1, 0, 0); FA_TRP(Al2, Ah2, Al3, Ah3, 1, 0); \
        if constexpr (ND0 > 2) { FA_TRP(Bl0, Bh0, Bl1, Bh1, 2, 0); FA_TRP(Bl2, Bh2, Bl3, Bh3, 3, 0); } \
        float ps = 0.f; bf16x8 pa0, pa1, pa2, pa3; FA_PK4(p0, 0, pa0); FA_PK4(p0, 8, pa1); \
        FA_LW(W_); FA_MM2(Al0, Ah0, Al1, Ah1, 0, pa0, pa1); FA_TRP(Al0, Ah0, Al1, Ah1, 0, 2); FA_E4(0); \
        FA_LW(W_); FA_MM2(Al2, Ah2, Al3, Ah3, 1, pa0, pa1); FA_TRP(Al2, Ah2, Al3, Ah3, 1, 2); FA_E4(4); \
        if constexpr (ND0 > 2) { FA_LW(12); FA_MM2(Bl0, Bh0, Bl1, Bh1, 2, pa0, pa1); FA_TRP(Bl0, Bh0, Bl1, Bh1, 2, 2); FA_E4(8); \
                                 FA_LW(12); FA_MM2(Bl2, Bh2, Bl3, Bh3, 3, pa0, pa1); FA_TRP(Bl2, Bh2, Bl3, Bh3, 3, 2); FA_E4(12); } \
        else { FA_E4(8); FA_E4(12); } \
        l_reg += ps;     \
        FA_PK4(p1, 0, pa2); FA_PK4(p1, 8, pa3); \
        FA_LW(W_); FA_MM2(Al0, Ah0, Al1, Ah1, 0, pa2, pa3); \
        if constexpr (ND0 > 2) { FA_LW(8); FA_MM2(Al2, Ah2, Al3, Ah3, 1, pa2, pa3); FA_LW(4); FA_MM2(Bl0, Bh0, Bl1, Bh1, 2, pa2, pa3); FA_LW(0); FA_MM2(Bl2, Bh2, Bl3, Bh3, 3, pa2, pa3); } \
        else { FA_LW(0); FA_MM2(Al2, Ah2, Al3, Ah3, 1, pa2, pa3); } } } while (0)
#define FA_ENDK(issued) do { if (issued) asm volatile("s_waitcnt vmcnt(%0)" :: "i"(NKC) : "memory"); else asm volatile("s_waitcnt vmcnt(0)" ::: "memory"); __builtin_amdgcn_s_barrier(); asm volatile("" ::: "memory"); } while (0)
#define FA_ENDV(issued) do { if (issued) asm volatile("s_waitcnt vmcnt(%0)" :: "i"(NVC) : "memory"); else asm volatile("s_waitcnt vmcnt(0)" ::: "memory"); __builtin_amdgcn_s_barrier(); asm volatile("" ::: "memory"); } while (0)
    VM_WAIT();
    __syncthreads();
    if (grp == 0) {
        for (int t = 0; t < NT; ++t) { f32x16 p0, p1; bool tact;
            { const bool is_ = t + 1 < NT; if (is_) FA_LOADK(t + 1); FA_H1(t); FA_ENDK(is_); }
            { const bool is_ = t + 1 < NT; if (is_) FA_LOADV(t + 1); FA_H2(t); FA_ENDV(is_); } }
        FA_ENDK(false);
    } else {
        { const bool is_ = 1 < NT; if (is_) FA_LOADK(1); FA_ENDK(is_); }
        for (int t = 0; t < NT; ++t) { f32x16 p0, p1; bool tact;
            { const bool is_ = t + 1 < NT; if (is_) FA_LOADV(t + 1); FA_H1(t); FA_ENDV(is_); }
            { const bool is_ = t + 2 < NT; if (is_) FA_LOADK(t + 2); FA_H2(t); FA_ENDK(is_); } }
    }
#undef FA_TILE_FLAGS
#undef FA_TI
#undef FA_KADDR
#undef FA_KHALF
#undef FA_KRD2
#undef FA_H1
#undef FA_H2
#undef FA_PK4
#undef FA_TR
#undef FA_TR8
#undef FA_MM4
#undef FA_TRP
#undef FA_MM2
#undef FA_E4
#undef FA_LW
#undef FA_ENDK
#undef FA_ENDV
#undef FA_LOADK
#undef FA_LOADV
    { auto rr = __builtin_amdgcn_permlane32_swap(__float_as_uint(l_reg), __float_as_uint(l_reg), false, false); l_reg = __uint_as_float(rr[0]) + __uint_as_float(rr[1]); }
    if constexpr (MODE == MODE_BAND_SINK) l_reg += __builtin_amdgcn_exp2f(D.sink2 - m_reg);
    const float inv = 1.0f / l_reg;
    int qi_e = qi; asm volatile("" : "+v"(qi_e));
    bf16* op = D.o + (long)qi_e * D.o_rs + 4 * hi;
#pragma unroll
    for (int d0 = 0; d0 < ND0; ++d0)
#pragma unroll
        for (int g4 = 0; g4 < 4; ++g4) { v2u w; w.x = cvtpk(o[d0][4 * g4 + 0] * inv, o[d0][4 * g4 + 1] * inv); w.y = cvtpk(o[d0][4 * g4 + 2] * inv, o[d0][4 * g4 + 3] * inv);
            *(GAS v2u*)(op + d0 * 32 + 8 * g4) = w; }
    if constexpr (MODE == MODE_BAND_LSE) { if (hi == 0) D.lse[(long)qi_e * D.lse_rs] = (m_reg + __builtin_amdgcn_logf(l_reg)) * 0.6931471805599453f; }
}
}

constexpr float LOG2E = 1.4426950408889634f;
__device__ __forceinline__ void fast_mla_attn(KArgs a, LAS unsigned char* lds, int tid, int vcu) {
    unsigned char* ws = a->ws;
    const bf16* QM = (const bf16*)(ws + WS_QMLA); const bf16* KB = (const bf16*)(ws + WS_KB); const bf16* VB = (const bf16*)(ws + WS_VB); bf16* CAT = (bf16*)(ws + WS_CAT);
    for (int it = vcu; it < 256; it += gridDim.x) {
        const int xq = it & 7, rq = it >> 3, bh = xq * 4 + (rq >> 3), p = rq & 7, b = bh >> 3, h = bh & 7; const long r0 = (long)b * SEQ;
#pragma unroll 1
        for (int half = 0; half < 2; ++half) { const int x = half == 0 ? 15 - p : p;
            fa::Desc D{};
            D.q0 = 256 * x; D.t_lo = 0; D.t_hi = 4 * x + 4; D.W = 1 << 30; D.own = x; D.sink2 = 0.f;
            D.q = QM + r0 * NQMLA + h * 192; D.q_rs = NQMLA; D.k = KB + r0 * NQMLA + h * 192; D.k_rs = NQMLA; D.v = VB + r0 * 1024 + h * 128; D.v_rs = 1024;
            D.o = CAT + r0 * NCAT_E + h * 128; D.o_rs = NCAT_E; D.c2 = 0.07216878364870322f * LOG2E; D.slc = 0.f; D.rope = (const float*)(ws + WS_ROPE);
            fa::attn_unit<192, 128, fa::MODE_CAUSAL>(D, lds, tid);
        }
    }
}
__device__ __forceinline__ void fast_moba_attn(KArgs a, int ev, LAS unsigned char* lds, int tid, int vcu) {
    unsigned char* ws = a->ws; (void)vcu;
    const bf16* Z = (const bf16*)(ws + WS_Z); const bf16* KM = (const bf16*)(ws + WS_KM); bf16* CAT = (bf16*)(ws + WS_CAT);
    unsigned* ctr = (unsigned*)(ws + WS_CTL) + CW_QUEUE + 64 * ev;
    volatile LAS unsigned* slot = (volatile LAS unsigned*)(lds + LDSCTL_OFF + 128);
    for (;;) {
        if (tid == 0) slot[0] = __hip_atomic_fetch_add(ctr, 1u, __ATOMIC_RELAXED, __HIP_MEMORY_SCOPE_AGENT);
        __syncthreads();
        const int idx = __builtin_amdgcn_readfirstlane((int)slot[0]);
        __syncthreads();
        if (idx >= 512) break;
        const int x = 15 - (idx >> 5), rem = idx & 31, h = 7 - (rem >> 2), b = rem & 3; const long r0 = (long)b * SEQ;
        fa::Desc D{};
        D.q0 = 256 * x; D.t_lo = 0; D.t_hi = 4 * x + 4; D.W = 1 << 30; D.own = x; D.sink2 = 0.f;
        D.q = Z + r0 * NZE + ZE_QB + h * 128; D.q_rs = NZE; D.k = Z + r0 * NZE + ZE_KB + h * 128; D.k_rs = NZE; D.v = Z + r0 * NZE + ZE_VB + h * 128; D.v_rs = NZE;
        D.o = CAT + r0 * NCAT_E + 1024 + h * 128; D.o_rs = NCAT_E; D.km = KM + (size_t)((b * 8 + h) * 16) * 128; D.ktn = (const float*)(ws + WS_KTN) + (size_t)(b * 8 + h) * 64;
        D.c2 = 0.08838834764831845f * LOG2E; D.slc = exp2f(-(float)(h + 1)) * LOG2E;
        fa::attn_unit<128, 128, fa::MODE_MOBA>(D, lds, tid);
    }
}
__device__ __forceinline__ void fast_dil_attn(KArgs a, LAS unsigned char* lds, int tid, int vcu) {
    unsigned char* ws = a->ws;
    const bf16* Z = (const bf16*)(ws + WS_Z); bf16* OD = (bf16*)(ws + WS_OD); float* LSE = (float*)(ws + WS_LSE);
    for (int u = vcu; u < 768; u += gridDim.x) {
        fa::Desc D{};
        const int b = u / 192, rem = u - b * 192, head = rem >> 4, sub = rem & 15, g = head >> 2, hh = head & 3, dil = (g == 0) ? 1 : (g == 1 ? 4 : 16), nb = 16 / dil, r = sub / nb, blk = sub - r * nb, i0 = 256 * blk;
        const long row0 = (long)b * SEQ + r;
        D.q = Z + row0 * NZO + ZO_QC + head * 128; D.q_rs = (long)dil * NZO; D.k = Z + row0 * NZO + ZO_KC + head * 128; D.k_rs = (long)dil * NZO; D.v = Z + row0 * NZO + ZO_VC + head * 128; D.v_rs = (long)dil * NZO;
        D.o = OD + ((size_t)g * MTOK + row0) * 512 + hh * 128; D.o_rs = (long)dil * 512; D.lse = LSE + ((size_t)g * MTOK + row0) * 4 + hh; D.lse_rs = (long)dil * 4;
        D.q0 = i0; D.t_lo = (i0 >= 128) ? (i0 / 64 - 2) : 0; D.t_hi = i0 / 64 + 4; D.W = 129; D.c2 = 0.08838834764831845f * LOG2E; D.slc = exp2f(-8.0f * (float)(head + 1) / 12.0f) * (float)dil * LOG2E;
        fa::attn_unit<128, 128, fa::MODE_BAND_LSE>(D, lds, tid);
    }
}
__device__ __forceinline__ void fast_swa_attn(KArgs a, int od, LAS unsigned char* lds, int tid, int vcu) {
    unsigned char* ws = a->ws;
    const bf16* Z = (const bf16*)(ws + WS_Z); bf16* CAT = (bf16*)(ws + WS_CAT);
    const float* sinks = a->in[I_OD_SINKS] + od * 16;
    for (int v = vcu; v < 1024; v += gridDim.x) {
        fa::Desc D{};
        const int b = v >> 8, rem = v & 255, hq = rem >> 4, blk = rem & 15, kvh = hq >> 3, i0 = 256 * blk; const long row0 = (long)b * SEQ;
        D.q = Z + row0 * NZO + ZO_QD + hq * 64; D.q_rs = NZO; D.k = Z + row0 * NZO + ZO_KD + kvh * 64; D.k_rs = NZO; D.v = Z + row0 * NZO + ZO_VD + kvh * 64; D.v_rs = NZO;
        D.o = CAT + row0 * NCAT_O + 512 + hq * 64; D.o_rs = NCAT_O;
        D.q0 = i0; D.t_lo = (i0 >= 128) ? (i0 / 64 - 2) : 0; D.t_hi = i0 / 64 + 4; D.W = 128; D.c2 = 0.125f * LOG2E; D.slc = exp2f(-0.5f * (float)(hq + 1)) * LOG2E; D.sink2 = sinks[hq] * LOG2E;
        fa::attn_unit<64, 64, fa::MODE_BAND_SINK>(D, lds, tid);
    }
}

#define XLPTR ((bf16*)nullptr)
#define RSTAB ((LAS float*)(lds + QBUF_OFF))
#define GEMM_CONS(ACT_, PART_, Bptr, O_, ldc_, N_) do { pg8::StaticOrder S0_; S0_.init(MTOK, (N_), (int)gridDim.x, VCU()); pg8::Unit u0_; u0_.pm = 0; u0_.pn = 0; (void)S0_.next(0, u0_); \
        prep_rstab((PART_), u0_.pm, RSTAB, tid_now_()); pg8::EpiBf16<ACT_> E_{(O_), (ldc_), (const LAS float*)RSTAB, u0_.pm, (PART_), nullptr, 0, nullptr, nullptr}; \
        GEMM_CALL(pg8::EpiBf16<ACT_>, (bf16*)(ws + WS_H), DM, (Bptr), DM, (N_), DM, E_); } while (0)
#define GEMM_CONS_I8(ACT_, PART_, Bptr, CSP_, O_, ldc_, N_) do { pg8::StaticOrder S0_; S0_.init(MTOK, (N_), (int)gridDim.x, VCU()); pg8::Unit u0_; u0_.pm = 0; u0_.pn = 0; (void)S0_.next(0, u0_); \
        const float* qrow_ = (const float*)(ws + WS_XQS); \
        prep_rstab_q((PART_), qrow_, u0_.pm, RSTAB, tid_now_()); pg8::EpiBf16<ACT_, true> E_{(O_), (ldc_), (const LAS float*)RSTAB, u0_.pm, (PART_), nullptr, 0, qrow_, (CSP_)}; \
        typedef pg8::EpiBf16<ACT_, true> EpiQ_; GEMM_CALL(EpiQ_, (ws + WS_XQ), DM, (Bptr), DM, (N_), DM, E_); } while (0)
#define GEMM_CONS_U8(PART_, Bptr, CSP_, O8_, BS_, N_) do { pg8::StaticOrder S0_; S0_.init(MTOK, (N_), (int)gridDim.x, VCU()); pg8::Unit u0_; u0_.pm = 0; u0_.pn = 0; (void)S0_.next(0, u0_); \
        const float* qrow_ = (const float*)(ws + WS_XQS); \
        prep_rstab_q((PART_), qrow_, u0_.pm, RSTAB, tid_now_()); pg8::EpiU8 E_{(O8_), (BS_), (const LAS float*)RSTAB, u0_.pm, (PART_), qrow_, (CSP_)}; \
        GEMM_CALL(pg8::EpiU8, (ws + WS_XQ), DM, (Bptr), DM, (N_), DM, E_); } while (0)
#define GEMM_CALL(EPI, Aptr, lda_, Bptr, ldb_, N_, K_, E_) GEMM_CALLW(EPI, Aptr, lda_, Bptr, ldb_, N_, K_, E_, 8)
#define GEMM_CALLW(EPI, Aptr, lda_, Bptr, ldb_, N_, K_, E_, WGM_) do { pg8::Gemm g_{(const pg8::bf16_t*)(Aptr), (const pg8::bf16_t*)(Bptr), MTOK, (N_), (K_), (lda_), (ldb_)}; \
        pg8::StaticOrder S_; S_.init(MTOK, (N_), (int)gridDim.x, VCU()); S_.wgm = (WGM_); pg8::gemm_phase<EPI, pg8::StaticOrder, true, true>(lds + RING_OFF, g_, S_, E_); } while (0)
#define PH_ENV() KArgs kp = kargs(); unsigned char* ws = kp->ws; const Env e = make_env(); (void)ws; (void)e
#define VCU() ((int)__builtin_amdgcn_readfirstlane((int)((volatile LAS unsigned*)(lds + LDSCTL_OFF + 64))[3]))

__global__ void __launch_bounds__(NTHR, 2) mega_fwd(Args args_unused) {
    extern __shared__ __attribute__((aligned(16))) unsigned char lds_raw[];
    LAS unsigned char* lds = (LAS unsigned char*)lds_raw;
    (void)args_unused;
    for (int u = threadIdx.x; u < (LDS_BYTES - LDSCTL_OFF) / 4; u += NTHR) ((LAS unsigned*)(lds + LDSCTL_OFF))[u] = 0u;
    __syncthreads();
    { KArgs kp = kargs(); (void)xcd_barrier_post((unsigned*)(kp->ws + WS_CTL) + CW_BAR, (volatile LAS unsigned*)(lds + LDSCTL_OFF + 64)); }
#define SEAM() do { KArgs kb_ = kargs(); XcdBarrier bar_; bar_.bar = (unsigned*)(kb_->ws + WS_CTL) + CW_BAR; bar_.x = xb_xcc_id(); bar_.st = (volatile LAS unsigned*)(lds + LDSCTL_OFF + 64); xcd_barrier(bar_); } while (0)

    { KArgs kp = kargs(); slab_phase(kp, lds, tid_now_()); }
    { PH_ENV(); prologue_phase(kp, lds, e.gw, e.NGW, e.wave, e.lane); }
    { PH_ENV(); init_phase(kp->in[I_X], (bf16*)(ws + WS_H), XLPTR, (float*)(ws + WS_PB), e.gw, e.NGW, e.lane); }
    SEAM();
    { KArgs kp = kargs(); unsigned* bw = (unsigned*)(kp->ws + WS_CTL) + CW_BAR; volatile LAS unsigned* st = (volatile LAS unsigned*)(lds + LDSCTL_OFF + 64);
      if (threadIdx.x == 0) { const unsigned G = gridDim.x; bool ok = (G % 8u) == 0u;
          for (unsigned j = 0; j < 16; ++j) { const unsigned c = xb_ld(&bw[XB_XCNT(j)]); ok = ok && (c == (j < 8u ? G / 8u : 0u)); }
          const unsigned x = xb_xcc_id(); st[3] = (ok && x < 8u && st[2] < G / 8u) ? x + 8u * st[2] : blockIdx.x; }
      __syncthreads(); }
    if (IN_I8_MASK & 1) { { PH_ENV(); quant_rows<4>((const bf16*)(ws + WS_H), DM, (signed char*)(ws + WS_XQ), (float*)(ws + WS_XQS), MTOK, e.gw, e.NGW, e.lane); } SEAM(); }
#pragma unroll 1
    for (int layer = 0; layer < DEPTH; ++layer) {
        const int i2 = layer >> 1;
        if (layer > 0 && ((IN_I8_MASK >> layer) & 1)) { { PH_ENV(); quant_rows<4>((const bf16*)(ws + WS_H), DM, (signed char*)(ws + WS_XQ), (float*)(ws + WS_XQS), MTOK, e.gw, e.NGW, e.lane); } SEAM(); }
        if ((layer & 1) == 0) {
            if ((IN_I8_MASK >> layer) & 1) { PH_ENV(); GEMM_CONS_I8(0, (const float*)(ws + WS_PB), (ws + WS_WQINE) + (size_t)i2 * 4096 * DM, (const float*)(ws + WS_CSTEP) + CS_INE + i2 * 4096, (bf16*)(ws + WS_Z), NZE, 4096); }
            else { PH_ENV(); GEMM_CONS(0, (const float*)(ws + WS_PB), (bf16*)(ws + WS_WINE) + (size_t)i2 * NZE * DM, (bf16*)(ws + WS_Z), NZE, 4096); }
            SEAM();
            { PH_ENV(); latent_phase(kp, i2, lds, e.gw, e.NGW, e.wave, e.lane); }
            { PH_ENV(); const bf16* Zq = (const bf16*)(ws + WS_Z) + ZE_QLAT; const bf16* Zk = (const bf16*)(ws + WS_Z) + ZE_KVLAT;
              pg8::StaticOrder S0; S0.init(MTOK, NQMLA, (int)gridDim.x, VCU()); pg8::Unit u0; u0.pm = 0; u0.pn = 0; (void)S0.next(0, u0);
              const int tq = tid_now_(); prep_rstab_z(Zq, NZE, u0.pm, RSTAB, tq); prep_rstab_z(Zk, NZE, u0.pm, RSTAB + 256, tq);
              { pg8::EpiBf16<0> E{(bf16*)(ws + WS_QMLA), NQMLA, (const LAS float*)RSTAB, u0.pm, nullptr, Zq, NZE, nullptr, nullptr}; GEMM_CALL(pg8::EpiBf16<0>, Zq, NZE, (bf16*)(ws + WS_WUQ) + (size_t)i2 * NQMLA * 512, 512, NQMLA, 512, E); }
              { pg8::EpiKV E{(bf16*)(ws + WS_KB), (bf16*)(ws + WS_VB), (const LAS float*)(RSTAB + 256), u0.pm, Zk, NZE}; GEMM_CALL(pg8::EpiKV, Zk, NZE, (bf16*)(ws + WS_WUKV) + (size_t)i2 * NKVU * 512, 512, NKVU, 512, E); } }
            SEAM();
            #if FAST_EVEN
            { KArgs kp = kargs(); int tid_o = threadIdx.x; asm volatile("" : "+v"(tid_o)); fast_mla_attn(kp, lds, tid_o, VCU()); }
            { KArgs kp = kargs(); int tid_o = threadIdx.x; asm volatile("" : "+v"(tid_o)); fast_moba_attn(kp, i2, lds, tid_o, VCU()); }
#else
            { PH_ENV(); naive_even_attn(kp, lds, e.gw, e.NGW, e.wave, e.lane); }
#endif
            SEAM();
            { PH_ENV(); quant_rows<4>((const bf16*)(ws + WS_CAT), NCAT_E, (signed char*)(ws + WS_CATQ), (float*)(ws + WS_CATQS), MTOK, e.gw, e.NGW, e.lane); }
            SEAM();
            { PH_ENV(); pg8::EpiResSplitT<true> E{(bf16*)(ws + WS_H), XLPTR, (float*)(ws + WS_PA), (const float*)(ws + WS_CATQS), (const float*)(ws + WS_CSTEP) + CS_OUTE + i2 * DM, nullptr};
              GEMM_CALLW(pg8::EpiResSplitT<true>, (ws + WS_CATQ), NCAT_E, (ws + WS_WQOUTE) + (size_t)i2 * DM * NCAT_E, NCAT_E, DM, NCAT_E, E, 4); }
            SEAM();
        } else {
            if ((IN_I8_MASK >> layer) & 1) { PH_ENV(); GEMM_CONS_I8(0, (const float*)(ws + WS_PB), (ws + WS_WQINO) + (size_t)i2 * NZO * DM, (const float*)(ws + WS_CSTEP) + CS_INO + i2 * NZO, (bf16*)(ws + WS_Z), NZO, NZO); }
            else { PH_ENV(); GEMM_CONS(0, (const float*)(ws + WS_PB), (bf16*)(ws + WS_WINO) + (size_t)i2 * NZO * DM, (bf16*)(ws + WS_Z), NZO, NZO); }
            SEAM();
            #if FAST_ODD
            { KArgs kp = kargs(); int tid_o = threadIdx.x; asm volatile("" : "+v"(tid_o)); fast_dil_attn(kp, lds, tid_o, VCU()); }
            { KArgs kp = kargs(); int tid_o = threadIdx.x; asm volatile("" : "+v"(tid_o)); fast_swa_attn(kp, i2, lds, tid_o, VCU()); }
#else
            { PH_ENV(); naive_odd_attn(kp, i2, lds, e.gw, e.NGW, e.wave, e.lane); }
#endif
            SEAM();
            { PH_ENV(); merge_quant_phase(kp, e.gw, e.NGW, e.lane); }
            SEAM();
            { PH_ENV(); pg8::EpiResSplitT<true> E{(bf16*)(ws + WS_H), XLPTR, (float*)(ws + WS_PA), (const float*)(ws + WS_CATQS), (const float*)(ws + WS_CSTEP) + CS_OUTO + i2 * DM, nullptr}; GEMM_CALLW(pg8::EpiResSplitT<true>, (ws + WS_CATQ), NCAT_O, (ws + WS_WQOUTO) + (size_t)i2 * DM * NCAT_O, NCAT_O, DM, NCAT_O, E, 4); }
            SEAM();
        }
        if ((UP_I8_MASK >> layer) & 1) {
            { PH_ENV(); quant_rows<4>((const bf16*)(ws + WS_H), DM, (signed char*)(ws + WS_XQ), (float*)(ws + WS_XQS), MTOK, e.gw, e.NGW, e.lane); }
            SEAM();
            if ((DN_I8_MASK >> layer) & 1) { PH_ENV(); GEMM_CONS_U8((const float*)(ws + WS_PA), (ws + WS_WUP + (size_t)layer * FF * DM * 2), (const float*)(ws + WS_WUP + (size_t)layer * FF * DM * 2 + (size_t)FF * DM), (unsigned char*)(ws + WS_U), (float*)(ws + WS_U + (size_t)128 * MiB), FF); }
            else { PH_ENV(); GEMM_CONS_I8(1, (const float*)(ws + WS_PA), (ws + WS_WUP + (size_t)layer * FF * DM * 2), (const float*)(ws + WS_WUP + (size_t)layer * FF * DM * 2 + (size_t)FF * DM), (bf16*)(ws + WS_U), FF, FF); }
        } else
        { PH_ENV(); GEMM_CONS(1, (const float*)(ws + WS_PA), (bf16*)(ws + WS_WUP) + (size_t)layer * FF * DM, (bf16*)(ws + WS_U), FF, FF); }
        SEAM();

        if ((DN_I8_MASK >> layer) & 1) {
            { PH_ENV(); requant_hidden((unsigned char*)(ws + WS_U), (const float*)(ws + WS_U + (size_t)128 * MiB), (float*)(ws + WS_XQS), e.gw, e.NGW, e.lane);
              quant_weight_dn((const bf16*)(ws + WS_WDN) + (size_t)layer * DM * FF, (signed char*)(ws + WS_OD), (float*)(ws + WS_OD + (size_t)DM * FF), (float*)(ws + WS_OD + (size_t)DM * FF + 8192), e.gw, e.NGW, e.lane); }
            SEAM();
            { PH_ENV(); pg8::EpiResSplitT<true, true> E{(bf16*)(ws + WS_H), XLPTR, (float*)(ws + WS_PB), (const float*)(ws + WS_XQS), (const float*)(ws + WS_OD + (size_t)DM * FF), (const float*)(ws + WS_OD + (size_t)DM * FF + 8192)};
              typedef pg8::EpiResSplitT<true, true> EpiDn_; GEMM_CALLW(EpiDn_, (ws + WS_U), FF, (ws + WS_OD), FF, DM, FF, E, 4); }
        } else
        { PH_ENV(); pg8::EpiResSplit E{(bf16*)(ws + WS_H), XLPTR, (float*)(ws + WS_PB), nullptr, nullptr, nullptr}; GEMM_CALLW(pg8::EpiResSplit, (bf16*)(ws + WS_U), FF, (bf16*)(ws + WS_WDN) + (size_t)layer * DM * FF, FF, DM, FF, E, 4); }
        SEAM();
    }
    { PH_ENV(); final_norm_phase((const bf16*)(ws + WS_H), (const bf16*)XLPTR, kp->out, kp->in[I_FINAL_NORM], e.gw, e.NGW, e.lane); }
#undef SEAM
}

static_assert((DN_I8_MASK & ~UP_I8_MASK) == 0, "the int8 down-projection takes its input from an int8 up-projection's block-scaled int8 image");
extern "C" void kernel_launch(void* const* d_in, const int* in_sizes, int n_in, void* d_out, int out_size, void* d_ws, size_t ws_size, hipStream_t stream) {
    static int grid = 0;
    if (grid == 0) {
        if (n_in != 15 || in_sizes[0] != MTOK * DM || out_size != MTOK * DM || ws_size < WS_END2) { fprintf(stderr, "kernel_launch: unexpected shapes (n_in %d, in0 %d, out %d, ws %zu)\n", n_in, n_in > 0 ? in_sizes[0] : -1, out_size, ws_size); grid = -1; return; }
        int dev = 0, cus = 0, per_cu = 0;
        if (hipGetDevice(&dev) != hipSuccess || hipDeviceGetAttribute(&cus, hipDeviceAttributeMultiprocessorCount, dev) != hipSuccess) { grid = -1; return; }
        if (hipFuncSetAttribute((const void*)mega_fwd, hipFuncAttributeMaxDynamicSharedMemorySize, LDS_BYTES) != hipSuccess) { fprintf(stderr, "kernel_launch: hipFuncSetAttribute failed\n"); grid = -1; return; }
        if (hipOccupancyMaxActiveBlocksPerMultiprocessor(&per_cu, (const void*)mega_fwd, NTHR, LDS_BYTES) != hipSuccess || per_cu < 1) fprintf(stderr, "kernel_launch: occupancy query reports %d\n", per_cu);
        (void)hipGetLastError();
        grid = cus;
    }
    if (grid < 0) return;
    if (hipMemsetAsync((char*)d_ws + WS_CTL, 0, CTL_ZERO_BYTES, stream) != hipSuccess) { fprintf(stderr, "kernel_launch: memset failed\n"); return; }
    Args a{};
    for (int i = 0; i < 15; ++i) a.in[i] = (const float*)d_in[i];
    a.out = (float*)d_out; a.ws = (unsigned char*)d_ws; a.ph_lo = 0; a.ph_hi = 1 << 20;
    hipLaunchKernelGGL(mega_fwd, dim3(grid), dim3(NTHR), LDS_BYTES, stream, a);
}
```

```cpp
#include <hip/hip_runtime.h>
#include <cstdio>
#include <cstdint>
namespace pg8 {
#define PG8_LAS __attribute__((address_space(3)))
typedef unsigned short bf16_t;
typedef short bf16x8 __attribute__((ext_vector_type(8)));
typedef float f32x4 __attribute__((ext_vector_type(4)));
typedef unsigned u32x4 __attribute__((ext_vector_type(4)));
constexpr int BM = 256, BK = 64, HALF = 128, HTB = HALF * BK * 2  , STAGE_BYTES = 8 * HTB, NXCD = 8, WGM = 8;

__host__ __device__ __forceinline__ int lds_byte(int r, int c) { const int st = (r >> 4) * 2 + (c >> 5), rr = r & 15, cc = c & 31, ob = rr * 64 + cc * 2; return st * 1024 + (ob ^ (((ob >> 9) & 1) << 5)); }
__host__ __device__ __forceinline__ void stage_rc(int b, int& R, int& C) { const int st = b / 1024, sb = b % 1024, swz = sb ^ (((sb >> 9) & 1) << 5); R = (st >> 1) * 16 + swz / 64; C = (st & 1) * 32 + (swz % 64) / 2; }
__host__ __device__ __forceinline__ int perm32(int rho) { const int n = rho >> 4, i = rho & 15; return 8 * (i >> 2) + 4 * n + (i & 3); }

struct Unit { int pm, pn; };
struct Gemm { const bf16_t* A; const bf16_t* Bt; int M, N, K, lda, ldb; };

struct StaticOrder {
    int nM, nN, nwg, G, c, wgm;
    __host__ __device__ __forceinline__ void init(int M, int N, int G_, int c_) { nM = M / BM; nN = N / BM; nwg = nM * nN; G = G_; c = c_; wgm = WGM; }
    __host__ __device__ __forceinline__ bool next(int i, Unit& u) const {
        const long L = (long)i * G + c; if (L >= nwg) return false;
        int wgid = (int)L; { const int q = nwg / NXCD, r = nwg % NXCD, xcd = wgid % NXCD, off = wgid / NXCD; wgid = (xcd < r ? xcd * (q + 1) : r * (q + 1) + (xcd - r) * q) + off; }
        const int nig = wgm * nN, gid = wgid / nig, fm = gid * wgm, gsz = (nM - fm) < wgm ? (nM - fm) : wgm;
        u.pm = fm + ((wgid % nig) % gsz); u.pn = (wgid % nig) / gsz; return true;
    }
    __device__ __forceinline__ void a_ready(const Unit&) const {}
    __device__ __forceinline__ void done(const Unit&) const {}
};
typedef int i32x4 __attribute__((ext_vector_type(4)));
template <bool I8> struct AccT { typedef f32x4 type; };
template <> struct AccT<true> { typedef i32x4 type; };
__device__ __forceinline__ f32x4 mma16(bf16x8 a, bf16x8 b, f32x4 c) { return __builtin_amdgcn_mfma_f32_16x16x32_bf16(a, b, c, 0, 0, 0); }
__device__ __forceinline__ i32x4 mma16(bf16x8 a, bf16x8 b, i32x4 c) { return __builtin_amdgcn_mfma_i32_16x16x64_i8(__builtin_bit_cast(i32x4, a), __builtin_bit_cast(i32x4, b), c, 0, 0, 0); }
template <class Epi, class Sched, bool ALIGN_EPI = false, bool SP2 = false>
__device__ __forceinline__ void gemm_phase(PG8_LAS unsigned char* lds, const Gemm g, const Sched& S, const Epi& E) {
    int tid_o = threadIdx.x; asm volatile("" : "+v"(tid_o));
    const int tid = tid_o, wid = __builtin_amdgcn_readfirstlane(tid >> 6), lane = tid & 63, wr = wid >> 2, wc = wid & 3, fr = lane & 15, fq = lane >> 4;
    constexpr int ESZ = Epi::I8 ? 1 : 2;
    const int K = g.K, nt = K * ESZ / (BK * 2);
    unsigned voffA[2], voffB[2];
#pragma unroll
    for (int i = 0; i < 2; ++i) { int R, C; stage_rc(tid * 16 + i * 8192, R, C); const int Rb = Epi::PERM ? (64 * (R >> 5) + perm32(R & 31)) : R;
        voffA[i] = (unsigned)(R * g.lda * ESZ + C * 2); voffB[i] = (unsigned)(Rb * g.ldb * ESZ + C * 2); }
    const size_t kstep = (size_t)(BK * 2);
    const size_t hstepA = (size_t)HALF * g.lda * ESZ, hstepB = (size_t)(Epi::PERM ? 32 : HALF) * g.ldb * ESZ;
    const size_t tstepA = 2 * hstepA, tstepB = (size_t)BM * g.ldb * ESZ;
    const unsigned ldsw = (unsigned)wid * 1024u;
    const int aoff = lds_byte(wr * 64 + fr, fq * 8), boff = lds_byte(wc * 32 + fr, fq * 8);
#define PG8_SA(b, h) (((b) * 2 + (h)) * HTB)
#define PG8_SB(b, h) ((4 + (b) * 2 + (h)) * HTB)
#define PG8_STAGE(bufoff, gbase, voff) do { _Pragma("unroll") for (int _i = 0; _i < 2; ++_i) \
        __builtin_amdgcn_global_load_lds((const unsigned*)((const char*)(gbase) + (voff)[_i]), (PG8_LAS unsigned*)(lds + (bufoff) + ldsw + _i * 8192), 16, 0, 0); } while (0)
#define PG8_LDA(dst, b, h) do { _Pragma("unroll") for (int m = 0; m < 4; ++m) _Pragma("unroll") for (int k = 0; k < 2; ++k) dst[m][k] = *(const PG8_LAS bf16x8*)(lds + PG8_SA(b, h) + aoff + m * 2048 + k * 1024); } while (0)
#define PG8_LDB(dst, b, h) do { _Pragma("unroll") for (int n = 0; n < 2; ++n) _Pragma("unroll") for (int k = 0; k < 2; ++k) dst[n][k] = *(const PG8_LAS bf16x8*)(lds + PG8_SB(b, h) + boff + n * 2048 + k * 1024); } while (0)
#define PG8_MMA(ai, bj, At, Bt) do { __builtin_amdgcn_s_setprio(1); _Pragma("unroll") for (int m = 0; m < 4; ++m) _Pragma("unroll") for (int n = 0; n < 2; ++n) _Pragma("unroll") for (int k = 0; k < 2; ++k) \
        acc[ai][bj][m][n] = mma16(Bt[n][k], At[m][k], acc[ai][bj][m][n]); __builtin_amdgcn_s_setprio(0); } while (0)
#define PG8_WAIT_V(n) asm volatile("s_waitcnt vmcnt(" #n ")" ::: "memory")
#define PG8_WAIT_L(n) asm volatile("s_waitcnt lgkmcnt(" #n ")" ::: "memory")
#define PG8_BAR __builtin_amdgcn_s_barrier()
#define PG8_SCHED __builtin_amdgcn_sched_barrier(0)
    Unit cur, nxt; int ui = 0;
    if (!S.next(0, cur)) return;
    typedef typename AccT<Epi::I8>::type acc_t;
    acc_t acc[2][2][4][2];
#pragma unroll
    for (int a = 0; a < 2; ++a)
#pragma unroll
        for (int b = 0; b < 2; ++b)
#pragma unroll
            for (int m = 0; m < 4; ++m)
#pragma unroll
                for (int n = 0; n < 2; ++n) acc[a][b][m][n] = (acc_t){0, 0, 0, 0};
    bf16x8 At[4][2], B0[2][2], B1[2][2];
    const char* cA = (const char*)g.A + (size_t)cur.pm * tstepA; const char* cB = (const char*)g.Bt + (size_t)cur.pn * tstepB;
    S.a_ready(cur);
    if constexpr (SP2) {
        PG8_STAGE(PG8_SB(0, 0), cB, voffB); PG8_STAGE(PG8_SB(0, 1), cB + hstepB, voffB); PG8_STAGE(PG8_SA(0, 0), cA, voffA); PG8_STAGE(PG8_SA(0, 1), cA + hstepA, voffA);
        if (wr == 1) PG8_BAR;
        PG8_WAIT_V(2); PG8_BAR;
        PG8_STAGE(PG8_SB(1, 0), cB + kstep, voffB); PG8_STAGE(PG8_SA(1, 0), cA + kstep, voffA); PG8_STAGE(PG8_SB(1, 1), cB + hstepB + kstep, voffB);
        PG8_WAIT_V(6); PG8_BAR;
    } else {
        PG8_STAGE(PG8_SB(0, 0), cB, voffB); PG8_STAGE(PG8_SA(0, 0), cA, voffA); PG8_STAGE(PG8_SB(0, 1), cB + hstepB, voffB); PG8_STAGE(PG8_SA(0, 1), cA + hstepA, voffA);
        if (wr == 1) PG8_BAR;
        PG8_WAIT_V(4); PG8_BAR;
        PG8_STAGE(PG8_SB(1, 0), cB + kstep, voffB); PG8_STAGE(PG8_SA(1, 0), cA + kstep, voffA); PG8_STAGE(PG8_SB(1, 1), cB + hstepB + kstep, voffB);
        PG8_WAIT_V(6); PG8_BAR;
    }
    for (;;) {
        const bool has_next = S.next(ui + 1, nxt);
        const char* nA = has_next ? (const char*)g.A + (size_t)nxt.pm * tstepA : cA; const char* nB = has_next ? (const char*)g.Bt + (size_t)nxt.pn * tstepB : cB;
        for (int t = 0; t < nt; t += 2) {
            const bool last = (t == nt - 2);
            const char* a1 = cA + (size_t)(t + 1) * kstep;
            const char* a2 = last ? nA : cA + (size_t)(t + 2) * kstep; const char* b2 = last ? nB : cB + (size_t)(t + 2) * kstep;
            const char* a3 = a2 + kstep; const char* b3 = b2 + kstep;
            if (last && has_next) S.a_ready(nxt);
            if constexpr (SP2) {
            PG8_LDB(B0, 0, 0); PG8_LDB(B1, 0, 1); PG8_SCHED; PG8_LDA(At, 0, 0); PG8_STAGE(PG8_SA(1, 1), a1 + hstepA, voffA);
            PG8_WAIT_V(8); PG8_WAIT_L(0); PG8_BAR; PG8_MMA(0, 0, At, B0); PG8_MMA(0, 1, At, B1); PG8_BAR; PG8_SCHED;
            PG8_LDA(At, 0, 1); PG8_STAGE(PG8_SB(0, 0), b2, voffB); PG8_STAGE(PG8_SB(0, 1), b2 + hstepB, voffB); PG8_STAGE(PG8_SA(0, 0), a2, voffA);
            PG8_WAIT_V(8); PG8_WAIT_L(0); PG8_BAR; PG8_MMA(1, 0, At, B0); PG8_MMA(1, 1, At, B1); PG8_BAR; PG8_SCHED;
            PG8_LDB(B0, 1, 0); PG8_LDB(B1, 1, 1); PG8_SCHED; PG8_LDA(At, 1, 0); PG8_STAGE(PG8_SA(0, 1), a2 + hstepA, voffA);
            PG8_WAIT_V(8); PG8_WAIT_L(0); PG8_BAR; PG8_MMA(0, 0, At, B0); PG8_MMA(0, 1, At, B1); PG8_BAR; PG8_SCHED;
            PG8_LDA(At, 1, 1); PG8_STAGE(PG8_SB(1, 0), b3, voffB); PG8_STAGE(PG8_SB(1, 1), b3 + hstepB, voffB); PG8_STAGE(PG8_SA(1, 0), a3, voffA);
            PG8_WAIT_V(8); PG8_WAIT_L(0); PG8_BAR; PG8_MMA(1, 0, At, B0); PG8_MMA(1, 1, At, B1); PG8_BAR; PG8_SCHED;
            } else {
            PG8_LDB(B0, 0, 0); PG8_SCHED; PG8_LDA(At, 0, 0); PG8_STAGE(PG8_SA(1, 1), a1 + hstepA, voffA);
            PG8_WAIT_L(8); PG8_BAR; PG8_WAIT_L(0); PG8_MMA(0, 0, At, B0); PG8_BAR; PG8_SCHED;
            PG8_LDB(B1, 0, 1); PG8_STAGE(PG8_SB(0, 0), b2, voffB);
            PG8_BAR; PG8_WAIT_L(0); PG8_MMA(0, 1, At, B1); PG8_BAR;
            PG8_LDA(At, 0, 1); PG8_STAGE(PG8_SA(0, 0), a2, voffA);
            PG8_BAR; PG8_WAIT_L(0); PG8_MMA(1, 0, At, B0); PG8_BAR; PG8_SCHED;
            PG8_STAGE(PG8_SB(0, 1), b2 + hstepB, voffB);
            PG8_WAIT_V(6); PG8_BAR; PG8_MMA(1, 1, At, B1); PG8_BAR;
            PG8_LDB(B0, 1, 0); PG8_SCHED; PG8_LDA(At, 1, 0); PG8_STAGE(PG8_SA(0, 1), a2 + hstepA, voffA);
            PG8_WAIT_L(8); PG8_BAR; PG8_WAIT_L(0); PG8_MMA(0, 0, At, B0); PG8_BAR; PG8_SCHED;
            PG8_LDB(B1, 1, 1); PG8_STAGE(PG8_SB(1, 0), b3, voffB);
            PG8_BAR; PG8_WAIT_L(0); PG8_MMA(0, 1, At, B1); PG8_BAR;
            PG8_LDA(At, 1, 1); PG8_STAGE(PG8_SA(1, 0), a3, voffA);
            PG8_BAR; PG8_WAIT_L(0); PG8_MMA(1, 0, At, B0); PG8_BAR; PG8_SCHED;
            PG8_STAGE(PG8_SB(1, 1), b3 + hstepB, voffB);
            PG8_WAIT_V(6); PG8_BAR; PG8_MMA(1, 1, At, B1); PG8_BAR;
            }
        }
        if constexpr (ALIGN_EPI) { if (wr == 0) PG8_BAR; }
        if constexpr (!Epi::AFTER_DRAIN) { if constexpr (Epi::I8) { f32x4 accf[2][2][4][2];
            const f32x4* cp_ = (const f32x4*)(E.qcol + cur.pn * BM + wc * 64 + 8 * fq); const f32x4 cs_[2][2] = {{cp_[0], cp_[1]}, {cp_[8], cp_[9]}};
            f32x4 of_[2][2] = {};
            if constexpr (Epi::OFFS) { const f32x4* op_ = (const f32x4*)(E.qoff + cur.pn * BM + wc * 64 + 8 * fq); of_[0][0] = op_[0]; of_[0][1] = op_[1]; of_[1][0] = op_[8]; of_[1][1] = op_[9]; }
#pragma unroll
            for (int a = 0; a < 2; ++a)
#pragma unroll
                for (int b = 0; b < 2; ++b)
#pragma unroll
                    for (int m = 0; m < 4; ++m)
#pragma unroll
                        for (int n = 0; n < 2; ++n) accf[a][b][m][n] = Epi::OFFS ? (__builtin_convertvector(acc[a][b][m][n], f32x4) + of_[b][n]) * cs_[b][n] : __builtin_convertvector(acc[a][b][m][n], f32x4) * cs_[b][n];
            E(accf, cur, wr, wc, fr, fq); } else { E(acc, cur, wr, wc, fr, fq); } S.done(cur); }
        if (!has_next) break;
#pragma unroll
        for (int a = 0; a < 2; ++a)
#pragma unroll
            for (int b = 0; b < 2; ++b)
#pragma unroll
                for (int m = 0; m < 4; ++m)
#pragma unroll
                    for (int n = 0; n < 2; ++n) acc[a][b][m][n] = (acc_t){0, 0, 0, 0};
        cur = nxt; cA = nA; cB = nB; ++ui;
        if constexpr (ALIGN_EPI) { if (wr == 1) PG8_BAR; }
    }
    PG8_WAIT_V(0);
    if constexpr (!ALIGN_EPI) { if (wr == 0) PG8_BAR; }
    PG8_BAR;
    if constexpr (Epi::AFTER_DRAIN && !Epi::I8) { E.fused(acc, cur, wr, wc, fr, fq, lds, wid, lane); S.done(cur); }
#undef PG8_SA
#undef PG8_SB
#undef PG8_STAGE
#undef PG8_LDA
#undef PG8_LDB
#undef PG8_MMA
#undef PG8_WAIT_V
#undef PG8_WAIT_L
#undef PG8_BAR
#undef PG8_SCHED
}
}

namespace pg8 {
__device__ __forceinline__ unsigned cvt_pk_bf16(float lo, float hi) { unsigned r; asm volatile("v_cvt_pk_bf16_f32 %0, %1, %2" : "=v"(r) : "v"(lo), "v"(hi)); return r; }
__device__ __forceinline__ float zrow_rstd(const bf16_t* z) { float s = 0.f;
#pragma unroll 1
    for (int c = 0; c < 64; ++c) { const u32x4 w = *(const u32x4*)(z + c * 8);
        const float a0 = __uint_as_float(w.x << 16), a1 = __uint_as_float(w.x & 0xffff0000u), a2 = __uint_as_float(w.y << 16), a3 = __uint_as_float(w.y & 0xffff0000u), a4 = __uint_as_float(w.z << 16), a5 = __uint_as_float(w.z & 0xffff0000u), a6 = __uint_as_float(w.w << 16), a7 = __uint_as_float(w.w & 0xffff0000u);
        s += ((a0 * a0 + a1 * a1) + (a2 * a2 + a3 * a3)) + ((a4 * a4 + a5 * a5) + (a6 * a6 + a7 * a7)); }
    return 1.0f / sqrtf(s * (1.0f / 512.0f) + 1e-6f); }
typedef unsigned u32x2 __attribute__((ext_vector_type(2)));
template <int ACT, bool I8_ = false> struct EpiBf16 {
    static constexpr bool PERM = true, AFTER_DRAIN = false, I8 = I8_, OFFS = false;
    bf16_t* O; int ldc; const PG8_LAS float* rstab; int tab_pm; const float* part; const bf16_t* zsrc; int zld; const float* qrow; const float* qcol;
    __device__ __forceinline__ void operator()(const f32x4 (&acc)[2][2][4][2], const Unit& u, int wr, int wc, int fr, int fq) const {
        const int row0 = u.pm * BM + wr * 64 + fr; const int col0 = u.pn * BM + wc * 64 + 8 * fq;
        float rs[2][4];
#pragma unroll
        for (int ai = 0; ai < 2; ++ai)
#pragma unroll
            for (int m = 0; m < 4; ++m) { rs[ai][m] = 1.0f;
                if (rstab) { if (u.pm == tab_pm) rs[ai][m] = rstab[ai * HALF + wr * 64 + m * 16 + fr];
                    else if (part) { const f32x4* pp = (const f32x4*)(part + (size_t)(row0 + ai * HALF + m * 16) * 32); float s = 0.f;
#pragma unroll 1
                        for (int j = 0; j < 8; ++j) { const f32x4 t = pp[j]; s += (t[0] + t[1]) + (t[2] + t[3]); }
                        rs[ai][m] = 1.0f / sqrtf(s * (1.0f / 2048.0f) + 1e-6f); if (I8_) rs[ai][m] *= qrow[row0 + ai * HALF + m * 16]; }
                    else rs[ai][m] = zrow_rstd(zsrc + (size_t)(row0 + ai * HALF + m * 16) * zld); } }
#pragma unroll
        for (int ai = 0; ai < 2; ++ai)
#pragma unroll
            for (int m = 0; m < 4; ++m) { bf16_t* rowp = O + (size_t)(row0 + ai * HALF + m * 16) * ldc + col0;
#pragma unroll
                for (int bj = 0; bj < 2; ++bj) { f32x4 v0 = acc[ai][bj][m][0] * rs[ai][m], v1 = acc[ai][bj][m][1] * rs[ai][m];
                    if (ACT == 1) {
#pragma unroll
                        for (int j = 0; j < 4; ++j) { const float a = fmaxf(v0[j], 0.f), b = fmaxf(v1[j], 0.f); v0[j] = a * a; v1[j] = b * b; } }
                    u32x4 w; w.x = cvt_pk_bf16(v0[0], v0[1]); w.y = cvt_pk_bf16(v0[2], v0[3]); w.z = cvt_pk_bf16(v1[0], v1[1]); w.w = cvt_pk_bf16(v1[2], v1[3]);
                    *(u32x4*)(rowp + bj * 32) = w; } }
    }
};
__device__ __forceinline__ unsigned q4u_(float a, float b, float c, float d) { return ((unsigned)((int)__builtin_rintf(a) - 128) & 255u) | (((unsigned)((int)__builtin_rintf(b) - 128) & 255u) << 8) | (((unsigned)((int)__builtin_rintf(c) - 128) & 255u) << 16) | ((unsigned)((int)__builtin_rintf(d) - 128) << 24); }
struct EpiU8 {
    static constexpr bool PERM = true, AFTER_DRAIN = false, I8 = true, OFFS = false;
    unsigned char* O8; float* bs; const PG8_LAS float* rstab; int tab_pm; const float* part; const float* qrow; const float* qcol;
    __device__ __forceinline__ void operator()(const f32x4 (&acc)[2][2][4][2], const Unit& u, int wr, int wc, int fr, int fq) const {
        const int row0 = u.pm * BM + wr * 64 + fr; const int col0 = u.pn * BM + wc * 64 + 8 * fq;
#pragma unroll
        for (int ai = 0; ai < 2; ++ai)
#pragma unroll
            for (int m = 0; m < 4; ++m) { const int row = row0 + ai * HALF + m * 16; float rs;
                if (u.pm == tab_pm) rs = rstab[ai * HALF + wr * 64 + m * 16 + fr];
                else { const f32x4* pp = (const f32x4*)(part + (size_t)row * 32); float s = 0.f;
#pragma unroll 1
                    for (int j = 0; j < 8; ++j) { const f32x4 t = pp[j]; s += (t[0] + t[1]) + (t[2] + t[3]); }
                    rs = (1.0f / sqrtf(s * (1.0f / 2048.0f) + 1e-6f)) * qrow[row]; }
                float h[2][8]; float mx = 0.f;
#pragma unroll
                for (int bj = 0; bj < 2; ++bj)
#pragma unroll
                    for (int j = 0; j < 8; ++j) { const float a = fmaxf(acc[ai][bj][m][j >> 2][j & 3] * rs, 0.f); h[bj][j] = a * a; mx = fmaxf(mx, h[bj][j]); }
                { auto r = __builtin_amdgcn_permlane16_swap(__float_as_uint(mx), __float_as_uint(mx), false, false); mx = fmaxf(__uint_as_float(r[0]), __uint_as_float(r[1])); }
                { auto r = __builtin_amdgcn_permlane32_swap(__float_as_uint(mx), __float_as_uint(mx), false, false); mx = fmaxf(__uint_as_float(r[0]), __uint_as_float(r[1])); }
                const float inv = mx > 0.f ? 255.0f / mx : 0.f;
                unsigned char* rowp = O8 + (size_t)row * 8192 + col0;
#pragma unroll
                for (int bj = 0; bj < 2; ++bj) { u32x2 w; w.x = q4u_(h[bj][0] * inv, h[bj][1] * inv, h[bj][2] * inv, h[bj][3] * inv); w.y = q4u_(h[bj][4] * inv, h[bj][5] * inv, h[bj][6] * inv, h[bj][7] * inv);
                    *(u32x2*)(rowp + bj * 32) = w; }
                if (fq == 0) bs[(size_t)row * 128 + u.pn * 4 + wc] = mx * (1.0f / 255.0f); }
    }
};
struct EpiKV {
    static constexpr bool PERM = true, AFTER_DRAIN = false, I8 = false, OFFS = false;
    bf16_t* KBp; bf16_t* VBp; const PG8_LAS float* rstab; int tab_pm; const bf16_t* zsrc; int zld;
    __device__ __forceinline__ void operator()(const f32x4 (&acc)[2][2][4][2], const Unit& u, int wr, int wc, int fr, int fq) const {
        const int row0 = u.pm * BM + wr * 64 + fr; const int c0 = (wc & 1) * 64 + 8 * fq;
#pragma unroll
        for (int ai = 0; ai < 2; ++ai)
#pragma unroll
            for (int m = 0; m < 4; ++m) { const size_t row = (size_t)(row0 + ai * HALF + m * 16);
                const float rs = (u.pm == tab_pm) ? rstab[ai * HALF + wr * 64 + m * 16 + fr] : zrow_rstd(zsrc + row * zld);
#pragma unroll
                for (int bj = 0; bj < 2; ++bj) { const f32x4 v0 = acc[ai][bj][m][0] * rs, v1 = acc[ai][bj][m][1] * rs;
                    u32x4 w; w.x = cvt_pk_bf16(v0[0], v0[1]); w.y = cvt_pk_bf16(v0[2], v0[3]); w.z = cvt_pk_bf16(v1[0], v1[1]); w.w = cvt_pk_bf16(v1[2], v1[3]);
                    bf16_t* dst = (wc < 2 ? KBp + row * 1536 + u.pn * 192 : VBp + row * 1024 + u.pn * 128) + c0 + bj * 32;
                    *(u32x4*)dst = w; } }
    }
};
__device__ __forceinline__ float bfl(unsigned w) { return __uint_as_float(w << 16); }
__device__ __forceinline__ float bfh(unsigned w) { return __uint_as_float(w & 0xffff0000u); }
template <bool I8_ = false, bool OFFS_ = false> struct EpiResSplitT {
    static constexpr bool PERM = true, AFTER_DRAIN = false, I8 = I8_, OFFS = OFFS_;
    bf16_t* XH; bf16_t* XL; float* part; const float* qrow; const float* qcol; const float* qoff;
    __device__ __forceinline__ void operator()(const f32x4 (&acc)[2][2][4][2], const Unit& u, int wr, int wc, int fr, int fq) const {
        const int row0 = u.pm * BM + wr * 64 + fr, col0 = u.pn * BM + wc * 64 + 8 * fq;
#pragma unroll
        for (int ai = 0; ai < 2; ++ai) { u32x4 hx[4][2];
#pragma unroll
            for (int m = 0; m < 4; ++m)
#pragma unroll
                for (int bj = 0; bj < 2; ++bj) hx[m][bj] = *(const u32x4*)(XH + (size_t)(row0 + ai * HALF + m * 16) * 2048 + col0 + bj * 32);
            float qs[4] = {1.f, 1.f, 1.f, 1.f};
            if (I8_) {
#pragma unroll
                for (int m = 0; m < 4; ++m) qs[m] = qrow[row0 + ai * HALF + m * 16]; }
            asm volatile("" ::: "memory");
#pragma unroll
            for (int m = 0; m < 4; ++m) { const int row = row0 + ai * HALF + m * 16; const size_t off = (size_t)row * 2048 + col0; float ss = 0.f; const float qf = qs[m];
#pragma unroll
                for (int bj = 0; bj < 2; ++bj) { const u32x4 h = hx[m][bj]; u32x4 l = {0u, 0u, 0u, 0u}; if (XL) l = *(const u32x4*)(XL + off + bj * 32);
                    const f32x4 a0 = I8_ ? acc[ai][bj][m][0] * qf : acc[ai][bj][m][0], a1 = I8_ ? acc[ai][bj][m][1] * qf : acc[ai][bj][m][1]; float x[8];
                    x[0] = (bfl(h.x) + bfl(l.x)) + a0[0]; x[1] = (bfh(h.x) + bfh(l.x)) + a0[1]; x[2] = (bfl(h.y) + bfl(l.y)) + a0[2]; x[3] = (bfh(h.y) + bfh(l.y)) + a0[3];
                    x[4] = (bfl(h.z) + bfl(l.z)) + a1[0]; x[5] = (bfh(h.z) + bfh(l.z)) + a1[1]; x[6] = (bfl(h.w) + bfl(l.w)) + a1[2]; x[7] = (bfh(h.w) + bfh(l.w)) + a1[3];
                    ss += ((x[0] * x[0] + x[1] * x[1]) + (x[2] * x[2] + x[3] * x[3])) + ((x[4] * x[4] + x[5] * x[5]) + (x[6] * x[6] + x[7] * x[7]));
                    u32x4 nh; nh.x = cvt_pk_bf16(x[0], x[1]); nh.y = cvt_pk_bf16(x[2], x[3]); nh.z = cvt_pk_bf16(x[4], x[5]); nh.w = cvt_pk_bf16(x[6], x[7]);
                    *(u32x4*)(XH + off + bj * 32) = nh;
                    if (XL) { u32x4 nl; nl.x = cvt_pk_bf16(x[0] - bfl(nh.x), x[1] - bfh(nh.x)); nl.y = cvt_pk_bf16(x[2] - bfl(nh.y), x[3] - bfh(nh.y)); nl.z = cvt_pk_bf16(x[4] - bfl(nh.z), x[5] - bfh(nh.z)); nl.w = cvt_pk_bf16(x[6] - bfl(nh.w), x[7] - bfh(nh.w));
                        *(u32x4*)(XL + off + bj * 32) = nl; } }
                { auto r = __builtin_amdgcn_permlane16_swap(__float_as_uint(ss), __float_as_uint(ss), false, false); ss = __uint_as_float(r[0]) + __uint_as_float(r[1]); }
                { auto r = __builtin_amdgcn_permlane32_swap(__float_as_uint(ss), __float_as_uint(ss), false, false); ss = __uint_as_float(r[0]) + __uint_as_float(r[1]); }
                if (fq == 0) part[(size_t)row * 32 + u.pn * 4 + wc] = ss; }
            asm volatile("" ::: "memory"); }
    }
};
typedef EpiResSplitT<false, false> EpiResSplit;
}

constexpr int NWAVES = 8, NTHR = NWAVES * 64;
constexpr int DM = 2048, BATCH = 4, SEQ = 4096, MTOK = BATCH * SEQ, DEPTH = 4, FF = 8192;
constexpr float NORM_EPS = 1e-6f;
constexpr int NZE = 4352, NZO = 5888;
constexpr int ZE_QLAT = 0, ZE_KVLAT = 512, ZE_QB = 1024, ZE_KB = 2048, ZE_VB = 3072, ZE_KPE = 4096;
constexpr int ZO_QC = 0, ZO_KC = 1536, ZO_VC = 3072, ZO_QD = 4608, ZO_KD = 5632, ZO_VD = 5760;
constexpr int NQMLA = 1536, NKVU = 2048, NCAT_E = 2048, NCAT_O = 1536;

constexpr size_t MiB = 1u << 20;
constexpr size_t WS_CTL = 0, CTL_ZERO_BYTES = 1 * MiB;
constexpr size_t WS_ROPE = 1 * MiB;
constexpr size_t WS_KTN = 2 * MiB + 128 * 1024;
constexpr size_t WS_KM = 2 * MiB;
constexpr size_t WS_LSE = 3 * MiB;
constexpr size_t WS_WUP = 4 * MiB, WS_WDN = 132 * MiB, WS_WINE = 260 * MiB, WS_WUQ = 294 * MiB, WS_WUKV = 297 * MiB, WS_WOUTE = 301 * MiB, WS_WINO = 317 * MiB, WS_WOUTO = 363 * MiB;
constexpr size_t WS_H = 376 * MiB, WS_Z = 440 * MiB, WS_QKVN = 624 * MiB, WS_QMLA = 656 * MiB, WS_KB = 704 * MiB, WS_VB = 752 * MiB, WS_CAT = 784 * MiB, WS_OD = 848 * MiB, WS_XL = 896 * MiB, WS_PA = 960 * MiB, WS_PB = 962 * MiB, WS_END = 964 * MiB;
constexpr size_t WS_XQ = 896 * MiB, WS_CATQ = 928 * MiB;
constexpr size_t WS_XQS = 3 * MiB + 768 * 1024, WS_CATQS = WS_XQS + 65536;
constexpr size_t WS_WQINE = 964 * MiB, WS_WQINO = 980 * MiB, WS_WQOUTE = 1003 * MiB, WS_WQOUTO = 1011 * MiB, WS_END2 = 1018 * MiB;
constexpr size_t WS_CSTEP = 1017 * MiB;
constexpr int CS_INE = 0, CS_INO = 8192, CS_OUTE = 8192 + 11776, CS_OUTO = CS_OUTE + 4096;
constexpr int CW_WMAX = 12288;
constexpr size_t WS_U = 440 * MiB;
static_assert(WS_U + (size_t)MTOK * FF * 2 <= WS_KB && WS_H + (size_t)MTOK * DM * 2 <= WS_Z && WS_Z + (size_t)MTOK * NZO * 2 <= WS_QKVN, "ws map");
constexpr int CW_QUEUE = 8192;
constexpr int CW_BAR = 4096;

constexpr int RING_OFF = 0, RING_BYTES = 131072, QBUF_OFF = 131072, LDSCTL_OFF = 139264, LDS_BYTES = 147456;

#define GAS __attribute__((address_space(1)))
#define LAS __attribute__((address_space(3)))
typedef unsigned short bf16;
typedef unsigned v4u __attribute__((ext_vector_type(4)));
typedef unsigned v2u __attribute__((ext_vector_type(2)));
typedef float f32x4 __attribute__((ext_vector_type(4)));
#define LDS_WAIT() asm volatile("s_waitcnt lgkmcnt(0)" ::: "memory")
#define VM_WAIT() asm volatile("s_waitcnt vmcnt(0)" ::: "memory")
__device__ __forceinline__ unsigned f2bf(float f) { unsigned u = __builtin_bit_cast(unsigned, f); return (u + 0x7fffu + ((u >> 16) & 1u)) >> 16; }
__device__ __forceinline__ unsigned pk2(float lo, float hi) { return f2bf(lo) | (f2bf(hi) << 16); }
__device__ __forceinline__ float bf_lo(unsigned w) { return __uint_as_float(w << 16); }
__device__ __forceinline__ float bf_hi(unsigned w) { return __uint_as_float(w & 0xffff0000u); }
__device__ __forceinline__ float bf1(bf16 b) { return __uint_as_float(((unsigned)b) << 16); }
#define DPP_ADD(v, ctrl) ((v) + __int_as_float(__builtin_amdgcn_update_dpp(0, __float_as_int(v), (ctrl), 0xf, 0xf, false)))
__device__ __forceinline__ float wave_sum_v(float v) {
    v = DPP_ADD(v, 0xB1); v = DPP_ADD(v, 0x4E); v = DPP_ADD(v, 0x141); v = DPP_ADD(v, 0x140);
    { auto r = __builtin_amdgcn_permlane16_swap(__float_as_uint(v), __float_as_uint(v), false, false); v = __uint_as_float(r[0]) + __uint_as_float(r[1]); }
    { auto r = __builtin_amdgcn_permlane32_swap(__float_as_uint(v), __float_as_uint(v), false, false); v = __uint_as_float(r[0]) + __uint_as_float(r[1]); }
    return v;
}
#define DPP_MAX(v, ctrl) fmaxf((v), __int_as_float(__builtin_amdgcn_update_dpp(0, __float_as_int(v), (ctrl), 0xf, 0xf, false)))
__device__ __forceinline__ float wave_max_v(float v) {
    v = DPP_MAX(v, 0xB1); v = DPP_MAX(v, 0x4E); v = DPP_MAX(v, 0x141); v = DPP_MAX(v, 0x140);
    { auto r = __builtin_amdgcn_permlane16_swap(__float_as_uint(v), __float_as_uint(v), false, false); v = fmaxf(__uint_as_float(r[0]), __uint_as_float(r[1])); }
    { auto r = __builtin_amdgcn_permlane32_swap(__float_as_uint(v), __float_as_uint(v), false, false); v = fmaxf(__uint_as_float(r[0]), __uint_as_float(r[1])); }
    return v;
}
__device__ __forceinline__ float shfl_xor_l(float v, int o, int lane) { return __int_as_float(__builtin_amdgcn_ds_bpermute((lane ^ o) << 2, __float_as_int(v))); }
__device__ __forceinline__ float wave_sum_l(float v, int lane) {
#pragma unroll
    for (int o = 1; o < 64; o <<= 1) v += shfl_xor_l(v, o, lane);
    return v;
}
__device__ __forceinline__ float wave_max_l(float v, int lane) {
#pragma unroll
    for (int o = 1; o < 64; o <<= 1) v = fmaxf(v, shfl_xor_l(v, o, lane));
    return v;
}

#define XB_TMO      128
#define XB_XCNT(j)  (256  + 64 * (j))
#define XB_XSUB(j)  (1280 + 64 * (j))
#define XB_XGEN(j)  (2304 + 64 * (j))
#define XB_TOP      3328
#define XB_TOPGEN   3392
#define XCD_BAR_WORDS 3456
#define XB_SPIN_CAP (1u << 22)
__device__ __forceinline__ unsigned xb_ld(unsigned* p)              { return __hip_atomic_load(p, __ATOMIC_RELAXED, __HIP_MEMORY_SCOPE_AGENT); }
__device__ __forceinline__ unsigned xb_add(unsigned* p, unsigned v) { return __hip_atomic_fetch_add(p, v, __ATOMIC_RELAXED, __HIP_MEMORY_SCOPE_AGENT); }
__device__ __forceinline__ unsigned xb_xcc_id() { return (unsigned)__builtin_amdgcn_s_getreg((3 << 11) | 20) & 0xFu; }
#define XB_SPIN(cond, bar) do { unsigned _sp = 0; while (cond) { __builtin_amdgcn_s_sleep(1); \
    if ((++_sp & 255u) == 0u) { if (xb_ld(&(bar)[XB_TMO])) break; if (_sp > XB_SPIN_CAP) { atomicAdd(&(bar)[XB_TMO], 1u); break; } } } } while (0)
struct XcdBarrier { unsigned* bar; unsigned x; volatile LAS unsigned* st; };
__device__ __forceinline__ XcdBarrier xcd_barrier_post(unsigned* bar, volatile LAS unsigned* st) {
    XcdBarrier b; b.bar = bar; b.x = xb_xcc_id(); b.st = st;
    if (threadIdx.x == 0) st[2] = xb_add(&bar[XB_XCNT(b.x)], 1u);
    return b;
}
__device__ __forceinline__ void xcd_barrier_complete(unsigned* bar, unsigned x, unsigned& nloc, unsigned& nx) {
    const unsigned G = gridDim.x * gridDim.y * gridDim.z;
    unsigned sum, cnt, mine, sp = 0u;
    for (;;) {
        sum = 0u; cnt = 0u; mine = 0u;
#pragma unroll
        for (unsigned j = 0; j < 16; ++j) { const unsigned c = xb_ld(&bar[XB_XCNT(j)]); sum += c; cnt += (c > 0u) ? 1u : 0u; mine = (j == x) ? c : mine; }
        if (sum == G) break;
        __builtin_amdgcn_s_sleep(1);
        if ((++sp & 255u) == 0u) { if (xb_ld(&bar[XB_TMO])) break; if (sp > XB_SPIN_CAP) { atomicAdd(&bar[XB_TMO], 1u); break; } }
    }
    nloc = mine > 0u ? mine : 1u; nx = cnt > 0u ? cnt : 1u;
}
__device__ __forceinline__ void xcd_barrier(const XcdBarrier& b) {
    asm volatile("s_waitcnt vmcnt(0)" ::: "memory");
    __syncthreads();
    if (threadIdx.x == 0) {
        unsigned* bar = b.bar;
        __builtin_amdgcn_s_waitcnt(0);
        unsigned nloc = b.st[0], nx = b.st[1];
        if (nloc == 0u) { xcd_barrier_complete(bar, b.x, nloc, nx); b.st[0] = nloc; b.st[1] = nx; }
        const unsigned old = xb_add(&bar[XB_XSUB(b.x)], 1u);
        const unsigned gen = old / nloc;
        if (old + 1u == (gen + 1u) * nloc) {
            __builtin_amdgcn_fence(__ATOMIC_RELEASE, "agent");
            asm volatile("s_waitcnt vmcnt(0)" ::: "memory");
            const unsigned og = xb_add(&bar[XB_TOP], 1u);
            const unsigned tg = og / nx;
            if (og + 1u == (tg + 1u) * nx) xb_add(&bar[XB_TOPGEN], 1u);
            else XB_SPIN(xb_ld(&bar[XB_TOPGEN]) == tg, bar);
            __builtin_amdgcn_fence(__ATOMIC_ACQUIRE, "agent");
            xb_add(&bar[XB_XGEN(b.x)], 1u);
            asm volatile("s_waitcnt vmcnt(0)" ::: "memory");
        } else {
            XB_SPIN(xb_ld(&bar[XB_XGEN(b.x)]) == gen, bar);
            __builtin_amdgcn_fence(__ATOMIC_ACQUIRE, "agent");
            asm volatile("s_waitcnt vmcnt(0)" ::: "memory");
        }
    }
    __syncthreads();
}

struct Args { const float* in[15]; float* out; unsigned char* ws; int ph_lo, ph_hi; };
typedef __attribute__((address_space(4))) const Args* KArgs;
__device__ __forceinline__ KArgs kargs() { KArgs p = (KArgs)__builtin_amdgcn_kernarg_segment_ptr(); asm volatile("" : "+s"(p)); return p; }
__device__ __forceinline__ int tid_now_() { int t = threadIdx.x; asm volatile("" : "+v"(t)); return t; }
struct Env { int lane, wave, gw, NGW, G; };
__device__ __forceinline__ Env make_env() { int tid = threadIdx.x; asm volatile("" : "+v"(tid)); Env e; e.lane = tid & 63; e.wave = __builtin_amdgcn_readfirstlane(tid >> 6); e.G = gridDim.x; e.gw = blockIdx.x * NWAVES + e.wave; e.NGW = e.G * NWAVES; return e; }
enum { I_X = 0, I_ATTN_NORM, I_MLP_NORM, I_WUP, I_WDN, I_EV_WIN, I_EV_QNORM, I_EV_WUQ, I_EV_KVNORM, I_EV_WUKV, I_EV_WOUT, I_OD_WIN, I_OD_SINKS, I_OD_WOUT, I_FINAL_NORM };

#ifndef IN_I8_MASK
#define IN_I8_MASK 14
#endif
#ifndef DN_I8_MASK
#define DN_I8_MASK 14
#endif
#ifndef UP_I8_MASK
#define UP_I8_MASK 14
#endif
struct Job { const float* W; bf16* WT; const float* gain; int K, ldw, scol0, drow0, ncols, qid; };
constexpr int NJOBS = 24;
__device__ __forceinline__ Job make_job(KArgs a, int j) {
    Job J; unsigned char* ws = a->ws; J.gain = nullptr; J.qid = -1;
    if (j < 4) { J.W = a->in[I_WUP] + (size_t)j * DM * FF; J.WT = (bf16*)(ws + WS_WUP) + (size_t)j * FF * DM; J.K = DM; J.ldw = FF; J.scol0 = 0; J.drow0 = 0; J.ncols = ((UP_I8_MASK >> j) & 1) ? 0 : FF; J.gain = a->in[I_MLP_NORM] + j * DM; return J; }
    if (j < 8) { const int l = j - 4; J.W = a->in[I_WDN] + (size_t)l * FF * DM; J.WT = (bf16*)(ws + WS_WDN) + (size_t)l * DM * FF; J.K = FF; J.ldw = DM; J.scol0 = 0; J.drow0 = 0; J.ncols = ((DN_I8_MASK >> l) & 1) ? 0 : DM; return J; }
    const int i = (j - 8) >> 3, sub = (j - 8) & 7;
    if (sub < 3) { J.W = a->in[I_EV_WIN] + (size_t)i * DM * 4160; J.WT = (bf16*)(ws + WS_WINE) + (size_t)i * NZE * DM; J.K = DM; J.ldw = 4160; J.gain = a->in[I_ATTN_NORM] + (2 * i) * DM;
        if (sub == 0) { J.scol0 = 0; J.drow0 = 0; J.ncols = 1024; J.qid = i; } else if (sub == 1) { J.scol0 = 1088; J.drow0 = 1024; J.ncols = 3072; J.qid = i; } else { J.scol0 = 1024; J.drow0 = 4096; J.ncols = 64; }
        if (sub < 2 && ((IN_I8_MASK >> (2 * i)) & 1)) J.ncols = 0;
        return J; }
    J.scol0 = 0; J.drow0 = 0;
    if (sub == 3) { J.W = a->in[I_EV_WUQ] + (size_t)i * 512 * NQMLA; J.WT = (bf16*)(ws + WS_WUQ) + (size_t)i * NQMLA * 512; J.K = 512; J.ldw = NQMLA; J.ncols = NQMLA; J.gain = a->in[I_EV_QNORM] + i * 512; return J; }
    if (sub == 4) { J.W = a->in[I_EV_WUKV] + (size_t)i * 512 * NKVU; J.WT = (bf16*)(ws + WS_WUKV) + (size_t)i * NKVU * 512; J.K = 512; J.ldw = NKVU; J.ncols = NKVU; J.gain = a->in[I_EV_KVNORM] + i * 512; return J; }
    if (sub == 5) { J.W = a->in[I_EV_WOUT] + (size_t)i * NCAT_E * DM; J.WT = (bf16*)(ws + WS_WOUTE) + (size_t)i * DM * NCAT_E; J.K = NCAT_E; J.ldw = DM; J.ncols = 0; J.qid = 4 + i; return J; }
    if (sub == 6) { J.W = a->in[I_OD_WIN] + (size_t)i * DM * NZO; J.WT = (bf16*)(ws + WS_WINO) + (size_t)i * NZO * DM; J.K = DM; J.ldw = NZO; J.ncols = NZO; J.gain = a->in[I_ATTN_NORM] + (2 * i + 1) * DM; J.qid = 2 + i; if ((IN_I8_MASK >> (2 * i + 1)) & 1) J.ncols = 0; return J; }
    J.W = a->in[I_OD_WOUT] + (size_t)i * NCAT_O * DM; J.WT = (bf16*)(ws + WS_WOUTO) + (size_t)i * DM * NCAT_O; J.K = NCAT_O; J.ldw = DM; J.ncols = 0; J.qid = 6 + i; return J;
}
__device__ __forceinline__ void tile_load(const Job& J, int item, int lane, f32x4 (&v)[8], unsigned* ctl) {
    const int nblk = J.ncols / 32, kb = item / nblk, nb = item % nblk, k0 = 64 * kb, n0 = 32 * nb;
    const GAS float* W = (const GAS float*)J.W + (size_t)(k0 + (lane >> 3)) * J.ldw + J.scol0 + n0 + 4 * (lane & 7);
#pragma unroll
    for (int i = 0; i < 8; ++i) v[i] = __builtin_nontemporal_load((const GAS f32x4*)(W + (size_t)(8 * i) * J.ldw));
    if (J.gain) {
#pragma unroll
        for (int i = 0; i < 8; ++i) v[i] = v[i] * ((const GAS float*)J.gain)[k0 + 8 * i + (lane >> 3)]; }
}
__device__ __forceinline__ void tile_store(const Job& J, LAS float* scr, int item, int lane, const f32x4 (&v)[8]) {
    const int nblk = J.ncols / 32, kb = item / nblk, nb = item % nblk, k0 = 64 * kb, n0 = 32 * nb;
#pragma unroll
    for (int i = 0; i < 8; ++i) { LAS float* d = scr + (8 * i + (lane >> 3)) * 33 + 4 * (lane & 7); d[0] = v[i][0]; d[1] = v[i][1]; d[2] = v[i][2]; d[3] = v[i][3]; }
    LDS_WAIT(); asm volatile("" ::: "memory");
    const int c = lane & 7;
#pragma unroll
    for (int j = 0; j < 4; ++j) { const int n = (lane >> 3) + 8 * j; const LAS float* s = scr + (8 * c) * 33 + n;
        v4u o; o.x = pk2(s[0 * 33], s[1 * 33]); o.y = pk2(s[2 * 33], s[3 * 33]); o.z = pk2(s[4 * 33], s[5 * 33]); o.w = pk2(s[6 * 33], s[7 * 33]);
        *(GAS v4u*)(J.WT + (size_t)(J.drow0 + n0 + n) * J.K + k0 + 8 * c) = o; }
    LDS_WAIT(); asm volatile("" ::: "memory");
}
__device__ __forceinline__ void prologue_phase(KArgs a, LAS unsigned char* lds, int gw, int NGW, int wave, int lane) {
    LAS float* scr = (LAS float*)(lds + RING_OFF + wave * 16384); unsigned* ctl_ = (unsigned*)(a->ws + WS_CTL);
    int total = 0;
    for (int j = 0; j < NJOBS; ++j) { const Job J = make_job(a, j); total += (J.K / 64) * (J.ncols / 32); }
    int jc = 0, basec = 0; Job Jc = make_job(a, 0); int nitc = (Jc.K / 64) * (Jc.ncols / 32);
#define PRO_LOCATE(gi) do { while ((gi) - basec >= nitc) { basec += nitc; ++jc; Jc = make_job(a, jc); nitc = (Jc.K / 64) * (Jc.ncols / 32); } } while (0)
    f32x4 v[8]; int gi = gw;
    if (gi < total) { PRO_LOCATE(gi); tile_load(Jc, gi - basec, lane, v, ctl_); }
    while (gi < total) {
        const Job Jt = Jc; const int itt = gi - basec; const int gn = gi + NGW;
        f32x4 vn[8];
        if (gn < total) { PRO_LOCATE(gn); tile_load(Jc, gn - basec, lane, vn, ctl_); }
        tile_store(Jt, scr, itt, lane, v);
        if (gn < total) {
#pragma unroll
            for (int i = 0; i < 8; ++i) v[i] = vn[i]; }
        gi = gn;
    }
#undef PRO_LOCATE
    for (int i = 0; i < 2; ++i) { GAS v4u* p = (GAS v4u*)((bf16*)(a->ws + WS_WINE) + (size_t)i * NZE * DM + (size_t)4160 * DM); const int n16 = 192 * DM / 8;
        for (int e = gw * 64 + lane; e < n16; e += NGW * 64) p[e] = (v4u){0u, 0u, 0u, 0u}; }
    { GAS float* ct = (GAS float*)(a->ws + WS_ROPE); GAS float* st = ct + SEQ * 32;
        for (int e = gw * 64 + lane; e < SEQ * 32; e += NGW * 64) { const int pos = e >> 5, i = e & 31; const double inv = exp2(-(double)i * (13.287712379549449 / 32.0)); const double ang = (double)pos * inv;
            ct[e] = (float)cos(ang); st[e] = (float)sin(ang); } }
}

__device__ __forceinline__ void init_phase(const float* X, bf16* XH, bf16* XL, float* PB, int gw, int NGW, int lane) {
    f32x4 v[8];
    if (gw < MTOK) { const GAS f32x4* xr = (const GAS f32x4*)(X + (size_t)gw * DM) + lane;
#pragma unroll
        for (int j = 0; j < 8; ++j) v[j] = xr[64 * j]; }
    for (int m = gw; m < MTOK; m += NGW) {
        f32x4 vn[8]; const int mn = m + NGW < MTOK ? m + NGW : m;
        { const GAS f32x4* xr = (const GAS f32x4*)(X + (size_t)mn * DM) + lane;
#pragma unroll
          for (int j = 0; j < 8; ++j) vn[j] = xr[64 * j]; }
        float s = 0.f;
#pragma unroll
        for (int j = 0; j < 8; ++j) s += (v[j].x * v[j].x + v[j].y * v[j].y) + (v[j].z * v[j].z + v[j].w * v[j].w);
        s = wave_sum_v(s);
        GAS v2u* oh = (GAS v2u*)(XH + (size_t)m * DM) + lane; GAS v2u* ol = (GAS v2u*)(XL + (size_t)m * DM) + lane;
#pragma unroll
        for (int j = 0; j < 8; ++j) { v2u h; h.x = pk2(v[j].x, v[j].y); h.y = pk2(v[j].z, v[j].w);
            v2u l; l.x = pk2(v[j].x - bf_lo(h.x), v[j].y - bf_hi(h.x)); l.y = pk2(v[j].z - bf_lo(h.y), v[j].w - bf_hi(h.y)); oh[64 * j] = h; if (XL) ol[64 * j] = l; }
        if (lane < 32) ((GAS float*)PB)[(size_t)m * 32 + lane] = lane == 0 ? s : 0.f;
#pragma unroll
        for (int j = 0; j < 8; ++j) v[j] = vn[j];
    }
}
__device__ __forceinline__ void final_norm_phase(const bf16* XH, const bf16* XL, float* out, const float* g, int gw, int NGW, int lane) {
    f32x4 gv[8];
#pragma unroll
    for (int j = 0; j < 8; ++j) gv[j] = ((const GAS f32x4*)g)[64 * j + lane];
    v2u hc[8];
    if (gw < MTOK) { const GAS v2u* ph = (const GAS v2u*)(XH + (size_t)gw * DM) + lane;
#pragma unroll
        for (int j = 0; j < 8; ++j) hc[j] = ph[64 * j]; }
    for (int m = gw; m < MTOK; m += NGW) {
        v2u hn[8]; const int mn = m + NGW < MTOK ? m + NGW : m;
        { const GAS v2u* ph = (const GAS v2u*)(XH + (size_t)mn * DM) + lane;
#pragma unroll
          for (int j = 0; j < 8; ++j) hn[j] = ph[64 * j]; }
        const GAS v2u* pl = (const GAS v2u*)(XL + (size_t)m * DM) + lane;
        f32x4 v[8]; float s = 0.f;
#pragma unroll
        for (int j = 0; j < 8; ++j) { const v2u h = hc[j]; v2u l = {0u, 0u}; if (XL) l = pl[64 * j]; v[j].x = bf_lo(h.x) + bf_lo(l.x); v[j].y = bf_hi(h.x) + bf_hi(l.x); v[j].z = bf_lo(h.y) + bf_lo(l.y); v[j].w = bf_hi(h.y) + bf_hi(l.y);
            s += (v[j].x * v[j].x + v[j].y * v[j].y) + (v[j].z * v[j].z + v[j].w * v[j].w); }
        const float rstd = 1.0f / sqrtf(wave_sum_v(s) * (1.f / DM) + NORM_EPS);
        GAS f32x4* xo = (GAS f32x4*)(out + (size_t)m * DM) + lane;
#pragma unroll
        for (int j = 0; j < 8; ++j) xo[64 * j] = v[j] * rstd * gv[j];
#pragma unroll
        for (int j = 0; j < 8; ++j) hc[j] = hn[j];
    }
}
__device__ __forceinline__ unsigned q4(float a, float b, float c, float d) { return ((unsigned)(int)__builtin_rintf(a) & 255u) | (((unsigned)(int)__builtin_rintf(b) & 255u) << 8) | (((unsigned)(int)__builtin_rintf(c) & 255u) << 16) | ((unsigned)(int)__builtin_rintf(d) << 24); }
template <int NCH>
__device__ __forceinline__ void quant_rows(const bf16* src, int ld, signed char* dst, float* step, int nrows, int gw, int NGW, int lane) {
    v4u c[NCH];
    if (gw < nrows) { const GAS v4u* ps = (const GAS v4u*)(src + (size_t)gw * ld) + lane;
#pragma unroll
        for (int j = 0; j < NCH; ++j) c[j] = ps[64 * j]; }
    for (int m = gw; m < nrows; m += NGW) {
        v4u n[NCH]; const int mn = m + NGW < nrows ? m + NGW : m;
        { const GAS v4u* ps = (const GAS v4u*)(src + (size_t)mn * ld) + lane;
#pragma unroll
          for (int j = 0; j < NCH; ++j) n[j] = ps[64 * j]; }
        float mx = 0.f;
#pragma unroll
        for (int j = 0; j < NCH; ++j) mx = fmaxf(mx, fmaxf(fmaxf(fmaxf(fabsf(bf_lo(c[j].x)), fabsf(bf_hi(c[j].x))), fmaxf(fabsf(bf_lo(c[j].y)), fabsf(bf_hi(c[j].y)))), fmaxf(fmaxf(fabsf(bf_lo(c[j].z)), fabsf(bf_hi(c[j].z))), fmaxf(fabsf(bf_lo(c[j].w)), fabsf(bf_hi(c[j].w))))));
        mx = wave_max_v(mx);
        const float inv = mx > 0.f ? 127.0f / mx : 0.f;
        GAS v2u* pd = (GAS v2u*)(dst + (size_t)m * (NCH * 512)) + lane;
#pragma unroll
        for (int j = 0; j < NCH; ++j) { v2u o; o.x = q4(bf_lo(c[j].x) * inv, bf_hi(c[j].x) * inv, bf_lo(c[j].y) * inv, bf_hi(c[j].y) * inv); o.y = q4(bf_lo(c[j].z) * inv, bf_hi(c[j].z) * inv, bf_lo(c[j].w) * inv, bf_hi(c[j].w) * inv); pd[64 * j] = o; }
        if (lane == 0) ((GAS float*)step)[m] = mx * (1.0f / 127.0f);
#pragma unroll
        for (int j = 0; j < NCH; ++j) c[j] = n[j];
    }
}
template <int NCH>
__device__ __forceinline__ void quant_weight(const bf16* src, int ld, signed char* dst, float* cstep, int nrows, int gw, int NGW, int lane) {
    for (int m = gw; m < nrows; m += NGW) { const GAS v4u* ps = (const GAS v4u*)(src + (size_t)m * ld) + lane; GAS v2u* pd = (GAS v2u*)(dst + (size_t)m * (NCH * 512)) + lane; v4u c[NCH];
#pragma unroll
        for (int j = 0; j < NCH; ++j) c[j] = ps[64 * j];
        float mx = 0.f;
#pragma unroll
        for (int j = 0; j < NCH; ++j) mx = fmaxf(mx, fmaxf(fmaxf(fmaxf(fabsf(bf_lo(c[j].x)), fabsf(bf_hi(c[j].x))), fmaxf(fabsf(bf_lo(c[j].y)), fabsf(bf_hi(c[j].y)))), fmaxf(fmaxf(fabsf(bf_lo(c[j].z)), fabsf(bf_hi(c[j].z))), fmaxf(fabsf(bf_lo(c[j].w)), fabsf(bf_hi(c[j].w))))));
        mx = wave_max_v(mx);
        const float inv = mx > 0.f ? 127.0f / mx : 0.f;
#pragma unroll
        for (int j = 0; j < NCH; ++j) { v2u o; o.x = q4(bf_lo(c[j].x) * inv, bf_hi(c[j].x) * inv, bf_lo(c[j].y) * inv, bf_hi(c[j].y) * inv); o.y = q4(bf_lo(c[j].z) * inv, bf_hi(c[j].z) * inv, bf_lo(c[j].w) * inv, bf_hi(c[j].w) * inv); pd[64 * j] = o; }
        if (lane == 0) ((GAS float*)cstep)[m] = mx * (1.0f / 127.0f); }
}
struct SJob { const float* W; const float* gain; signed char* dst; float* cstep; int K, ldw, scol0, drow0, ncols, hasg; };
constexpr int NSJOBS = 14;
__device__ __forceinline__ SJob make_sjob(KArgs a, int j) {
    SJob J; unsigned char* ws = a->ws; J.W = nullptr; J.gain = a->in[I_ATTN_NORM]; J.hasg = 0; J.dst = nullptr; J.cstep = nullptr; J.K = DM; J.ldw = DM; J.scol0 = 0; J.drow0 = 0; J.ncols = 0;
    float* cst = (float*)(ws + WS_CSTEP);
    if (j < 4) { if ((UP_I8_MASK >> j) & 1) { J.W = a->in[I_WUP] + (size_t)j * DM * FF; J.gain = a->in[I_MLP_NORM] + j * DM; J.hasg = 1; J.dst = (signed char*)(ws + WS_WUP) + (size_t)j * FF * DM * 2; J.cstep = (float*)(J.dst + (size_t)FF * DM); J.ldw = FF; J.ncols = FF; } return J; }
    const int i = (j - 4) / 5, sub = (j - 4) % 5;
    if (sub < 2) { if ((IN_I8_MASK >> (2 * i)) & 1) { J.W = a->in[I_EV_WIN] + (size_t)i * DM * 4160; J.gain = a->in[I_ATTN_NORM] + (2 * i) * DM; J.hasg = 1; J.dst = (signed char*)(ws + WS_WQINE) + (size_t)i * 4096 * DM; J.cstep = cst + CS_INE + i * 4096; J.ldw = 4160;
                       if (sub == 0) { J.scol0 = 0; J.drow0 = 0; J.ncols = 1024; } else { J.scol0 = 1088; J.drow0 = 1024; J.ncols = 3072; } } return J; }
    if (sub == 2) { if ((IN_I8_MASK >> (2 * i + 1)) & 1) { J.W = a->in[I_OD_WIN] + (size_t)i * DM * NZO; J.gain = a->in[I_ATTN_NORM] + (2 * i + 1) * DM; J.hasg = 1; J.dst = (signed char*)(ws + WS_WQINO) + (size_t)i * NZO * DM; J.cstep = cst + CS_INO + i * NZO; J.ldw = NZO; J.ncols = NZO; } return J; }
    if (sub == 3) { J.W = a->in[I_EV_WOUT] + (size_t)i * NCAT_E * DM; J.dst = (signed char*)(ws + WS_WQOUTE) + (size_t)i * DM * NCAT_E; J.cstep = cst + CS_OUTE + i * DM; J.K = NCAT_E; J.ncols = DM; return J; }
    J.W = a->in[I_OD_WOUT] + (size_t)i * NCAT_O * DM; J.dst = (signed char*)(ws + WS_WQOUTO) + (size_t)i * DM * NCAT_O; J.cstep = cst + CS_OUTO + i * DM; J.K = NCAT_O; J.ncols = DM; return J;
}
__device__ __forceinline__ int q1i(float a) { return (int)__builtin_rintf(a); }
constexpr int NBIGSLABS = 128 * (((DN_I8_MASK >> 0) & 1) + ((DN_I8_MASK >> 1) & 1) + ((DN_I8_MASK >> 2) & 1) + ((DN_I8_MASK >> 3) & 1));
__device__ __forceinline__ void slabdn_load(const float* Wl, int slab, int bt, int tid, f32x4 (&v)[4][2]) {
    const GAS float* W = (const GAS float*)Wl + (size_t)(bt * 1024 + 2 * (tid >> 2)) * DM + 16 * slab + 4 * (tid & 3);
#pragma unroll
    for (int it = 0; it < 4; ++it) { const GAS float* p = W + (size_t)(it * 256) * DM; v[it][0] = __builtin_nontemporal_load((const GAS f32x4*)p); v[it][1] = __builtin_nontemporal_load((const GAS f32x4*)(p + DM)); }
}
__device__ __forceinline__ int dn_layer_of(int li) { int l = 0, cnt = -1; for (int b = 0; b < 4; ++b) if ((DN_I8_MASK >> b) & 1) { ++cnt; if (cnt == li) l = b; } return l; }
__device__ __forceinline__ void slabdn_phase(KArgs a, LAS unsigned char* lds, int tid) {
    constexpr int PD = 2052;
    LAS unsigned* T = (LAS unsigned*)(lds + RING_OFF); LAS float* wmax = (LAS float*)(T + 16 * PD);
    const int c4 = tid & 3, rp = tid >> 2, wave = __builtin_amdgcn_readfirstlane(tid >> 6), lane = tid & 63;
    const int c_ = (int)blockIdx.x; const bool xmap = gridDim.x == 256 && NBIGSLABS == 384;
    int s = xmap ? (c_ & 7) * 32 + (c_ >> 3) : c_; if (s >= NBIGSLABS) return;
    f32x4 v[4][2];
    { const int l = dn_layer_of(s >> 7); slabdn_load(a->in[I_WDN] + (size_t)l * FF * DM, s & 127, 0, tid, v); }
#pragma unroll 1
    for (;;) {
        const int l = dn_layer_of(s >> 7), sl = s & 127; const float* Wl = a->in[I_WDN] + (size_t)l * FF * DM;
        const int sn = xmap ? (s < 256 && c_ < 128 ? 256 + (c_ & 7) * 16 + (c_ >> 3) : NBIGSLABS) : s + (int)gridDim.x; const bool has_next = sn < NBIGSLABS; const int ln = dn_layer_of((has_next ? sn : s) >> 7); const float* Wn = a->in[I_WDN] + (size_t)ln * FF * DM;
        signed char* dst = (signed char*)(a->ws + WS_WDN) + (size_t)l * DM * FF * 2; float* cstep = (float*)(dst + (size_t)DM * FF); float* coff = cstep + 2048;
        unsigned keep[16][4]; float mx0 = 0.f, mx1 = 0.f, mx2 = 0.f, mx3 = 0.f;
#pragma unroll
        for (int bt = 0; bt < 8; ++bt) {
            f32x4 vn[4][2];
            if (bt < 7) slabdn_load(Wl, sl, bt + 1, tid, vn); else slabdn_load(has_next ? Wn : Wl, has_next ? (sn & 127) : sl, has_next ? 0 : 7, tid, vn);
#pragma unroll
            for (int it = 0; it < 4; ++it) {
                const unsigned d0 = pk2(v[it][0][0], v[it][1][0]), d1 = pk2(v[it][0][1], v[it][1][1]), d2 = pk2(v[it][0][2], v[it][1][2]), d3 = pk2(v[it][0][3], v[it][1][3]);
                if (bt < 4) { const int kd = bt * 512 + it * 128 + rp; T[(4 * c4 + 0) * PD + kd] = d0; T[(4 * c4 + 1) * PD + kd] = d1; T[(4 * c4 + 2) * PD + kd] = d2; T[(4 * c4 + 3) * PD + kd] = d3; }
                else { keep[(bt & 3) * 4 + it][0] = d0; keep[(bt & 3) * 4 + it][1] = d1; keep[(bt & 3) * 4 + it][2] = d2; keep[(bt & 3) * 4 + it][3] = d3; }
                mx0 = fmaxf(mx0, fmaxf(fabsf(bf_lo(d0)), fabsf(bf_hi(d0)))); mx1 = fmaxf(mx1, fmaxf(fabsf(bf_lo(d1)), fabsf(bf_hi(d1)))); mx2 = fmaxf(mx2, fmaxf(fabsf(bf_lo(d2)), fabsf(bf_hi(d2)))); mx3 = fmaxf(mx3, fmaxf(fabsf(bf_lo(d3)), fabsf(bf_hi(d3)))); }
            __builtin_amdgcn_sched_barrier(0);
#pragma unroll
            for (int it = 0; it < 4; ++it) { v[it][0] = vn[it][0]; v[it][1] = vn[it][1]; }
        }
#pragma unroll
        for (int o = 4; o < 64; o <<= 1) { mx0 = fmaxf(mx0, __shfl_xor(mx0, o)); mx1 = fmaxf(mx1, __shfl_xor(mx1, o)); mx2 = fmaxf(mx2, __shfl_xor(mx2, o)); mx3 = fmaxf(mx3, __shfl_xor(mx3, o)); }
        if (lane < 4) { wmax[wave * 16 + 4 * lane + 0] = mx0; wmax[wave * 16 + 4 * lane + 1] = mx1; wmax[wave * 16 + 4 * lane + 2] = mx2; wmax[wave * 16 + 4 * lane + 3] = mx3; }
        __syncthreads();
        float cmx[2], inv[2], sum[2] = {0.f, 0.f};
#pragma unroll
        for (int cc = 0; cc < 2; ++cc) { float m_ = 0.f;
#pragma unroll
            for (int w2 = 0; w2 < 8; ++w2) m_ = fmaxf(m_, wmax[w2 * 16 + 2 * wave + cc]);
            cmx[cc] = m_; inv[cc] = m_ > 0.f ? 127.0f / m_ : 0.f; }
#pragma unroll
        for (int hf = 0; hf < 2; ++hf) {
            if (hf == 1) { __syncthreads();
#pragma unroll
                for (int i = 0; i < 16; ++i) { const int kd = i * 128 + rp; T[(4 * c4 + 0) * PD + kd] = keep[i][0]; T[(4 * c4 + 1) * PD + kd] = keep[i][1]; T[(4 * c4 + 2) * PD + kd] = keep[i][2]; T[(4 * c4 + 3) * PD + kd] = keep[i][3]; }
                __syncthreads(); }
#pragma unroll
            for (int cc = 0; cc < 2; ++cc) { const int col = 2 * wave + cc, n = 16 * sl + col; GAS v2u* pd = (GAS v2u*)(dst + (size_t)n * FF + hf * 4096) + lane; const float iv = inv[cc]; float sm = 0.f;
#pragma unroll 1
                for (int ch = 0; ch < 8; ++ch) { const v4u c = *(const LAS v4u*)(T + col * PD + ch * 256 + lane * 4);
                    const int q0 = q1i(bf_lo(c.x) * iv), q1 = q1i(bf_hi(c.x) * iv), q2 = q1i(bf_lo(c.y) * iv), q3 = q1i(bf_hi(c.y) * iv), q4_ = q1i(bf_lo(c.z) * iv), q5 = q1i(bf_hi(c.z) * iv), q6 = q1i(bf_lo(c.w) * iv), q7 = q1i(bf_hi(c.w) * iv);
                    sm += (float)(((q0 + q1) + (q2 + q3)) + ((q4_ + q5) + (q6 + q7)));
                    v2u o; o.x = ((unsigned)q0 & 255u) | (((unsigned)q1 & 255u) << 8) | (((unsigned)q2 & 255u) << 16) | ((unsigned)q3 << 24); o.y = ((unsigned)q4_ & 255u) | (((unsigned)q5 & 255u) << 8) | (((unsigned)q6 & 255u) << 16) | ((unsigned)q7 << 24); pd[64 * ch] = o; }
                sum[cc] += sm; }
        }
#pragma unroll
        for (int cc = 0; cc < 2; ++cc) { const float st = wave_sum_v(sum[cc]); const int n = 16 * sl + 2 * wave + cc; if (lane == 0) { ((GAS float*)cstep)[n] = cmx[cc] * (1.0f / 127.0f); ((GAS float*)coff)[n] = 128.0f * st; } }
        __syncthreads();
        if (!has_next) break;
        s = sn;
    }
}
__device__ __forceinline__ void slab_load(const SJob& J, int slab, int bt, int tid, f32x4 (&v)[4][2], float (&g)[4][2]) {
    const int c4 = tid & 7, rp = tid >> 3;
#pragma unroll
    for (int it = 0; it < 4; ++it) { const int k = bt * 512 + it * 128 + 2 * rp; g[it][0] = ((const GAS float*)J.gain)[k]; g[it][1] = ((const GAS float*)J.gain)[k + 1]; }
    const GAS float* W = (const GAS float*)J.W + (size_t)(bt * 512 + 2 * rp) * J.ldw + J.scol0 + 32 * slab + 4 * c4;
#pragma unroll
    for (int it = 0; it < 4; ++it) { const GAS float* p = W + (size_t)(it * 128) * J.ldw; v[it][0] = __builtin_nontemporal_load((const GAS f32x4*)p); v[it][1] = __builtin_nontemporal_load((const GAS f32x4*)(p + J.ldw)); }
}
__device__ __forceinline__ void slab_phase(KArgs a, LAS unsigned char* lds, int tid) {
    constexpr int PD = 1026;
    LAS unsigned* T = (LAS unsigned*)(lds + RING_OFF); LAS float* wmax = (LAS float*)(T + 32 * PD);
    const int c4 = tid & 7, rp = tid >> 3, wave = __builtin_amdgcn_readfirstlane(tid >> 6), lane = tid & 63;
    int total = 0;
    for (int j = 0; j < NSJOBS; ++j) total += make_sjob(a, j).ncols / 32;
    const int G_ = (int)gridDim.x, c_ = (int)blockIdx.x; const bool skew = G_ == 256 && NBIGSLABS == 384 && total >= 256;
    auto seq = [&](int n) -> int { if (!skew) return c_ + n * G_; if (c_ >= 128) { if (n < 2) return 2 * (c_ - 128) + n; return 256 + c_ + 256 * (n - 2); } return 256 + c_ + 256 * n; };
    int nseq = 0; int s = seq(0); if (s >= total) return;
    int jc = 0, basec = 0; SJob J = make_sjob(a, 0);
#define SLAB_LOCATE(si) do { while ((si) - basec >= J_.ncols / 32) { basec += J_.ncols / 32; ++jc; J_ = make_sjob(a, jc); } } while (0)
    { SJob J_ = J; SLAB_LOCATE(s); J = J_; }
    int sl = s - basec;
    f32x4 v[4][2]; float g[4][2];
    slab_load(J, sl, 0, tid, v, g);
#pragma unroll 1
    for (;;) {
        const int sn = seq(nseq + 1); const bool has_next = sn < total;
        SJob Jn = J; int sln = 0;
        if (has_next) { SJob J_ = J; SLAB_LOCATE(sn); Jn = J_; sln = sn - basec; }
        float mx0 = 0.f, mx1 = 0.f, mx2 = 0.f, mx3 = 0.f; const int nb = J.K / 512;
#pragma unroll 1
        for (int bt = 0; bt < nb; ++bt) {
            f32x4 vn[4][2]; float gn[4][2];
            { const bool more = bt + 1 < nb; SJob Jl = more || !has_next ? J : Jn; slab_load(Jl, more || !has_next ? sl : sln, more ? bt + 1 : (has_next ? 0 : bt), tid, vn, gn); }
#pragma unroll
            for (int it = 0; it < 4; ++it) { const int kd = bt * 256 + it * 64 + rp; const float g0 = J.hasg ? g[it][0] : 1.f, g1 = J.hasg ? g[it][1] : 1.f;
                const unsigned d0 = pk2(v[it][0][0] * g0, v[it][1][0] * g1), d1 = pk2(v[it][0][1] * g0, v[it][1][1] * g1), d2 = pk2(v[it][0][2] * g0, v[it][1][2] * g1), d3 = pk2(v[it][0][3] * g0, v[it][1][3] * g1);
                T[(4 * c4 + 0) * PD + kd] = d0; T[(4 * c4 + 1) * PD + kd] = d1; T[(4 * c4 + 2) * PD + kd] = d2; T[(4 * c4 + 3) * PD + kd] = d3;
                mx0 = fmaxf(mx0, fmaxf(fabsf(bf_lo(d0)), fabsf(bf_hi(d0)))); mx1 = fmaxf(mx1, fmaxf(fabsf(bf_lo(d1)), fabsf(bf_hi(d1)))); mx2 = fmaxf(mx2, fmaxf(fabsf(bf_lo(d2)), fabsf(bf_hi(d2)))); mx3 = fmaxf(mx3, fmaxf(fabsf(bf_lo(d3)), fabsf(bf_hi(d3)))); }
            __builtin_amdgcn_sched_barrier(0);
#pragma unroll
            for (int it = 0; it < 4; ++it) { v[it][0] = vn[it][0]; v[it][1] = vn[it][1]; g[it][0] = gn[it][0]; g[it][1] = gn[it][1]; }
        }
#pragma unroll
        for (int o = 8; o < 64; o <<= 1) { mx0 = fmaxf(mx0, __shfl_xor(mx0, o)); mx1 = fmaxf(mx1, __shfl_xor(mx1, o)); mx2 = fmaxf(mx2, __shfl_xor(mx2, o)); mx3 = fmaxf(mx3, __shfl_xor(mx3, o)); }
        if (lane < 8) { wmax[wave * 32 + 4 * lane + 0] = mx0; wmax[wave * 32 + 4 * lane + 1] = mx1; wmax[wave * 32 + 4 * lane + 2] = mx2; wmax[wave * 32 + 4 * lane + 3] = mx3; }
        __syncthreads();
#pragma unroll 1
        for (int cc = 0; cc < 4; ++cc) { const int col = 4 * wave + cc; float mx = 0.f;
#pragma unroll
            for (int w2 = 0; w2 < 8; ++w2) mx = fmaxf(mx, wmax[w2 * 32 + col]);
            const float inv = mx > 0.f ? 127.0f / mx : 0.f; const int n = J.drow0 + 32 * sl + col; GAS v2u* pd = (GAS v2u*)(J.dst + (size_t)n * J.K) + lane;
#pragma unroll 1
            for (int ch = 0; ch < nb; ++ch) { const LAS v2u* sp = (const LAS v2u*)(T + col * PD + ch * 256 + lane * 4); const v2u x = sp[0], y = sp[1];
                v2u o; o.x = q4(bf_lo(x.x) * inv, bf_hi(x.x) * inv, bf_lo(x.y) * inv, bf_hi(x.y) * inv); o.y = q4(bf_lo(y.x) * inv, bf_hi(y.x) * inv, bf_lo(y.y) * inv, bf_hi(y.y) * inv); pd[64 * ch] = o; }
            if (lane == 0) ((GAS float*)J.cstep)[n] = mx * (1.0f / 127.0f); }
        __syncthreads();
        if (!has_next) break;
        J = Jn; sl = sln; s = sn; ++nseq;
    }
#undef SLAB_LOCATE
}
__device__ __forceinline__ unsigned q4u(float a, float b, float c, float d) { return ((unsigned)((int)__builtin_rintf(a) - 128) & 255u) | (((unsigned)((int)__builtin_rintf(b) - 128) & 255u) << 8) | (((unsigned)((int)__builtin_rintf(c) - 128) & 255u) << 16) | ((unsigned)((int)__builtin_rintf(d) - 128) << 24); }
__device__ __forceinline__ void quant_hidden(bf16* U, float* step, int gw, int NGW, int lane) {
    for (int m = gw; m < MTOK; m += NGW) { const GAS v4u* ps = (const GAS v4u*)(U + (size_t)m * FF) + lane; v4u c[16];
#pragma unroll
        for (int j = 0; j < 16; ++j) c[j] = ps[64 * j];
        float mx = 0.f;
#pragma unroll
        for (int j = 0; j < 16; ++j) mx = fmaxf(mx, fmaxf(fmaxf(fmaxf(bf_lo(c[j].x), bf_hi(c[j].x)), fmaxf(bf_lo(c[j].y), bf_hi(c[j].y))), fmaxf(fmaxf(bf_lo(c[j].z), bf_hi(c[j].z)), fmaxf(bf_lo(c[j].w), bf_hi(c[j].w)))));
        mx = wave_max_v(mx);
        const float inv = mx > 0.f ? 255.0f / mx : 0.f;
        asm volatile("s_waitcnt vmcnt(0)" ::: "memory");
        GAS v2u* pd = (GAS v2u*)((signed char*)(U + (size_t)m * FF)) + lane;
#pragma unroll
        for (int j = 0; j < 16; ++j) { v2u o; o.x = q4u(bf_lo(c[j].x) * inv, bf_hi(c[j].x) * inv, bf_lo(c[j].y) * inv, bf_hi(c[j].y) * inv); o.y = q4u(bf_lo(c[j].z) * inv, bf_hi(c[j].z) * inv, bf_lo(c[j].w) * inv, bf_hi(c[j].w) * inv); pd[64 * j] = o; }
        if (lane == 0) ((GAS float*)step)[m] = mx * (1.0f / 255.0f); }
}
__device__ __forceinline__ unsigned rq4(unsigned w, float ratio) {
    const float a = (float)((int)(signed char)(w & 255u) + 128) * ratio, b = (float)((int)(signed char)((w >> 8) & 255u) + 128) * ratio, c = (float)((int)(signed char)((w >> 16) & 255u) + 128) * ratio, d = (float)((int)(signed char)(w >> 24) + 128) * ratio;
    return q4u(a, b, c, d); }
__device__ __forceinline__ void requant_hidden(unsigned char* U8, const float* bs, float* step, int gw, int NGW, int lane) {
    for (int m = gw; m < MTOK; m += NGW) { GAS v4u* ps = (GAS v4u*)(U8 + (size_t)m * 8192) + lane; const GAS float* bp = (const GAS float*)bs + (size_t)m * 128; v4u c[8]; float bsv[8];
#pragma unroll
        for (int j = 0; j < 8; ++j) { c[j] = ps[64 * j]; bsv[j] = bp[j * 16 + (lane >> 2)]; }
        float mx = fmaxf(bp[lane], bp[64 + lane]);
        mx = wave_max_v(mx);
        const float inv = mx > 0.f ? 1.0f / mx : 0.f;
#pragma unroll
        for (int j = 0; j < 8; ++j) { const float ratio = bsv[j] * inv; v4u o; o.x = rq4(c[j].x, ratio); o.y = rq4(c[j].y, ratio); o.z = rq4(c[j].z, ratio); o.w = rq4(c[j].w, ratio); ps[64 * j] = o; }
        if (lane == 0) ((GAS float*)step)[m] = mx; }
}
__device__ __forceinline__ void quant_weight_dn(const bf16* src, signed char* dst, float* cstep, float* coff, int gw, int NGW, int lane) {
    for (int m = gw; m < DM; m += NGW) { const GAS v4u* ps = (const GAS v4u*)(src + (size_t)m * FF) + lane; GAS v2u* pd = (GAS v2u*)(dst + (size_t)m * FF) + lane; v4u c[16];
#pragma unroll
        for (int j = 0; j < 16; ++j) c[j] = ps[64 * j];
        float mx = 0.f;
#pragma unroll
        for (int j = 0; j < 16; ++j) mx = fmaxf(mx, fmaxf(fmaxf(fmaxf(fabsf(bf_lo(c[j].x)), fabsf(bf_hi(c[j].x))), fmaxf(fabsf(bf_lo(c[j].y)), fabsf(bf_hi(c[j].y)))), fmaxf(fmaxf(fabsf(bf_lo(c[j].z)), fabsf(bf_hi(c[j].z))), fmaxf(fabsf(bf_lo(c[j].w)), fabsf(bf_hi(c[j].w))))));
        mx = wave_max_v(mx);
        const float inv = mx > 0.f ? 127.0f / mx : 0.f; float sum = 0.f;
#pragma unroll
        for (int j = 0; j < 16; ++j) { const int q0 = q1i(bf_lo(c[j].x) * inv), q1 = q1i(bf_hi(c[j].x) * inv), q2 = q1i(bf_lo(c[j].y) * inv), q3 = q1i(bf_hi(c[j].y) * inv), q4_ = q1i(bf_lo(c[j].z) * inv), q5 = q1i(bf_hi(c[j].z) * inv), q6 = q1i(bf_lo(c[j].w) * inv), q7 = q1i(bf_hi(c[j].w) * inv);
            sum += (float)(((q0 + q1) + (q2 + q3)) + ((q4_ + q5) + (q6 + q7)));
            v2u o; o.x = ((unsigned)q0 & 255u) | (((unsigned)q1 & 255u) << 8) | (((unsigned)q2 & 255u) << 16) | ((unsigned)q3 << 24); o.y = ((unsigned)q4_ & 255u) | (((unsigned)q5 & 255u) << 8) | (((unsigned)q6 & 255u) << 16) | ((unsigned)q7 << 24); pd[64 * j] = o; }
        sum = wave_sum_v(sum);
        if (lane == 0) { ((GAS float*)cstep)[m] = mx * (1.0f / 127.0f); ((GAS float*)coff)[m] = 128.0f * sum; } }
}
__device__ __forceinline__ void prep_rstab_z(const bf16* Zc, int zld, int pm, LAS float* rstab, int tid) {
    const int wave = __builtin_amdgcn_readfirstlane(tid >> 6), lane = tid & 63;
#pragma unroll 1
    for (int hf = 0; hf < 2; ++hf) { v4u w[16];
#pragma unroll
        for (int i = 0; i < 16; ++i) w[i] = *(const GAS v4u*)(Zc + (size_t)(pm * 256 + wave * 32 + hf * 16 + i) * zld + lane * 8);
#pragma unroll
        for (int i = 0; i < 16; ++i) { const v4u x = w[i];
            float s = ((bf_lo(x.x) * bf_lo(x.x) + bf_hi(x.x) * bf_hi(x.x)) + (bf_lo(x.y) * bf_lo(x.y) + bf_hi(x.y) * bf_hi(x.y))) + ((bf_lo(x.z) * bf_lo(x.z) + bf_hi(x.z) * bf_hi(x.z)) + (bf_lo(x.w) * bf_lo(x.w) + bf_hi(x.w) * bf_hi(x.w)));
            s = wave_sum_v(s);
            if (lane == 0) rstab[wave * 32 + hf * 16 + i] = 1.0f / sqrtf(s * (1.f / 512) + NORM_EPS); } }
    __syncthreads();
}
__device__ __forceinline__ void prep_rstab(const float* part, int pm, LAS float* rstab, int tid) {
    const int row = tid >> 1, half = tid & 1; const GAS f32x4* pp = (const GAS f32x4*)(part + (size_t)(pm * 256 + row) * 32 + half * 16);
    const f32x4 a = pp[0], b = pp[1], c = pp[2], d = pp[3];
    float s = (((a[0] + a[1]) + (a[2] + a[3])) + ((b[0] + b[1]) + (b[2] + b[3]))) + (((c[0] + c[1]) + (c[2] + c[3])) + ((d[0] + d[1]) + (d[2] + d[3])));
    s = DPP_ADD(s, 0xB1);
    if (half == 0) rstab[row] = 1.0f / sqrtf(s * (1.f / DM) + NORM_EPS);
    __syncthreads();
}
__device__ __forceinline__ void prep_rstab_q(const float* part, const float* qrow, int pm, LAS float* rstab, int tid) {
    const int row = tid >> 1, half = tid & 1; const GAS f32x4* pp = (const GAS f32x4*)(part + (size_t)(pm * 256 + row) * 32 + half * 16);
    const f32x4 a = pp[0], b = pp[1], c = pp[2], d = pp[3];
    float s = (((a[0] + a[1]) + (a[2] + a[3])) + ((b[0] + b[1]) + (b[2] + b[3]))) + (((c[0] + c[1]) + (c[2] + c[3])) + ((d[0] + d[1]) + (d[2] + d[3])));
    s = DPP_ADD(s, 0xB1);
    if (half == 0) rstab[row] = (1.0f / sqrtf(s * (1.f / DM) + NORM_EPS)) * ((const GAS float*)qrow)[pm * 256 + row];
    __syncthreads();
}
__device__ __forceinline__ void latent_phase(KArgs a, int ev, LAS unsigned char* lds, int gw, int NGW, int wave, int lane) {
    const bf16* Z = (const bf16*)(a->ws + WS_Z); bf16* KBp = (bf16*)(a->ws + WS_KB); bf16* KM = (bf16*)(a->ws + WS_KM);
    const GAS float* ct = (const GAS float*)(a->ws + WS_ROPE); const GAS float* st = ct + SEQ * 32;
    { typedef short bf16x8_t __attribute__((ext_vector_type(8))); typedef float f32x16_t __attribute__((ext_vector_type(16)));
      const bf16* Hb = (const bf16*)(a->ws + WS_H); const float* PBp = (const float*)(a->ws + WS_PB);     const bf16* Wpe = (const bf16*)(a->ws + WS_WINE) + (size_t)ev * NZE * DM + (size_t)4096 * DM;
      LAS float* red = (LAS float*)(lds + RING_OFF);
      const int r32 = lane & 31, hi = lane >> 5;
      for (int chunk = blockIdx.x; chunk < MTOK / 32; chunk += gridDim.x) { const int row0 = chunk * 32;
          f32x16_t c0 = {}, c1 = {};
          const bf16* ap = Hb + (size_t)(row0 + r32) * DM + wave * 256 + hi * 8; const bf16* bp0 = Wpe + (size_t)r32 * DM + wave * 256 + hi * 8; const bf16* bp1 = bp0 + (size_t)32 * DM;
#pragma unroll
          for (int ks = 0; ks < 16; ++ks) { const bf16x8_t av = *(const GAS bf16x8_t*)(ap + ks * 16), b0 = *(const GAS bf16x8_t*)(bp0 + ks * 16), b1 = *(const GAS bf16x8_t*)(bp1 + ks * 16);
              c0 = __builtin_amdgcn_mfma_f32_32x32x16_bf16(av, b0, c0, 0, 0, 0); c1 = __builtin_amdgcn_mfma_f32_32x32x16_bf16(av, b1, c1, 0, 0, 0); }
#pragma unroll
          for (int r = 0; r < 16; ++r) { red[(wave * 32 + r) * 64 + lane] = c0[r]; red[(wave * 32 + 16 + r) * 64 + lane] = c1[r]; }
          __syncthreads();
#pragma unroll
          for (int rr = 0; rr < 2; ++rr) { const int r = 2 * wave + rr; float x1 = 0.f, x2 = 0.f;
#pragma unroll
              for (int w = 0; w < 8; ++w) { x1 += red[(w * 32 + r) * 64 + lane]; x2 += red[(w * 32 + 16 + r) * 64 + lane]; }
              const int tok = row0 + (r & 3) + 8 * (r >> 2) + 4 * hi, pos = tok & (SEQ - 1); const float c = ct[pos * 32 + r32], s = st[pos * 32 + r32];
              { float ssq = ((const GAS float*)PBp)[(size_t)tok * 32 + r32];
                ssq = DPP_ADD(ssq, 0xB1); ssq = DPP_ADD(ssq, 0x4E); ssq = DPP_ADD(ssq, 0x141); ssq = DPP_ADD(ssq, 0x140);
                { auto rr2 = __builtin_amdgcn_permlane16_swap(__float_as_uint(ssq), __float_as_uint(ssq), false, false); ssq = __uint_as_float(rr2[0]) + __uint_as_float(rr2[1]); }
                const float rstd = 1.0f / sqrtf(ssq * (1.f / DM) + NORM_EPS); x1 *= rstd; x2 *= rstd; }
              const bf16 o1 = (bf16)f2bf(x1 * c - x2 * s), o2 = (bf16)f2bf(x2 * c + x1 * s);
#pragma unroll
              for (int h = 0; h < 8; ++h) { ((GAS bf16*)KBp)[(size_t)tok * 1536 + h * 192 + 128 + r32] = o1; ((GAS bf16*)KBp)[(size_t)tok * 1536 + h * 192 + 160 + r32] = o2; } }
          __syncthreads(); } }
    { float* KTN = (float*)(a->ws + WS_KTN);
      for (int t = gw; t < BATCH * 8 * 64; t += NGW) { const int tile = t & 63, h = (t >> 6) & 7, b = t >> 9;
          const bf16* kp = Z + (size_t)(b * SEQ + tile * 64 + lane) * NZE + ZE_KB + h * 128; float s = 0.f;
#pragma unroll
          for (int c = 0; c < 16; ++c) { const v4u w = *(const GAS v4u*)(kp + c * 8);
              s += bf_lo(w.x) * bf_lo(w.x) + bf_hi(w.x) * bf_hi(w.x) + bf_lo(w.y) * bf_lo(w.y) + bf_hi(w.y) * bf_hi(w.y) + bf_lo(w.z) * bf_lo(w.z) + bf_hi(w.z) * bf_hi(w.z) + bf_lo(w.w) * bf_lo(w.w) + bf_hi(w.w) * bf_hi(w.w); }
          s = wave_max_v(s);
          if (lane == 0) KTN[(size_t)(b * 8 + h) * 64 + tile] = sqrtf(s) * 1.0001f; } }
    { LAS float* red = (LAS float*)(lds + RING_OFF);
      const int rr = lane >> 4, cc = lane & 15;
      for (int st = gw; st < BATCH * 16 * 8 * 4; st += NGW) { const int t = st >> 2, sub = st & 3, h = t & 7, n = (t >> 3) & 15, b = t >> 7;
          const bf16* kp = Z + (size_t)(b * SEQ + n * 256 + sub * 64 + rr) * NZE + ZE_KB + h * 128 + cc * 8; v4u w[16];
#pragma unroll
          for (int i = 0; i < 16; ++i) w[i] = *(const GAS v4u*)(kp + (size_t)(4 * i) * NZE);
          float s[8] = {0.f, 0.f, 0.f, 0.f, 0.f, 0.f, 0.f, 0.f};
#pragma unroll
          for (int i = 0; i < 16; ++i) { s[0] += bf_lo(w[i].x); s[1] += bf_hi(w[i].x); s[2] += bf_lo(w[i].y); s[3] += bf_hi(w[i].y); s[4] += bf_lo(w[i].z); s[5] += bf_hi(w[i].z); s[6] += bf_lo(w[i].w); s[7] += bf_hi(w[i].w); }
#pragma unroll
          for (int j = 0; j < 8; ++j) {
              { auto r = __builtin_amdgcn_permlane16_swap(__float_as_uint(s[j]), __float_as_uint(s[j]), false, false); s[j] = __uint_as_float(r[0]) + __uint_as_float(r[1]); }
              { auto r = __builtin_amdgcn_permlane32_swap(__float_as_uint(s[j]), __float_as_uint(s[j]), false, false); s[j] = __uint_as_float(r[0]) + __uint_as_float(r[1]); } }
          if (rr == 0) {
#pragma unroll
              for (int j = 0; j < 8; ++j) red[wave * 128 + cc * 8 + j] = s[j]; }
          __syncthreads();
          if (sub == 0) { const float m0 = (red[wave * 128 + lane * 2] + red[(wave + 1) * 128 + lane * 2]) + (red[(wave + 2) * 128 + lane * 2] + red[(wave + 3) * 128 + lane * 2]);
              const float m1 = (red[wave * 128 + lane * 2 + 1] + red[(wave + 1) * 128 + lane * 2 + 1]) + (red[(wave + 2) * 128 + lane * 2 + 1] + red[(wave + 3) * 128 + lane * 2 + 1]);
              *(GAS unsigned*)(KM + ((size_t)((b * 8 + h) * 16 + n)) * 128 + lane * 2) = pk2(m0 * (1.f / 256), m1 * (1.f / 256)); }
          __syncthreads(); } }
}
__device__ __forceinline__ void qrope_phase(KArgs a, int gw, int NGW, int lane) {
    GAS bf16* Q = (GAS bf16*)(a->ws + WS_QMLA); const GAS float* ct = (const GAS float*)(a->ws + WS_ROPE); const GAS float* st = ct + SEQ * 32;
    for (int m = gw; m < MTOK; m += NGW) { const int pos = m & (SEQ - 1);
#pragma unroll
        for (int e = 0; e < 4; ++e) { const int p = e * 64 + lane, h = p >> 5, i = p & 31; GAS bf16* qp = Q + (size_t)m * NQMLA + h * 192 + 128 + i;
            const float x1 = bf1(qp[0]), x2 = bf1(qp[32]), c = ct[pos * 32 + i], s = st[pos * 32 + i];
            qp[0] = (bf16)f2bf(x1 * c - x2 * s); qp[32] = (bf16)f2bf(x2 * c + x1 * s); } }
}

__device__ __forceinline__ float dot8(const LAS float* q, v4u w) {
    return q[0] * bf_lo(w.x) + q[1] * bf_hi(w.x) + q[2] * bf_lo(w.y) + q[3] * bf_hi(w.y) + q[4] * bf_lo(w.z) + q[5] * bf_hi(w.z) + q[6] * bf_lo(w.w) + q[7] * bf_hi(w.w);
}
__device__ __forceinline__ float dot_row(const LAS float* q, const bf16* k, int n) { float s = 0.f; for (int c = 0; c < n; c += 8) s += dot8(q + c, *(const GAS v4u*)(k + c)); return s; }
__device__ __forceinline__ void load_q(LAS float* qs, const bf16* q, int n, int lane) { for (int c = lane; c < n; c += 64) qs[c] = bf1(((const GAS bf16*)q)[c]); LDS_WAIT(); asm volatile("" ::: "memory"); }
__device__ __forceinline__ float softmax_lds(LAS float* sc, int n, int lane, bool has_sink, float sink, float& lse) {
    float mx = has_sink ? sink : -__builtin_inff();
    for (int j = lane; j < n; j += 64) mx = fmaxf(mx, sc[j]);
    mx = wave_max_l(mx, lane); float sum = 0.f;
    for (int j = lane; j < n; j += 64) { const float p = __expf(sc[j] - mx); sc[j] = p; sum += p; }
    sum = wave_sum_l(sum, lane); if (has_sink) sum += __expf(sink - mx);
    LDS_WAIT(); asm volatile("" ::: "memory");
    lse = mx + __logf(sum);
    return 1.0f / sum;
}
__device__ __forceinline__ void naive_even_attn(KArgs a, LAS unsigned char* lds, int gw, int NGW, int wave, int lane) {
    LAS float* sc = (LAS float*)(lds + RING_OFF + wave * 16384); LAS float* qs = (LAS float*)(lds + QBUF_OFF + wave * 1024);
    const bf16* Z = (const bf16*)(a->ws + WS_Z); const bf16* QM = (const bf16*)(a->ws + WS_QMLA); const bf16* KBp = (const bf16*)(a->ws + WS_KB); const bf16* VBp = (const bf16*)(a->ws + WS_VB); const bf16* KM = (const bf16*)(a->ws + WS_KM);
    bf16* CAT = (bf16*)(a->ws + WS_CAT);
    for (int task = gw; task < MTOK * 16; task += NGW) {
        const int hh = task & 15, row = task >> 4, b = row >> 12, t = row & (SEQ - 1); float lse;
        if (hh < 8) {
            const int h = hh; load_q(qs, QM + (size_t)row * NQMLA + h * 192, 192, lane);
            const float scale = 0.07216878364870322f;
            for (int j = lane; j <= t; j += 64) { const size_t kr = (size_t)(b * SEQ + j);
                sc[j] = dot_row(qs, KBp + kr * 1536 + h * 192, 192) * scale; }
            LDS_WAIT(); asm volatile("" ::: "memory");
            const float inv = softmax_lds(sc, t + 1, lane, false, 0.f, lse);
            float o0 = 0.f, o1 = 0.f; const bf16* vp = VBp + (size_t)(b * SEQ) * 1024 + h * 128 + lane * 2;
            for (int j = 0; j <= t; ++j) { const unsigned w = *(const GAS unsigned*)(vp + (size_t)j * 1024); const float p = sc[j]; o0 += p * bf_lo(w); o1 += p * bf_hi(w); }
            *(GAS unsigned*)(CAT + (size_t)row * NCAT_E + h * 128 + lane * 2) = pk2(o0 * inv, o1 * inv);
        } else {
            const int h = hh - 8, own = t >> 8; load_q(qs, Z + (size_t)row * NZE + ZE_QB + h * 128, 128, lane);
            float g = -__builtin_inff();
            if (lane < own) g = dot_row(qs, KM + ((size_t)((b * 8 + h) * 16 + lane)) * 128, 128);
            int sel[4]; int nsel = 0;
#pragma unroll
            for (int r = 0; r < 3; ++r) { const float mx = wave_max_l(g, lane); const unsigned long long bal = __ballot(g == mx && mx > -__builtin_inff());
                if (bal) { const int idx = __builtin_ctzll(bal); sel[r] = idx; if (lane == idx) g = -__builtin_inff(); nsel = r + 1; } else sel[r] = -1; }
            sel[3] = own;
            const float scale = 0.08838834764831845f, slope = exp2f(-(float)(h + 1));
#pragma unroll
            for (int r = 0; r < 4; ++r) { const int n = sel[r];
                for (int jj = lane; jj < 256; jj += 64) { float s = -__builtin_inff();
                    if (n >= 0) { const int kpos = n * 256 + jj; if (kpos <= t) s = dot_row(qs, Z + (size_t)(b * SEQ + kpos) * NZE + ZE_KB + h * 128, 128) * scale - slope * (float)(t - kpos); }
                    sc[r * 256 + jj] = s; } }
            LDS_WAIT(); asm volatile("" ::: "memory");
            const float inv = softmax_lds(sc, 1024, lane, false, 0.f, lse);
            float o0 = 0.f, o1 = 0.f;
#pragma unroll
            for (int r = 0; r < 4; ++r) { const int n = sel[r]; if (n < 0) continue;
                const bf16* vp = Z + (size_t)(b * SEQ + n * 256) * NZE + ZE_VB + h * 128 + lane * 2; const int lim = (n == own) ? (t - n * 256 + 1) : 256;
                for (int jj = 0; jj < lim; ++jj) { const unsigned w = *(const GAS unsigned*)(vp + (size_t)jj * NZE); const float p = sc[r * 256 + jj]; o0 += p * bf_lo(w); o1 += p * bf_hi(w); } }
            *(GAS unsigned*)(CAT + (size_t)row * NCAT_E + 1024 + h * 128 + lane * 2) = pk2(o0 * inv, o1 * inv);
            (void)nsel;
        }
    }
}
__device__ __forceinline__ void naive_odd_attn(KArgs a, int od, LAS unsigned char* lds, int gw, int NGW, int wave, int lane) {
    LAS float* sc = (LAS float*)(lds + RING_OFF + wave * 16384); LAS float* qs = (LAS float*)(lds + QBUF_OFF + wave * 1024);
    const bf16* Z = (const bf16*)(a->ws + WS_Z); bf16* CAT = (bf16*)(a->ws + WS_CAT); bf16* OD = (bf16*)(a->ws + WS_OD); float* LSE = (float*)(a->ws + WS_LSE);
    const float* sinks = a->in[I_OD_SINKS] + od * 16;
    for (int task = gw; task < MTOK * 28; task += NGW) {
        const int row = task / 28, hh = task - row * 28, b = row >> 12, t = row & (SEQ - 1); float lse;
        if (hh < 12) {
            const int g = hh >> 2, j4 = hh & 3, dil = (g == 0) ? 1 : (g == 1 ? 4 : 16);
            load_q(qs, Z + (size_t)row * NZO + ZO_QC + hh * 128, 128, lane);
            const float scale = 0.08838834764831845f, slope = exp2f(-8.0f * (float)(hh + 1) / 12.0f);
            for (int k = lane; k < 129; k += 64) { const int kpos = t - dil * k; float s = -__builtin_inff();
                if (kpos >= 0) s = dot_row(qs, Z + (size_t)(b * SEQ + kpos) * NZO + ZO_KC + hh * 128, 128) * scale - slope * (float)(dil * k);
                sc[k] = s; }
            LDS_WAIT(); asm volatile("" ::: "memory");
            const float inv = softmax_lds(sc, 129, lane, false, 0.f, lse);
            float o0 = 0.f, o1 = 0.f;
            for (int k = 0; k < 129; ++k) { const int kpos = t - dil * k; if (kpos < 0) break;
                const unsigned w = *(const GAS unsigned*)(Z + (size_t)(b * SEQ + kpos) * NZO + ZO_VC + hh * 128 + lane * 2); const float p = sc[k]; o0 += p * bf_lo(w); o1 += p * bf_hi(w); }
            *(GAS unsigned*)(OD + ((size_t)g * MTOK + row) * 512 + j4 * 128 + lane * 2) = pk2(o0 * inv, o1 * inv);
            if (lane == 0) LSE[((size_t)g * MTOK + row) * 4 + j4] = lse;
        } else {
            const int hq = hh - 12, kvh = hq >> 3; load_q(qs, Z + (size_t)row * NZO + ZO_QD + hq * 64, 64, lane);
            const float scale = 0.125f, slope = exp2f(-0.5f * (float)(hq + 1)), sink = sinks[hq];
            for (int k = lane; k < 128; k += 64) { const int kpos = t - k; float s = -__builtin_inff();
                if (kpos >= 0) s = dot_row(qs, Z + (size_t)(b * SEQ + kpos) * NZO + ZO_KD + kvh * 64, 64) * scale - slope * (float)k;
                sc[k] = s; }
            LDS_WAIT(); asm volatile("" ::: "memory");
            const float inv = softmax_lds(sc, 128, lane, true, sink, lse);
            float o0 = 0.f;
            for (int k = 0; k < 128; ++k) { const int kpos = t - k; if (kpos < 0) break;
                o0 += sc[k] * bf1(((const GAS bf16*)Z)[(size_t)(b * SEQ + kpos) * NZO + ZO_VD + kvh * 64 + lane]); }
            ((GAS bf16*)CAT)[(size_t)row * NCAT_O + 512 + hq * 64 + lane] = (bf16)f2bf(o0 * inv);
        }
    }
}
__device__ __forceinline__ void merge_quant_phase(KArgs a, int gw, int NGW, int lane) {
    const bf16* OD = (const bf16*)(a->ws + WS_OD); const float* LSE = (const float*)(a->ws + WS_LSE); const bf16* CAT = (const bf16*)(a->ws + WS_CAT);
    signed char* CQ = (signed char*)(a->ws + WS_CATQ); float* CS = (float*)(a->ws + WS_CATQS);
    const int j4 = lane >> 4;
    for (int rb = gw; rb < MTOK; rb += 4 * NGW) {
        float ls[4][3]; v4u av[4][3], sw[4][2];
#pragma unroll
        for (int k = 0; k < 4; ++k) { const int row = rb + k * NGW < MTOK ? rb + k * NGW : rb;
#pragma unroll
            for (int g = 0; g < 3; ++g) { ls[k][g] = ((const GAS float*)LSE)[((size_t)g * MTOK + row) * 4 + j4]; av[k][g] = *(const GAS v4u*)(OD + ((size_t)g * MTOK + row) * 512 + lane * 8); }
            sw[k][0] = *(const GAS v4u*)(CAT + (size_t)row * NCAT_O + 512 + lane * 8); sw[k][1] = *(const GAS v4u*)(CAT + (size_t)row * NCAT_O + 1024 + lane * 8); }
#pragma unroll
        for (int k = 0; k < 4; ++k) { const int row = rb + k * NGW; if (row >= MTOK) break;
            const float l0 = ls[k][0], l1 = ls[k][1], l2 = ls[k][2]; const v4u a0 = av[k][0], a1 = av[k][1], a2 = av[k][2];
            const float mxl = fmaxf(l0, fmaxf(l1, l2)); float w0 = __expf(l0 - mxl), w1 = __expf(l1 - mxl), w2 = __expf(l2 - mxl); const float invw = 1.0f / (w0 + w1 + w2); w0 *= invw; w1 *= invw; w2 *= invw;
            float x[24];
            x[0] = w0 * bf_lo(a0.x) + w1 * bf_lo(a1.x) + w2 * bf_lo(a2.x); x[1] = w0 * bf_hi(a0.x) + w1 * bf_hi(a1.x) + w2 * bf_hi(a2.x);
            x[2] = w0 * bf_lo(a0.y) + w1 * bf_lo(a1.y) + w2 * bf_lo(a2.y); x[3] = w0 * bf_hi(a0.y) + w1 * bf_hi(a1.y) + w2 * bf_hi(a2.y);
            x[4] = w0 * bf_lo(a0.z) + w1 * bf_lo(a1.z) + w2 * bf_lo(a2.z); x[5] = w0 * bf_hi(a0.z) + w1 * bf_hi(a1.z) + w2 * bf_hi(a2.z);
            x[6] = w0 * bf_lo(a0.w) + w1 * bf_lo(a1.w) + w2 * bf_lo(a2.w); x[7] = w0 * bf_hi(a0.w) + w1 * bf_hi(a1.w) + w2 * bf_hi(a2.w);
#pragma unroll
            for (int c = 0; c < 2; ++c) { const v4u s = sw[k][c]; x[8 + 8 * c + 0] = bf_lo(s.x); x[8 + 8 * c + 1] = bf_hi(s.x); x[8 + 8 * c + 2] = bf_lo(s.y); x[8 + 8 * c + 3] = bf_hi(s.y);
                x[8 + 8 * c + 4] = bf_lo(s.z); x[8 + 8 * c + 5] = bf_hi(s.z); x[8 + 8 * c + 6] = bf_lo(s.w); x[8 + 8 * c + 7] = bf_hi(s.w); }
            float mx = 0.f;
#pragma unroll
            for (int i = 0; i < 24; ++i) mx = fmaxf(mx, fabsf(x[i]));
            mx = wave_max_v(mx);
            const float inv = mx > 0.f ? 127.0f / mx : 0.f;
            GAS v2u* pd = (GAS v2u*)(CQ + (size_t)row * NCAT_O) + lane;
#pragma unroll
            for (int c = 0; c < 3; ++c) { v2u o; o.x = q4(x[8 * c] * inv, x[8 * c + 1] * inv, x[8 * c + 2] * inv, x[8 * c + 3] * inv); o.y = q4(x[8 * c + 4] * inv, x[8 * c + 5] * inv, x[8 * c + 6] * inv, x[8 * c + 7] * inv); pd[64 * c] = o; }
            if (lane == 0) ((GAS float*)CS)[row] = mx * (1.0f / 127.0f); } }
}

#ifndef PROBE_DUP_DN
#define PROBE_DUP_DN 0
#endif
#ifndef PROBE_DUP_UP
#define PROBE_DUP_UP 0
#endif
#ifndef PROBE_DUP_EVATT
#define PROBE_DUP_EVATT 0
#endif
#ifndef PROBE_DUP_PRO
#define PROBE_DUP_PRO 0
#endif
#ifndef FAST_EVEN
#define FAST_EVEN 1
#endif
#ifndef FAST_ODD
#define FAST_ODD 1
#endif


namespace fa {
typedef short bf16x8 __attribute__((ext_vector_type(8)));
typedef short s16x4 __attribute__((ext_vector_type(4)));
typedef float f32x16 __attribute__((ext_vector_type(16)));
typedef unsigned u32x4 __attribute__((ext_vector_type(4)));
enum { MODE_CAUSAL = 0, MODE_MOBA = 1, MODE_BAND_LSE = 2, MODE_BAND_SINK = 3 };
struct Desc {
    const bf16* q; long q_rs;
    const bf16* k; long k_rs;
    const bf16* v; long v_rs;
    bf16* o; long o_rs;
    float* lse; long lse_rs;
    const bf16* km;
    const float* rope;
    const float* ktn;
    int q0, t_lo, t_hi, W, own;
    float c2, slc, sink2;
};
typedef float f32x2_t __attribute__((ext_vector_type(2))); typedef __bf16 bf16x2_t __attribute__((ext_vector_type(2)));
__device__ __forceinline__ unsigned cvtpk(float lo, float hi) { const f32x2_t v = {lo, hi}; const bf16x2_t b = __builtin_convertvector(v, bf16x2_t); return __builtin_bit_cast(unsigned, b); }
__device__ __forceinline__ int v_rd_base(int lane) { return ((lane & 3) << 3) | (((lane >> 2) & 3) << 6) | (((lane >> 4) & 1) << 5) | (((lane >> 5) & 1) << 8); }
template <int NCG> __device__ __forceinline__ int v_st(int k, int c) { const int kk = (k & ~0xC) | ((k & 4) << 1) | ((k & 8) >> 1); return ((kk >> 3) * NCG + (c >> 5)) * 512 + ((kk & 7) * 32 + (c & 31)) * 2; }

template <int DQK, int DV, int MODE>
__device__ __forceinline__ void attn_unit(const Desc& D, LAS unsigned char* lds, int tid) {
    constexpr int KPITCH = DQK * 2, SHM_K = 64 * KPITCH, SHM_V = 64 * DV * 2, NCG = DV / 32, NKS = DQK / 16, ND0 = DV / 32;
    constexpr int KCH = DQK / 8, NKC = 64 * KCH / 512, VCH = DV / 8, NVC = 64 * VCH / 512;
    constexpr int NOPE = (DQK >= 128) ? 128 : 0, ROPE = DQK - NOPE, NOPE_SLOTS = 64 * (NOPE / 8), NOPE_BYTES = 64 * NOPE * 2, NKS_N = NOPE / 16;
    static_assert(ROPE == 0 || ROPE == 64, "K tile images");
    constexpr int OFF_V = 0, OFF_K = 2 * SHM_V, OFF_G = 2 * SHM_V + 2 * SHM_K;
    constexpr bool BIAS = (MODE != MODE_CAUSAL);
    constexpr float THR2 = 11.0f;
    const int wid = __builtin_amdgcn_readfirstlane(tid >> 6), lane = tid & 63, r32 = lane & 31, hi = lane >> 5;
    const int grp = wid >> 2;
    const float NEG = -__builtin_inff();
    unsigned kgo[NKC], vgo[NVC];
#pragma unroll
    for (int i = 0; i < NKC; ++i) { const int s = (i * 8 + wid) * 64 + lane; int row, ch;
        if (s < NOPE_SLOTS) { row = s >> 4; ch = (s & 15) ^ (row & 15); }
        else { const int s2 = s - NOPE_SLOTS; row = s2 >> 3; ch = NOPE / 8 + ((s2 & 7) ^ ((row >> 1) & 7)); }
        kgo[i] = (unsigned)(row * (int)D.k_rs + ch * 8) * 2u; }
#pragma unroll
    for (int i = 0; i < NVC; ++i) { const int s = (i * 8 + wid) * 64 + lane, sub = s >> 5, kk = (sub / NCG) * 8 + ((s & 31) >> 2), c = (sub % NCG) * 32 + (s & 3) * 8, k = (kk & ~0xC) | ((kk & 4) << 1) | ((kk & 8) >> 1);
        vgo[i] = (unsigned)(k * (int)D.v_rs + c) * 2u; }
#define FA_TI(s) ((MODE == MODE_MOBA) ? (D.t_hi - 1 - (s)) : (D.t_lo + (s)))
#define FA_LOADK(s) do { const char* kt_ = (const char*)D.k + (size_t)FA_TI(s) * 64 * D.k_rs * 2; \
        _Pragma("unroll") for (int i = 0; i < NKC; ++i) __builtin_amdgcn_global_load_lds((const unsigned*)(kt_ + kgo[i]), (LAS unsigned*)(lds + OFF_K + ((s) & 1) * SHM_K + (i * 8 + wid) * 1024), 16, 0, 0); } while (0)
#define FA_LOADV(s) do { const char* vt_ = (const char*)D.v + (size_t)FA_TI(s) * 64 * D.v_rs * 2; \
        _Pragma("unroll") for (int i = 0; i < NVC; ++i) __builtin_amdgcn_global_load_lds((const unsigned*)(vt_ + vgo[i]), (LAS unsigned*)(lds + OFF_V + ((s) & 1) * SHM_V + (i * 8 + wid) * 1024), 16, 0, 0); } while (0)
    FA_LOADK(0); FA_LOADV(0);
    const int qi = D.q0 + wid * 32 + r32;
    bf16x8 qr[NKS];
    { const bf16* qp = D.q + (long)qi * D.q_rs + hi * 8;
#pragma unroll
      for (int d0 = 0; d0 < NKS; ++d0) qr[d0] = *(const GAS bf16x8*)(qp + d0 * 16); }
    if constexpr (MODE == MODE_CAUSAL && DQK == 192) {
#pragma unroll
        for (int dd = 0; dd < 2; ++dd) { const float* cp = D.rope + (size_t)qi * 32 + dd * 16 + hi * 8; const float* sp = cp + SEQ * 32;
            const f32x4 c0 = *(const GAS f32x4*)cp, c1 = *(const GAS f32x4*)(cp + 4), s0 = *(const GAS f32x4*)sp, s1 = *(const GAS f32x4*)(sp + 4);
            const float cc[8] = {c0[0], c0[1], c0[2], c0[3], c1[0], c1[1], c1[2], c1[3]}, ss[8] = {s0[0], s0[1], s0[2], s0[3], s1[0], s1[1], s1[2], s1[3]};
            const u32x4 a = __builtin_bit_cast(u32x4, qr[8 + dd]), b = __builtin_bit_cast(u32x4, qr[10 + dd]); u32x4 oa, ob;
#pragma unroll
            for (int w = 0; w < 4; ++w) { const float x1l = bf_lo(a[w]), x1h = bf_hi(a[w]), x2l = bf_lo(b[w]), x2h = bf_hi(b[w]);
                oa[w] = pk2(x1l * cc[2 * w] - x2l * ss[2 * w], x1h * cc[2 * w + 1] - x2h * ss[2 * w + 1]);
                ob[w] = pk2(x2l * cc[2 * w] + x1l * ss[2 * w], x2h * cc[2 * w + 1] + x1h * ss[2 * w + 1]); }
            qr[8 + dd] = __builtin_bit_cast(bf16x8, oa); qr[10 + dd] = __builtin_bit_cast(bf16x8, ob); }
    }
    const int qlo = D.q0 + wid * 32;
    float qn = 0.f;
    if constexpr (MODE == MODE_MOBA) {
#pragma unroll
        for (int d0 = 0; d0 < NKS; ++d0) { const u32x4 w = __builtin_bit_cast(u32x4, qr[d0]);
#pragma unroll
            for (int e = 0; e < 4; ++e) { const float lo = bf_lo(w[e]), hh = bf_hi(w[e]); qn = fmaf(lo, lo, fmaf(hh, hh, qn)); } }
        { auto rr = __builtin_amdgcn_permlane32_swap(__float_as_uint(qn), __float_as_uint(qn), false, false); qn = __uint_as_float(rr[0]) + __uint_as_float(rr[1]); }
        qn = sqrtf(qn) * 1.0001f;
    }
    const int kbN = r32 * 256, mmN = hi ^ (r32 & 15), kbR = NOPE_BYTES + r32 * 128, mmR = hi ^ ((r32 >> 1) & 7);
#define FA_KADDR(d0) (((d0) < NKS_N) ? (kbN + (((2 * (d0)) ^ mmN) << 4)) : (kbR + (((2 * ((d0) - NKS_N)) ^ mmR) << 4)))
#define FA_KHALF(d0) (((d0) < NKS_N) ? 32 * 256 : 32 * 128)
    constexpr int KPF = 3;
    const unsigned kb_lds = (unsigned)(uintptr_t)(lds + OFF_K);
#define FA_KRD2(R, base, d) do { const unsigned a_ = (base) + (unsigned)FA_KADDR(d); asm volatile("ds_read_b128 %0, %1" : "=v"(R[0]) : "v"(a_) : "memory"); \
        if ((d) < NKS_N) asm volatile("ds_read_b128 %0, %1 offset:8192" : "=v"(R[1]) : "v"(a_) : "memory"); else asm volatile("ds_read_b128 %0, %1 offset:4096" : "=v"(R[1]) : "v"(a_) : "memory"); } while (0)
    const int vb0 = (int)(unsigned)(uintptr_t)(lds + OFF_V) + v_rd_base(lane);

    unsigned selmask = 0u;
    if constexpr (MODE == MODE_MOBA) {
        if (D.own > 0) {
            if (tid < 256) { const int row = tid >> 4, ch = tid & 15; *(LAS bf16x8*)(lds + OFF_G + row * 256 + ((ch ^ (row & 15)) << 4)) = *(const GAS bf16x8*)(D.km + row * 128 + ch * 8); }
            __syncthreads();
            f32x16 gp = {};
#pragma unroll
            for (int d0 = 0; d0 < 8; ++d0) { const bf16x8 kf = *(const LAS bf16x8*)(lds + OFF_G + r32 * 256 + (((2 * d0) ^ hi ^ (r32 & 15)) << 4)); gp = __builtin_amdgcn_mfma_f32_32x32x16_bf16(kf, qr[d0], gp, 0, 0, 0); }
            float g[16];
#pragma unroll
            for (int r = 0; r < 8; ++r) { const unsigned x = __float_as_uint(gp[r]); auto sw = __builtin_amdgcn_permlane32_swap(x, x, false, false);
                g[(r & 3) + 8 * (r >> 2)] = __uint_as_float(sw[0]); g[(r & 3) + 8 * (r >> 2) + 4] = __uint_as_float(sw[1]); }
#pragma unroll
            for (int n = 0; n < 16; ++n) if (n >= D.own) g[n] = NEG;
#pragma unroll
            for (int pass = 0; pass < 3; ++pass) { float best = NEG; int bi = -1;
#pragma unroll
                for (int n = 0; n < 16; ++n) if (g[n] > best) { best = g[n]; bi = n; }
                if (bi >= 0) selmask |= 1u << bi;
#pragma unroll
                for (int n = 0; n < 16; ++n) if (n == bi) g[n] = NEG; }
        }
    }

    float m_reg = -1e30f, l_reg = 0.f; f32x16 o[ND0];
#pragma unroll
    for (int d0 = 0; d0 < ND0; ++d0) o[d0] = f32x16{};
    const int NT = D.t_hi - D.t_lo;
#define FA_TILE_FLAGS(t) const int buf = (t) & 1, kbase = FA_TI(t) * 64; bool act, need_mask; bool lane_sel = true; \
        if constexpr (MODE == MODE_MOBA) { const int n_ = kbase >> 8; \
            if (n_ < D.own) { const float ktm_ = D.ktn[kbase >> 6]; const float bnd_ = fmaf(qn * D.c2, ktm_, -D.slc * (float)(qi - kbase - 63)) + 1.0f; \
                lane_sel = ((selmask >> n_) & 1u) && (bnd_ - m_reg >= -151.0f); act = __any(lane_sel); need_mask = false; } \
            else { act = kbase <= qlo + 31; need_mask = kbase + 63 > qlo; } } \
        else { act = (kbase <= qlo + 31) && (kbase + 63 >= qlo - D.W + 1); need_mask = (kbase + 63 > qlo) || (kbase < qlo + 31 - D.W + 1); } \
        (void)buf; (void)need_mask; (void)lane_sel
#define FA_H1(t) do { FA_TILE_FLAGS(t); tact = act; if (act) { \
        p0 = f32x16{}; p1 = f32x16{}; \
        { const unsigned kbuf_ = kb_lds + (unsigned)(buf * SHM_K); bf16x8 kf[KPF][2];     \
          _Pragma("unroll") for (int j = 0; j < KPF; ++j) if (j < NKS) FA_KRD2(kf[j], kbuf_, j); \
          _Pragma("unroll") for (int d0 = 0; d0 < NKS; ++d0) { \
              const int rem_ = (NKS - 1 - d0) < (KPF - 1) ? (NKS - 1 - d0) : (KPF - 1); \
              if (rem_ >= 2) FA_LW(4); else if (rem_ == 1) FA_LW(2); else FA_LW(0); \
              p0 = __builtin_amdgcn_mfma_f32_32x32x16_bf16(kf[d0 % KPF][0], qr[d0], p0, 0, 0, 0); \
              p1 = __builtin_amdgcn_mfma_f32_32x32x16_bf16(kf[d0 % KPF][1], qr[d0], p1, 0, 0, 0); \
              if (d0 + KPF < NKS) FA_KRD2(kf[d0 % KPF], kbuf_, d0 + KPF); } } \
        const int dq = qi - kbase - 4 * hi;     \
        if constexpr (BIAS) { const float b0_ = -(float)dq * D.slc; \
            _Pragma("unroll") for (int r = 0; r < 16; ++r) { const float c = (float)((r & 3) + 8 * (r >> 2)); p0[r] = fmaf(p0[r], D.c2, fmaf(c, D.slc, b0_)); p1[r] = fmaf(p1[r], D.c2, fmaf(c + 32.f, D.slc, b0_)); } } \
          \
        if (need_mask) { _Pragma("unroll") for (int r = 0; r < 16; ++r) { const int c = (r & 3) + 8 * (r >> 2); \
            if ((unsigned)(dq - c) >= (unsigned)D.W) p0[r] = NEG; if ((unsigned)(dq - c - 32) >= (unsigned)D.W) p1[r] = NEG; } } \
        if constexpr (MODE == MODE_MOBA) { if (!lane_sel) { _Pragma("unroll") for (int r = 0; r < 16; ++r) { p0[r] = NEG; p1[r] = NEG; } } } \
        float pmax = p0[0]; \
        _Pragma("unroll") for (int r = 1; r < 16; ++r) pmax = fmaxf(pmax, p0[r]); \
        _Pragma("unroll") for (int r = 0; r < 16; ++r) pmax = fmaxf(pmax, p1[r]); \
        { auto rr = __builtin_amdgcn_permlane32_swap(__float_as_uint(pmax), __float_as_uint(pmax), false, false); pmax = fmaxf(__uint_as_float(rr[0]), __uint_as_float(rr[1])); } \
        if constexpr (!BIAS) pmax *= D.c2; \
        if (!__all(pmax - m_reg <= THR2)) {     \
            const float mn = fmaxf(m_reg, pmax), alpha = __builtin_amdgcn_exp2f(m_reg - mn); m_reg = mn; l_reg *= alpha; \
            _Pragma("unroll") for (int d0 = 0; d0 < ND0; ++d0) _Pragma("unroll") for (int r = 0; r < 16; ++r) o[d0][r] *= alpha; } \
          \
        _Pragma("unroll") for (int r = 0; r < 16; ++r) p0[r] = BIAS ? __builtin_amdgcn_exp2f(p0[r] - m_reg) : __builtin_amdgcn_exp2f(fmaf(p0[r], D.c2, -m_reg)); } } while (0)
#define FA_PK4(P, B_, OUT) do { const unsigned a0 = cvtpk(P[B_ + 0], P[B_ + 1]), a1 = cvtpk(P[B_ + 2], P[B_ + 3]), b0 = cvtpk(P[B_ + 4], P[B_ + 5]), b1 = cvtpk(P[B_ + 6], P[B_ + 7]); \
        auto r0 = __builtin_amdgcn_permlane32_swap(a0, b0, false, false); auto r1 = __builtin_amdgcn_permlane32_swap(a1, b1, false, false); \
        u32x4 w = {r0[0], r1[0], r0[1], r1[1]}; OUT = __builtin_bit_cast(bf16x8, w); } while (0)
#define FA_TR(dst, off) asm volatile("ds_read_b64_tr_b16 %0, %1 offset:%2" : "=&v"(dst) : "v"(vb), "i"(off) : "memory")
#define FA_TR8(S, d0) do { constexpr int b_ = (d0) * 512; FA_TR(S##l0, b_); FA_TR(S##h0, b_ + NCG * 512); FA_TR(S##l1, b_ + NCG * 1024); FA_TR(S##h1, b_ + NCG * 1536); \
        FA_TR(S##l2, b_ + NCG * 2048); FA_TR(S##h2, b_ + NCG * 2560); FA_TR(S##l3, b_ + NCG * 3072); FA_TR(S##h3, b_ + NCG * 3584); } while (0)
#define FA_MM4(S, d0) do { \
        o[d0] = __builtin_amdgcn_mfma_f32_32x32x16_bf16((bf16x8){S##l0[0], S##l0[1], S##l0[2], S##l0[3], S##h0[0], S##h0[1], S##h0[2], S##h0[3]}, pa0, o[d0], 0, 0, 0); \
        o[d0] = __builtin_amdgcn_mfma_f32_32x32x16_bf16((bf16x8){S##l1[0], S##l1[1], S##l1[2], S##l1[3], S##h1[0], S##h1[1], S##h1[2], S##h1[3]}, pa1, o[d0], 0, 0, 0); \
        o[d0] = __builtin_amdgcn_mfma_f32_32x32x16_bf16((bf16x8){S##l2[0], S##l2[1], S##l2[2], S##l2[3], S##h2[0], S##h2[1], S##h2[2], S##h2[3]}, pa2, o[d0], 0, 0, 0); \
        o[d0] = __builtin_amdgcn_mfma_f32_32x32x16_bf16((bf16x8){S##l3[0], S##l3[1], S##l3[2], S##l3[3], S##h3[0], S##h3[1], S##h3[2], S##h3[3]}, pa3, o[d0], 0, 0, 0); } while (0)
#define FA_LW(n) do { asm volatile("s_waitcnt lgkmcnt(%0)" :: "i"(n) : "memory"); __builtin_amdgcn_sched_barrier(0); } while (0)
#define FA_TRP(L0, H0, L1, H1, d0, j0) do { constexpr int b_ = (d0) * 512 + NCG * 512 * (2 * (j0)); FA_TR(L0, b_); FA_TR(H0, b_ + NCG * 512); FA_TR(L1, b_ + NCG * 1024); FA_TR(H1, b_ + NCG * 1536); } while (0)
#define FA_MM2(L0, H0, L1, H1, d0, PA, PB) do { \
        o[d0] = __builtin_amdgcn_mfma_f32_32x32x16_bf16((bf16x8){L0[0], L0[1], L0[2], L0[3], H0[0], H0[1], H0[2], H0[3]}, PA, o[d0], 0, 0, 0); \
        o[d0] = __builtin_amdgcn_mfma_f32_32x32x16_bf16((bf16x8){L1[0], L1[1], L1[2], L1[3], H1[0], H1[1], H1[2], H1[3]}, PB, o[d0], 0, 0, 0); } while (0)
#define FA_E4(B_) do { _Pragma("unroll") for (int r = (B_); r < (B_) + 4; ++r) { p1[r] = BIAS ? __builtin_amdgcn_exp2f(p1[r] - m_reg) : __builtin_amdgcn_exp2f(fmaf(p1[r], D.c2, -m_reg)); ps += p0[r] + p1[r]; } } while (0)
#define FA_H2(t) do { const int buf = (t) & 1; if (tact) { \
        const int vb = vb0 + buf * SHM_V; constexpr int W_ = ND0 > 2 ? 12 : 4; \
        s16x4 Al0, Al1, Al2, Al3, Ah0, Ah1, Ah2, Ah3, Bl0, Bl1, Bl2, Bl3, Bh0, Bh1, Bh2, Bh3; \
        FA_TRP(Al0, Ah0, Al1, Ah1, 0, 0); FA_TRP(Al2, Ah2, Al3, Ah3, 1, 0); \
        if constexpr (ND0 > 2) { FA_TRP(Bl0, Bh0, Bl1, Bh1, 2, 0); FA_TRP(Bl2, Bh2, Bl3, Bh3, 3, 0); } \
        float ps = 0.f; bf16x8 pa0, pa1, pa2, pa3; FA_PK4(p0, 0, pa0); FA_PK4(p0, 8, pa1); \
        FA_LW(W_); FA_MM2(Al0, Ah0, Al1, Ah1, 0, pa0, pa1); FA_TRP(Al0, Ah0, Al1, Ah1, 0, 2); FA_E4(0); \
        FA_LW(W_); FA_MM2(Al2, Ah2, Al3, Ah3, 1, pa0, pa1); FA_TRP(Al2, Ah2, Al3, Ah3, 1, 2); FA_E4(4); \
        if constexpr (ND0 > 2) { FA_LW(12); FA_MM2(Bl0, Bh0, Bl1, Bh1, 2, pa0, pa1); FA_TRP(Bl0, Bh0, Bl1, Bh1, 2, 2); FA_E4(8); \
                                 FA_LW(12); FA_MM2(Bl2, Bh2, Bl3, Bh3, 3, pa0, pa1); FA_TRP(Bl2, Bh2, Bl3, Bh3, 3, 2); FA_E4(12); } \
        else { FA_E4(8); FA_E4(12); } \
        l_reg += ps;     \
        FA_PK4(p1, 0, pa2); FA_PK4(p1, 8, pa3); \
        FA_LW(W_); FA_MM2(Al0, Ah0, Al1, Ah1, 0, pa2, pa3); \
        if constexpr (ND0 > 2) { FA_LW(8); FA_MM2(Al2, Ah2, Al3, Ah3, 1, pa2, pa3); FA_LW(4); FA_MM2(Bl0, Bh0, Bl1, Bh1, 2, pa2, pa3); FA_LW(0); FA_MM2(Bl2, Bh2, Bl3, Bh3, 3, pa2, pa3); } \
        else { FA_LW(0); FA_MM2(Al2, Ah2, Al3, Ah3, 1, pa2, pa3); } } } while (0)
#define FA_ENDK(issued) do { if (issued) asm volatile("s_waitcnt vmcnt(%0)" :: "i"(NKC) : "memory"); else asm volatile("s_waitcnt vmcnt(0)" ::: "memory"); __builtin_amdgcn_s_barrier(); asm volatile("" ::: "memory"); } while (0)
#define FA_ENDV(issued) do { if (issued) asm volatile("s_waitcnt vmcnt(%0)" :: "i"(NVC) : "memory"); else asm volatile("s_waitcnt vmcnt(0)" ::: "memory"); __builtin_amdgcn_s_barrier(); asm volatile("" ::: "memory"); } while (0)
    VM_WAIT();
    __syncthreads();
    if (grp == 0) {
        for (int t = 0; t < NT; ++t) { f32x16 p0, p1; bool tact;
            { const bool is_ = t + 1 < NT; if (is_) FA_LOADK(t + 1); FA_H1(t); FA_ENDK(is_); }
            { const bool is_ = t + 1 < NT; if (is_) FA_LOADV(t + 1); FA_H2(t); FA_ENDV(is_); } }
        FA_ENDK(false);
    } else {
        { const bool is_ = 1 < NT; if (is_) FA_LOADK(1); FA_ENDK(is_); }
        for (int t = 0; t < NT; ++t) { f32x16 p0, p1; bool tact;
            { const bool is_ = t + 1 < NT; if (is_) FA_LOADV(t + 1); FA_H1(t); FA_ENDV(is_); }
            { const bool is_ = t + 2 < NT; if (is_) FA_LOADK(t + 2); FA_H2(t); FA_ENDK(is_); } }
    }
#undef FA_TILE_FLAGS
#undef FA_TI
#undef FA_KADDR
#undef FA_KHALF
#undef FA_KRD2
#undef FA_H1
#undef FA_H2
#undef FA_PK4
#undef FA_TR
#undef FA_TR8
#undef FA_MM4
#undef FA_TRP
#undef FA_MM2
#undef FA_E4
#undef FA_LW
#undef FA_ENDK
#undef FA_ENDV
#undef FA_LOADK
#undef FA_LOADV
    { auto rr = __builtin_amdgcn_permlane32_swap(__float_as_uint(l_reg), __float_as_uint(l_reg), false, false); l_reg = __uint_as_float(rr[0]) + __uint_as_float(rr[1]); }
    if constexpr (MODE == MODE_BAND_SINK) l_reg += __builtin_amdgcn_exp2f(D.sink2 - m_reg);
    const float inv = 1.0f / l_reg;
    int qi_e = qi; asm volatile("" : "+v"(qi_e));
    bf16* op = D.o + (long)qi_e * D.o_rs + 4 * hi;
#pragma unroll
    for (int d0 = 0; d0 < ND0; ++d0)
#pragma unroll
        for (int g4 = 0; g4 < 4; ++g4) { v2u w; w.x = cvtpk(o[d0][4 * g4 + 0] * inv, o[d0][4 * g4 + 1] * inv); w.y = cvtpk(o[d0][4 * g4 + 2] * inv, o[d0][4 * g4 + 3] * inv);
            *(GAS v2u*)(op + d0 * 32 + 8 * g4) = w; }
    if constexpr (MODE == MODE_BAND_LSE) { if (hi == 0) D.lse[(long)qi_e * D.lse_rs] = (m_reg + __builtin_amdgcn_logf(l_reg)) * 0.6931471805599453f; }
}
}

constexpr float LOG2E = 1.4426950408889634f;
__device__ __forceinline__ void fast_mla_attn(KArgs a, LAS unsigned char* lds, int tid, int vcu) {
    unsigned char* ws = a->ws;
    const bf16* QM = (const bf16*)(ws + WS_QMLA); const bf16* KB = (const bf16*)(ws + WS_KB); const bf16* VB = (const bf16*)(ws + WS_VB); bf16* CAT = (bf16*)(ws + WS_CAT);
    for (int it = vcu; it < 256; it += gridDim.x) {
        const int xq = it & 7, rq = it >> 3, bh = xq * 4 + (rq >> 3), p = rq & 7, b = bh >> 3, h = bh & 7; const long r0 = (long)b * SEQ;
#pragma unroll 1
        for (int half = 0; half < 2; ++half) { const int x = half == 0 ? 15 - p : p;
            fa::Desc D{};
            D.q0 = 256 * x; D.t_lo = 0; D.t_hi = 4 * x + 4; D.W = 1 << 30; D.own = x; D.sink2 = 0.f;
            D.q = QM + r0 * NQMLA + h * 192; D.q_rs = NQMLA; D.k = KB + r0 * NQMLA + h * 192; D.k_rs = NQMLA; D.v = VB + r0 * 1024 + h * 128; D.v_rs = 1024;
            D.o = CAT + r0 * NCAT_E + h * 128; D.o_rs = NCAT_E; D.c2 = 0.07216878364870322f * LOG2E; D.slc = 0.f; D.rope = (const float*)(ws + WS_ROPE);
            fa::attn_unit<192, 128, fa::MODE_CAUSAL>(D, lds, tid);
        }
    }
}
__device__ __forceinline__ void fast_moba_attn(KArgs a, int ev, LAS unsigned char* lds, int tid, int vcu) {
    unsigned char* ws = a->ws; (void)vcu;
    const bf16* Z = (const bf16*)(ws + WS_Z); const bf16* KM = (const bf16*)(ws + WS_KM); bf16* CAT = (bf16*)(ws + WS_CAT);
    unsigned* ctr = (unsigned*)(ws + WS_CTL) + CW_QUEUE + 64 * ev;
    volatile LAS unsigned* slot = (volatile LAS unsigned*)(lds + LDSCTL_OFF + 128);
    for (;;) {
        if (tid == 0) slot[0] = __hip_atomic_fetch_add(ctr, 1u, __ATOMIC_RELAXED, __HIP_MEMORY_SCOPE_AGENT);
        __syncthreads();
        const int idx = __builtin_amdgcn_readfirstlane((int)slot[0]);
        __syncthreads();
        if (idx >= 512) break;
        const int x = 15 - (idx >> 5), rem = idx & 31, h = 7 - (rem >> 2), b = rem & 3; const long r0 = (long)b * SEQ;
        fa::Desc D{};
        D.q0 = 256 * x; D.t_lo = 0; D.t_hi = 4 * x + 4; D.W = 1 << 30; D.own = x; D.sink2 = 0.f;
        D.q = Z + r0 * NZE + ZE_QB + h * 128; D.q_rs = NZE; D.k = Z + r0 * NZE + ZE_KB + h * 128; D.k_rs = NZE; D.v = Z + r0 * NZE + ZE_VB + h * 128; D.v_rs = NZE;
        D.o = CAT + r0 * NCAT_E + 1024 + h * 128; D.o_rs = NCAT_E; D.km = KM + (size_t)((b * 8 + h) * 16) * 128; D.ktn = (const float*)(ws + WS_KTN) + (size_t)(b * 8 + h) * 64;
        D.c2 = 0.08838834764831845f * LOG2E; D.slc = exp2f(-(float)(h + 1)) * LOG2E;
        fa::attn_unit<128, 128, fa::MODE_MOBA>(D, lds, tid);
    }
}
__device__ __forceinline__ void fast_dil_attn(KArgs a, LAS unsigned char* lds, int tid, int vcu) {
    unsigned char* ws = a->ws;
    const bf16* Z = (const bf16*)(ws + WS_Z); bf16* OD = (bf16*)(ws + WS_OD); float* LSE = (float*)(ws + WS_LSE);
    for (int u = vcu; u < 768; u += gridDim.x) {
        fa::Desc D{};
        const int b = u / 192, rem = u - b * 192, head = rem >> 4, sub = rem & 15, g = head >> 2, hh = head & 3, dil = (g == 0) ? 1 : (g == 1 ? 4 : 16), nb = 16 / dil, r = sub / nb, blk = sub - r * nb, i0 = 256 * blk;
        const long row0 = (long)b * SEQ + r;
        D.q = Z + row0 * NZO + ZO_QC + head * 128; D.q_rs = (long)dil * NZO; D.k = Z + row0 * NZO + ZO_KC + head * 128; D.k_rs = (long)dil * NZO; D.v = Z + row0 * NZO + ZO_VC + head * 128; D.v_rs = (long)dil * NZO;
        D.o = OD + ((size_t)g * MTOK + row0) * 512 + hh * 128; D.o_rs = (long)dil * 512; D.lse = LSE + ((size_t)g * MTOK + row0) * 4 + hh; D.lse_rs = (long)dil * 4;
        D.q0 = i0; D.t_lo = (i0 >= 128) ? (i0 / 64 - 2) : 0; D.t_hi = i0 / 64 + 4; D.W = 129; D.c2 = 0.08838834764831845f * LOG2E; D.slc = exp2f(-8.0f * (float)(head + 1) / 12.0f) * (float)dil * LOG2E;
        fa::attn_unit<128, 128, fa::MODE_BAND_LSE>(D, lds, tid);
    }
}
__device__ __forceinline__ void fast_swa_attn(KArgs a, int od, LAS unsigned char* lds, int tid, int vcu) {
    unsigned char* ws = a->ws;
    const bf16* Z = (const bf16*)(ws + WS_Z); bf16* CAT = (bf16*)(ws + WS_CAT);
    const float* sinks = a->in[I_OD_SINKS] + od * 16;
    for (int v = vcu; v < 1024; v += gridDim.x) {
        fa::Desc D{};
        const int b = v >> 8, rem = v & 255, hq = rem >> 4, blk = rem & 15, kvh = hq >> 3, i0 = 256 * blk; const long row0 = (long)b * SEQ;
        D.q = Z + row0 * NZO + ZO_QD + hq * 64; D.q_rs = NZO; D.k = Z + row0 * NZO + ZO_KD + kvh * 64; D.k_rs = NZO; D.v = Z + row0 * NZO + ZO_VD + kvh * 64; D.v_rs = NZO;
        D.o = CAT + row0 * NCAT_O + 512 + hq * 64; D.o_rs = NCAT_O;
        D.q0 = i0; D.t_lo = (i0 >= 128) ? (i0 / 64 - 2) : 0; D.t_hi = i0 / 64 + 4; D.W = 128; D.c2 = 0.125f * LOG2E; D.slc = exp2f(-0.5f * (float)(hq + 1)) * LOG2E; D.sink2 = sinks[hq] * LOG2E;
        fa::attn_unit<64, 64, fa::MODE_BAND_SINK>(D, lds, tid);
    }
}

#define XLPTR ((bf16*)nullptr)
#define RSTAB ((LAS float*)(lds + QBUF_OFF))
#define GEMM_CONS(ACT_, PART_, Bptr, O_, ldc_, N_) do { pg8::StaticOrder S0_; S0_.init(MTOK, (N_), (int)gridDim.x, VCU()); pg8::Unit u0_; u0_.pm = 0; u0_.pn = 0; (void)S0_.next(0, u0_); \
        prep_rstab((PART_), u0_.pm, RSTAB, tid_now_()); pg8::EpiBf16<ACT_> E_{(O_), (ldc_), (const LAS float*)RSTAB, u0_.pm, (PART_), nullptr, 0, nullptr, nullptr}; \
        GEMM_CALL(pg8::EpiBf16<ACT_>, (bf16*)(ws + WS_H), DM, (Bptr), DM, (N_), DM, E_); } while (0)
#define GEMM_CONS_I8(ACT_, PART_, Bptr, CSP_, O_, ldc_, N_) do { pg8::StaticOrder S0_; S0_.init(MTOK, (N_), (int)gridDim.x, VCU()); pg8::Unit u0_; u0_.pm = 0; u0_.pn = 0; (void)S0_.next(0, u0_); \
        const float* qrow_ = (const float*)(ws + WS_XQS); \
        prep_rstab_q((PART_), qrow_, u0_.pm, RSTAB, tid_now_()); pg8::EpiBf16<ACT_, true> E_{(O_), (ldc_), (const LAS float*)RSTAB, u0_.pm, (PART_), nullptr, 0, qrow_, (CSP_)}; \
        typedef pg8::EpiBf16<ACT_, true> EpiQ_; GEMM_CALL(EpiQ_, (ws + WS_XQ), DM, (Bptr), DM, (N_), DM, E_); } while (0)
#define GEMM_CONS_U8(PART_, Bptr, CSP_, O8_, BS_, N_) do { pg8::StaticOrder S0_; S0_.init(MTOK, (N_), (int)gridDim.x, VCU()); pg8::Unit u0_; u0_.pm = 0; u0_.pn = 0; (void)S0_.next(0, u0_); \
        const float* qrow_ = (const float*)(ws + WS_XQS); \
        prep_rstab_q((PART_), qrow_, u0_.pm, RSTAB, tid_now_()); pg8::EpiU8 E_{(O8_), (BS_), (const LAS float*)RSTAB, u0_.pm, (PART_), qrow_, (CSP_)}; \
        GEMM_CALL(pg8::EpiU8, (ws + WS_XQ), DM, (Bptr), DM, (N_), DM, E_); } while (0)
#define GEMM_CALL(EPI, Aptr, lda_, Bptr, ldb_, N_, K_, E_) GEMM_CALLW(EPI, Aptr, lda_, Bptr, ldb_, N_, K_, E_, 8)
#define GEMM_CALLW(EPI, Aptr, lda_, Bptr, ldb_, N_, K_, E_, WGM_) do { pg8::Gemm g_{(const pg8::bf16_t*)(Aptr), (const pg8::bf16_t*)(Bptr), MTOK, (N_), (K_), (lda_), (ldb_)}; \
        pg8::StaticOrder S_; S_.init(MTOK, (N_), (int)gridDim.x, VCU()); S_.wgm = (WGM_); pg8::gemm_phase<EPI, pg8::StaticOrder, true, true>(lds + RING_OFF, g_, S_, E_); } while (0)
#define PH_ENV() KArgs kp = kargs(); unsigned char* ws = kp->ws; const Env e = make_env(); (void)ws; (void)e
#define VCU() ((int)__builtin_amdgcn_readfirstlane((int)((volatile LAS unsigned*)(lds + LDSCTL_OFF + 64))[3]))

__global__ void __launch_bounds__(NTHR, 2) mega_fwd(Args args_unused) {
    extern __shared__ __attribute__((aligned(16))) unsigned char lds_raw[];
    LAS unsigned char* lds = (LAS unsigned char*)lds_raw;
    (void)args_unused;
    for (int u = threadIdx.x; u < (LDS_BYTES - LDSCTL_OFF) / 4; u += NTHR) ((LAS unsigned*)(lds + LDSCTL_OFF))[u] = 0u;
    __syncthreads();
    { KArgs kp = kargs(); (void)xcd_barrier_post((unsigned*)(kp->ws + WS_CTL) + CW_BAR, (volatile LAS unsigned*)(lds + LDSCTL_OFF + 64)); }
#define SEAM() do { KArgs kb_ = kargs(); XcdBarrier bar_; bar_.bar = (unsigned*)(kb_->ws + WS_CTL) + CW_BAR; bar_.x = xb_xcc_id(); bar_.st = (volatile LAS unsigned*)(lds + LDSCTL_OFF + 64); xcd_barrier(bar_); } while (0)

    { KArgs kp = kargs(); slabdn_phase(kp, lds, tid_now_()); }
    { KArgs kp = kargs(); slab_phase(kp, lds, tid_now_()); }
    { PH_ENV(); prologue_phase(kp, lds, e.gw, e.NGW, e.wave, e.lane); }
    { PH_ENV(); init_phase(kp->in[I_X], (bf16*)(ws + WS_H), XLPTR, (float*)(ws + WS_PB), e.gw, e.NGW, e.lane); }
    SEAM();
    { KArgs kp = kargs(); unsigned* bw = (unsigned*)(kp->ws + WS_CTL) + CW_BAR; volatile LAS unsigned* st = (volatile LAS unsigned*)(lds + LDSCTL_OFF + 64);
      if (threadIdx.x == 0) { const unsigned G = gridDim.x; bool ok = (G % 8u) == 0u;
          for (unsigned j = 0; j < 16; ++j) { const unsigned c = xb_ld(&bw[XB_XCNT(j)]); ok = ok && (c == (j < 8u ? G / 8u : 0u)); }
          const unsigned x = xb_xcc_id(); st[3] = (ok && x < 8u && st[2] < G / 8u) ? x + 8u * st[2] : blockIdx.x; }
      __syncthreads(); }
    if (IN_I8_MASK & 1) { { PH_ENV(); quant_rows<4>((const bf16*)(ws + WS_H), DM, (signed char*)(ws + WS_XQ), (float*)(ws + WS_XQS), MTOK, e.gw, e.NGW, e.lane); } SEAM(); }
#pragma unroll 1
    for (int layer = 0; layer < DEPTH; ++layer) {
        const int i2 = layer >> 1;
        if (layer > 0 && ((IN_I8_MASK >> layer) & 1)) { { PH_ENV(); quant_rows<4>((const bf16*)(ws + WS_H), DM, (signed char*)(ws + WS_XQ), (float*)(ws + WS_XQS), MTOK, e.gw, e.NGW, e.lane); } SEAM(); }
        if ((layer & 1) == 0) {
            if ((IN_I8_MASK >> layer) & 1) { PH_ENV(); GEMM_CONS_I8(0, (const float*)(ws + WS_PB), (ws + WS_WQINE) + (size_t)i2 * 4096 * DM, (const float*)(ws + WS_CSTEP) + CS_INE + i2 * 4096, (bf16*)(ws + WS_Z), NZE, 4096); }
            else { PH_ENV(); GEMM_CONS(0, (const float*)(ws + WS_PB), (bf16*)(ws + WS_WINE) + (size_t)i2 * NZE * DM, (bf16*)(ws + WS_Z), NZE, 4096); }
            SEAM();
            { PH_ENV(); latent_phase(kp, i2, lds, e.gw, e.NGW, e.wave, e.lane); }
            { PH_ENV(); const bf16* Zq = (const bf16*)(ws + WS_Z) + ZE_QLAT; const bf16* Zk = (const bf16*)(ws + WS_Z) + ZE_KVLAT;
              pg8::StaticOrder S0; S0.init(MTOK, NQMLA, (int)gridDim.x, VCU()); pg8::Unit u0; u0.pm = 0; u0.pn = 0; (void)S0.next(0, u0);
              const int tq = tid_now_(); prep_rstab_z(Zq, NZE, u0.pm, RSTAB, tq); prep_rstab_z(Zk, NZE, u0.pm, RSTAB + 256, tq);
              { pg8::EpiBf16<0> E{(bf16*)(ws + WS_QMLA), NQMLA, (const LAS float*)RSTAB, u0.pm, nullptr, Zq, NZE, nullptr, nullptr}; GEMM_CALL(pg8::EpiBf16<0>, Zq, NZE, (bf16*)(ws + WS_WUQ) + (size_t)i2 * NQMLA * 512, 512, NQMLA, 512, E); }
              { pg8::EpiKV E{(bf16*)(ws + WS_KB), (bf16*)(ws + WS_VB), (const LAS float*)(RSTAB + 256), u0.pm, Zk, NZE}; GEMM_CALL(pg8::EpiKV, Zk, NZE, (bf16*)(ws + WS_WUKV) + (size_t)i2 * NKVU * 512, 512, NKVU, 512, E); } }
            SEAM();
            #if FAST_EVEN
            { KArgs kp = kargs(); int tid_o = threadIdx.x; asm volatile("" : "+v"(tid_o)); fast_mla_attn(kp, lds, tid_o, VCU()); }
            { KArgs kp = kargs(); int tid_o = threadIdx.x; asm volatile("" : "+v"(tid_o)); fast_moba_attn(kp, i2, lds, tid_o, VCU()); }
#else
            { PH_ENV(); naive_even_attn(kp, lds, e.gw, e.NGW, e.wave, e.lane); }
#endif
            SEAM();
            { PH_ENV(); quant_rows<4>((const bf16*)(ws + WS_CAT), NCAT_E, (signed char*)(ws + WS_CATQ), (float*)(ws + WS_CATQS), MTOK, e.gw, e.NGW, e.lane); }
            SEAM();
            { PH_ENV(); pg8::EpiResSplitT<true> E{(bf16*)(ws + WS_H), XLPTR, (float*)(ws + WS_PA), (const float*)(ws + WS_CATQS), (const float*)(ws + WS_CSTEP) + CS_OUTE + i2 * DM, nullptr};
              GEMM_CALLW(pg8::EpiResSplitT<true>, (ws + WS_CATQ), NCAT_E, (ws + WS_WQOUTE) + (size_t)i2 * DM * NCAT_E, NCAT_E, DM, NCAT_E, E, 4); }
            SEAM();
        } else {
            if ((IN_I8_MASK >> layer) & 1) { PH_ENV(); GEMM_CONS_I8(0, (const float*)(ws + WS_PB), (ws + WS_WQINO) + (size_t)i2 * NZO * DM, (const float*)(ws + WS_CSTEP) + CS_INO + i2 * NZO, (bf16*)(ws + WS_Z), NZO, NZO); }
            else { PH_ENV(); GEMM_CONS(0, (const float*)(ws + WS_PB), (bf16*)(ws + WS_WINO) + (size_t)i2 * NZO * DM, (bf16*)(ws + WS_Z), NZO, NZO); }
            SEAM();
            #if FAST_ODD
            { KArgs kp = kargs(); int tid_o = threadIdx.x; asm volatile("" : "+v"(tid_o)); fast_dil_attn(kp, lds, tid_o, VCU()); }
            { KArgs kp = kargs(); int tid_o = threadIdx.x; asm volatile("" : "+v"(tid_o)); fast_swa_attn(kp, i2, lds, tid_o, VCU()); }
#else
            { PH_ENV(); naive_odd_attn(kp, i2, lds, e.gw, e.NGW, e.wave, e.lane); }
#endif
            SEAM();
            { PH_ENV(); merge_quant_phase(kp, e.gw, e.NGW, e.lane); }
            SEAM();
            { PH_ENV(); pg8::EpiResSplitT<true> E{(bf16*)(ws + WS_H), XLPTR, (float*)(ws + WS_PA), (const float*)(ws + WS_CATQS), (const float*)(ws + WS_CSTEP) + CS_OUTO + i2 * DM, nullptr}; GEMM_CALLW(pg8::EpiResSplitT<true>, (ws + WS_CATQ), NCAT_O, (ws + WS_WQOUTO) + (size_t)i2 * DM * NCAT_O, NCAT_O, DM, NCAT_O, E, 4); }
            SEAM();
        }
        if ((UP_I8_MASK >> layer) & 1) {
            { PH_ENV(); quant_rows<4>((const bf16*)(ws + WS_H), DM, (signed char*)(ws + WS_XQ), (float*)(ws + WS_XQS), MTOK, e.gw, e.NGW, e.lane); }
            SEAM();
            if ((DN_I8_MASK >> layer) & 1) { PH_ENV(); GEMM_CONS_U8((const float*)(ws + WS_PA), (ws + WS_WUP + (size_t)layer * FF * DM * 2), (const float*)(ws + WS_WUP + (size_t)layer * FF * DM * 2 + (size_t)FF * DM), (unsigned char*)(ws + WS_U), (float*)(ws + WS_U + (size_t)128 * MiB), FF); }
            else { PH_ENV(); GEMM_CONS_I8(1, (const float*)(ws + WS_PA), (ws + WS_WUP + (size_t)layer * FF * DM * 2), (const float*)(ws + WS_WUP + (size_t)layer * FF * DM * 2 + (size_t)FF * DM), (bf16*)(ws + WS_U), FF, FF); }
        } else
        { PH_ENV(); GEMM_CONS(1, (const float*)(ws + WS_PA), (bf16*)(ws + WS_WUP) + (size_t)layer * FF * DM, (bf16*)(ws + WS_U), FF, FF); }
        SEAM();

        if ((DN_I8_MASK >> layer) & 1) {
            { PH_ENV(); requant_hidden((unsigned char*)(ws + WS_U), (const float*)(ws + WS_U + (size_t)128 * MiB), (float*)(ws + WS_XQS), e.gw, e.NGW, e.lane); }
            SEAM();
            { PH_ENV(); pg8::EpiResSplitT<true, true> E{(bf16*)(ws + WS_H), XLPTR, (float*)(ws + WS_PB), (const float*)(ws + WS_XQS), (const float*)(ws + WS_WDN + (size_t)layer * DM * FF * 2 + (size_t)DM * FF), (const float*)(ws + WS_WDN + (size_t)layer * DM * FF * 2 + (size_t)DM * FF + 8192)};
              typedef pg8::EpiResSplitT<true, true> EpiDn_; GEMM_CALLW(EpiDn_, (ws + WS_U), FF, (ws + WS_WDN + (size_t)layer * DM * FF * 2), FF, DM, FF, E, 4); }
        } else
        { PH_ENV(); pg8::EpiResSplit E{(bf16*)(ws + WS_H), XLPTR, (float*)(ws + WS_PB), nullptr, nullptr, nullptr}; GEMM_CALLW(pg8::EpiResSplit, (bf16*)(ws + WS_U), FF, (bf16*)(ws + WS_WDN) + (size_t)layer * DM * FF, FF, DM, FF, E, 4); }
        SEAM();
    }
    { PH_ENV(); final_norm_phase((const bf16*)(ws + WS_H), (const bf16*)XLPTR, kp->out, kp->in[I_FINAL_NORM], e.gw, e.NGW, e.lane); }
#undef SEAM
}

static_assert((DN_I8_MASK & ~UP_I8_MASK) == 0, "the int8 down-projection takes its input from an int8 up-projection's block-scaled int8 image");
extern "C" void kernel_launch(void* const* d_in, const int* in_sizes, int n_in, void* d_out, int out_size, void* d_ws, size_t ws_size, hipStream_t stream) {
    static int grid = 0;
    if (grid == 0) {
        if (n_in != 15 || in_sizes[0] != MTOK * DM || out_size != MTOK * DM || ws_size < WS_END2) { fprintf(stderr, "kernel_launch: unexpected shapes (n_in %d, in0 %d, out %d, ws %zu)\n", n_in, n_in > 0 ? in_sizes[0] : -1, out_size, ws_size); grid = -1; return; }
        int dev = 0, cus = 0, per_cu = 0;
        if (hipGetDevice(&dev) != hipSuccess || hipDeviceGetAttribute(&cus, hipDeviceAttributeMultiprocessorCount, dev) != hipSuccess) { grid = -1; return; }
        if (hipFuncSetAttribute((const void*)mega_fwd, hipFuncAttributeMaxDynamicSharedMemorySize, LDS_BYTES) != hipSuccess) { fprintf(stderr, "kernel_launch: hipFuncSetAttribute failed\n"); grid = -1; return; }
        if (hipOccupancyMaxActiveBlocksPerMultiprocessor(&per_cu, (const void*)mega_fwd, NTHR, LDS_BYTES) != hipSuccess || per_cu < 1) fprintf(stderr, "kernel_launch: occupancy query reports %d\n", per_cu);
        (void)hipGetLastError();
        grid = cus;
    }
    if (grid < 0) return;
    if (hipMemsetAsync((char*)d_ws + WS_CTL, 0, CTL_ZERO_BYTES, stream) != hipSuccess) { fprintf(stderr, "kernel_launch: memset failed\n"); return; }
    Args a{};
    for (int i = 0; i < 15; ++i) a.in[i] = (const float*)d_in[i];
    a.out = (float*)d_out; a.ws = (unsigned char*)d_ws; a.ph_lo = 0; a.ph_hi = 1 << 20;
    hipLaunchKernelGGL(mega_fwd, dim3(grid), dim3(NTHR), LDS_BYTES, stream, a);
}
```
